# Optimizing an MI355X kernel written in HIP

```python
import jax, jax.numpy as jnp
from jax import lax
import numpy as np

D_MODEL = 1024
BATCH = 4
SEQ = 8192
DEPTH = 1

CONV_DIM = 512
CONV_KERNEL = 31
HGRN_DIM = 1024
HGRN_HEADS = 8
HGRN_HEAD_DIM = HGRN_DIM // HGRN_HEADS
HGRN_CHUNK = 64
N_BRANCHES = 2
D_FF = 2816
FFN_KERNEL = 3
LN_EPS = 1e-5
RMS_EPS = 1e-6
ALPHA = (2.0 * DEPTH) ** 0.25
BETA = (8.0 * DEPTH) ** -0.25

IN_SPLITS = [CONV_DIM, CONV_DIM, HGRN_DIM, HGRN_DIM, HGRN_DIM, HGRN_DIM, N_BRANCHES * D_MODEL]
IN_COLS = sum(IN_SPLITS)
IN_OFFSETS = list(np.cumsum(IN_SPLITS)[:-1])

kernel_name = "hybrid_conformer_conv_hgrn2_gated_merge_convffn"


def layer_norm(x, g, b):
    xf = x.astype(jnp.float32)
    mu = jnp.mean(xf, axis=-1, keepdims=True)
    var = jnp.mean(jnp.square(xf - mu), axis=-1, keepdims=True)
    y = (xf - mu) * lax.rsqrt(var + LN_EPS) * g.astype(jnp.float32) + b.astype(jnp.float32)
    return y.astype(x.dtype)


def causal_dwconv(x, w, b):
    k_w = w.shape[0]
    c = x.shape[-1]
    y = lax.conv_general_dilated(
        x, w[:, None, :].astype(x.dtype), window_strides=(1,), padding=[(k_w - 1, 0)],
        dimension_numbers=("NWC", "WIO", "NWC"), feature_group_count=c)
    return y + b.astype(x.dtype)


def hgrn2_chunked(q, k, v, logf):
    bsz, seq, nh, dk = q.shape
    dv = v.shape[-1]
    nc = seq // HGRN_CHUNK

    def to_chunks(t):
        return t.reshape(bsz, nc, HGRN_CHUNK, nh, t.shape[-1]).transpose(1, 0, 3, 2, 4)

    qc, kc, vc, lfc = to_chunks(q), to_chunks(k), to_chunks(v), to_chunks(logf)
    bc = jnp.cumsum(lfc, axis=3)
    mask = jnp.tril(jnp.ones((HGRN_CHUNK, HGRN_CHUNK), dtype=bool))[:, :, None]

    def step(state, inp):
        q_c, k_c, v_c, b_c = inp
        diff = b_c[:, :, :, None, :] - b_c[:, :, None, :, :]
        decay = jnp.exp(jnp.where(mask, diff, -jnp.inf))
        scores = jnp.einsum("bhtk,bhsk,bhtsk->bhts", q_c, k_c, decay)
        o_intra = jnp.einsum("bhts,bhsv->bhtv", scores, v_c)
        o_inter = jnp.einsum("bhtk,bhkv->bhtv", q_c * jnp.exp(b_c), state)
        b_last = b_c[:, :, -1, :]
        k_tail = k_c * jnp.exp(b_last[:, :, None, :] - b_c)
        new_state = jnp.exp(b_last)[..., None] * state + jnp.einsum("bhsk,bhsv->bhkv", k_tail, v_c)
        return new_state, o_intra + o_inter

    s0 = jnp.zeros((bsz, nh, dk, dv), jnp.float32)
    _, oc = lax.scan(step, s0, (qc, kc, vc, bc))
    return oc.transpose(1, 0, 3, 2, 4).reshape(bsz, seq, nh, dv)


def setup_inputs(seed: int = 0) -> dict:
    key = jax.random.key(seed)
    ks = jax.random.split(key, 20)

    def nrm(k, shape, scale):
        return jax.random.normal(k, shape, jnp.float32) * scale

    col_scale = jnp.concatenate([
        jnp.ones((2 * CONV_DIM + 2 * HGRN_DIM,), jnp.float32),
        jnp.full((HGRN_DIM,), BETA, jnp.float32),
        jnp.ones((HGRN_DIM + N_BRANCHES * D_MODEL,), jnp.float32)])
    ffn_scale = jnp.concatenate([jnp.full((D_FF,), BETA, jnp.float32), jnp.ones((D_FF,), jnp.float32)])
    return {
        "x": nrm(ks[0], (BATCH, SEQ, D_MODEL), 1.0),
        "w_in": nrm(ks[1], (DEPTH, D_MODEL, IN_COLS), D_MODEL ** -0.5) * col_scale,
        "w_conv_dw": nrm(ks[2], (DEPTH, CONV_KERNEL, CONV_DIM), CONV_KERNEL ** -0.5),
        "b_conv_dw": nrm(ks[3], (DEPTH, CONV_DIM), 0.02),
        "conv_ln_g": 1.0 + nrm(ks[4], (DEPTH, CONV_DIM), 0.02),
        "conv_ln_b": nrm(ks[5], (DEPTH, CONV_DIM), 0.02),
        "w_conv_out": nrm(ks[6], (DEPTH, CONV_DIM, D_MODEL), BETA * CONV_DIM ** -0.5),
        "hgrn_lb_logits": nrm(ks[7], (DEPTH + 1, HGRN_DIM), 0.5),
        "hgrn_norm_g": 1.0 + nrm(ks[8], (DEPTH, HGRN_DIM), 0.02),
        "w_hgrn_out": nrm(ks[9], (DEPTH, HGRN_DIM, D_MODEL), BETA * HGRN_DIM ** -0.5),
        "w_out": nrm(ks[10], (DEPTH, D_MODEL, D_MODEL), BETA * D_MODEL ** -0.5),
        "ln1_g": 1.0 + nrm(ks[11], (DEPTH, D_MODEL), 0.02),
        "ln1_b": nrm(ks[12], (DEPTH, D_MODEL), 0.02),
        "w_ffn_in": nrm(ks[13], (DEPTH, D_MODEL, 2 * D_FF), D_MODEL ** -0.5) * ffn_scale,
        "w_ffn_dw": nrm(ks[14], (DEPTH, FFN_KERNEL, D_FF), FFN_KERNEL ** -0.5),
        "b_ffn_dw": nrm(ks[15], (DEPTH, D_FF), 0.02),
        "w_ffn_out": nrm(ks[16], (DEPTH, D_FF, D_MODEL), BETA * D_FF ** -0.5),
        "ln2_g": 1.0 + nrm(ks[17], (DEPTH, D_MODEL), 0.02),
        "ln2_b": nrm(ks[18], (DEPTH, D_MODEL), 0.02),
    }


def reference(x, w_in, w_conv_dw, b_conv_dw, conv_ln_g, conv_ln_b, w_conv_out,
              hgrn_lb_logits, hgrn_norm_g, w_hgrn_out, w_out, ln1_g, ln1_b,
              w_ffn_in, w_ffn_dw, b_ffn_dw, w_ffn_out, ln2_g, ln2_b):
    bsz, seq, _ = x.shape
    lb_all = jnp.cumsum(jax.nn.softmax(hgrn_lb_logits.astype(jnp.float32), axis=0), axis=0)
    for l in range(DEPTH):
        h = x
        proj = h @ w_in[l]
        c_val, c_gate, q_z, f_z, i_v, g_z, m_z = jnp.split(proj, IN_OFFSETS, axis=-1)

        c = c_val * jax.nn.sigmoid(c_gate)
        c = causal_dwconv(c, w_conv_dw[l], b_conv_dw[l])
        c = jax.nn.silu(layer_norm(c, conv_ln_g[l], conv_ln_b[l]))
        y_conv = c @ w_conv_out[l]

        lb = lb_all[l]
        zf = f_z.astype(jnp.float32)
        logf = jnp.log(lb + (1.0 - lb) * jax.nn.sigmoid(zf))
        k_in = (1.0 - lb) * jax.nn.sigmoid(-zf)
        qf = jax.nn.silu(q_z.astype(jnp.float32))
        heads = lambda t: t.reshape(bsz, seq, HGRN_HEADS, HGRN_HEAD_DIM)
        o = hgrn2_chunked(heads(qf), heads(k_in), heads(i_v.astype(jnp.float32)), heads(logf))
        o = o * lax.rsqrt(jnp.mean(jnp.square(o), axis=-1, keepdims=True) + RMS_EPS)
        o = o.reshape(bsz, seq, HGRN_DIM) * hgrn_norm_g[l].astype(jnp.float32)
        o = o.astype(x.dtype) * jax.nn.silu(g_z)
        y_hgrn = o @ w_hgrn_out[l]

        gates = jax.nn.sigmoid(m_z).reshape(bsz, seq, N_BRANCHES, D_MODEL)
        mixed = gates[:, :, 0, :] * y_conv + gates[:, :, 1, :] * y_hgrn
        mix = mixed @ w_out[l]
        x = layer_norm(ALPHA * x + mix, ln1_g[l], ln1_b[l])

        z = x @ w_ffn_in[l]
        u, gv = jnp.split(z, [D_FF], axis=-1)
        u = causal_dwconv(u, w_ffn_dw[l], b_ffn_dw[l])
        y_ffn = (jax.nn.gelu(u) * gv) @ w_ffn_out[l]
        x = layer_norm(ALPHA * x + y_ffn, ln2_g[l], ln2_b[l])
    return x
```

```cpp
#include <hip/hip_runtime.h>
#include <hip/hip_cooperative_groups.h>
#include <cstdio>
namespace cg = cooperative_groups;

#define LAS __attribute__((address_space(3)))
typedef unsigned short bf16_t;
typedef short bf16x8 __attribute__((ext_vector_type(8)));
typedef float f32x4 __attribute__((ext_vector_type(4)));
typedef float f32x2 __attribute__((ext_vector_type(2)));
typedef unsigned u32x4 __attribute__((ext_vector_type(4)));
typedef unsigned u32x2 __attribute__((ext_vector_type(2)));

constexpr int T_TOK = 32768, SEQ = 8192, DM = 1024, IN_COLS = 7168, CONV_DIM = 512, CONV_K = 31, HG = 1024, DFF = 2816;
constexpr float ALPHA = 1.189207115002721f;
constexpr float LN_EPS = 1e-5f, RMS_EPS = 1e-6f;
constexpr int NTHREADS = 512;
constexpr int LDS_BYTES = 140 * 1024;

constexpr size_t MiB = 1024ull * 1024ull;
constexpr size_t OFF_W    = 0;
constexpr size_t OFF_WIN  = OFF_W;
constexpr size_t OFF_WCO  = OFF_WIN + (size_t)IN_COLS * DM * 2;
constexpr size_t OFF_WHO  = OFF_WCO + (size_t)DM * CONV_DIM * 2;
constexpr size_t OFF_WOUT = OFF_WHO + (size_t)DM * HG * 2;
constexpr size_t OFF_WFI  = OFF_WOUT + (size_t)DM * DM * 2;
constexpr size_t OFF_WFO  = OFF_WFI + (size_t)2 * DFF * DM * 2;
constexpr size_t OFF_G    = 36 * MiB;
constexpr size_t OFF_Q    = 100 * MiB;
constexpr size_t OFF_KIN  = 164 * MiB;
constexpr size_t OFF_V    = 228 * MiB;
constexpr size_t OFF_XB   = 292 * MiB;
constexpr size_t OFF_CVG  = 356 * MiB;
constexpr size_t OFF_L    = 420 * MiB;
constexpr size_t OFF_D    = 484 * MiB;
constexpr size_t OFF_MISC = 485 * MiB;
constexpr size_t OFF_Z    = OFF_Q;
constexpr size_t OFF_PART7  = 486 * MiB;
constexpr size_t OFF_PART11 = 487 * MiB;
constexpr size_t OFF_BAR  = 489 * MiB;
constexpr size_t OFF_CNT  = OFF_BAR + 64 * 1024;
constexpr size_t ZERO_BYTES = 64 * 1024 + 2 * 128 * 2 * 256;
constexpr size_t WS_NEED  = 490 * MiB;

struct Params {
    const float* x; const float* w_in; const float* w_conv_dw; const float* b_conv_dw; const float* conv_ln_g; const float* conv_ln_b;
    const float* w_conv_out; const float* lb_logits; const float* hgrn_norm_g; const float* w_hgrn_out; const float* w_out;
    const float* ln1_g; const float* ln1_b; const float* w_ffn_in; const float* w_ffn_dw; const float* b_ffn_dw; const float* w_ffn_out;
    const float* ln2_g; const float* ln2_b;
    float* out; unsigned char* ws;
};

__device__ __forceinline__ unsigned cvt_pk_bf16(float lo, float hi) { unsigned r; asm("v_cvt_pk_bf16_f32 %0, %1, %2" : "=v"(r) : "v"(lo), "v"(hi)); return r; }
__device__ __forceinline__ float bf2f(unsigned short b) { return __uint_as_float(((unsigned)b) << 16); }
__device__ __forceinline__ float bflo(unsigned u) { return __uint_as_float(u << 16); }
__device__ __forceinline__ float bfhi(unsigned u) { return __uint_as_float(u & 0xffff0000u); }
__device__ __forceinline__ unsigned short f2bf(float f) { return (unsigned short)(cvt_pk_bf16(f, 0.f) & 0xffffu); }
__device__ __forceinline__ float sigmoidf_(float x) { return __builtin_amdgcn_rcpf(1.0f + __expf(-x)); }
__device__ __forceinline__ unsigned pk_f16(float lo, float hi) {
    _Float16 a = (_Float16)lo, b = (_Float16)hi; unsigned short ua, ub; __builtin_memcpy(&ua, &a, 2); __builtin_memcpy(&ub, &b, 2); return (unsigned)ua | ((unsigned)ub << 16); }
__device__ __forceinline__ float wave_sum(float v) {
#pragma unroll
    for (int o = 32; o >= 1; o >>= 1) v += __shfl_xor(v, o);
    return v; }

namespace pg8 {
constexpr int BM = 256, BK = 64, HALF = 128, HTB = HALF * BK * 2, STAGE_BYTES = 8 * HTB, NXCD = 8, WGM = 4;
__host__ __device__ __forceinline__ int lds_byte(int r, int c) { const int st = (r >> 4) * 2 + (c >> 5), rr = r & 15, cc = c & 31, ob = rr * 64 + cc * 2; return st * 1024 + (ob ^ (((ob >> 9) & 1) << 5)); }
__host__ __device__ __forceinline__ void stage_rc(int b, int& R, int& C) { const int st = b / 1024, sb = b % 1024, swz = sb ^ (((sb >> 9) & 1) << 5); R = (st >> 1) * 16 + swz / 64; C = (st & 1) * 32 + (swz % 64) / 2; }
__host__ __device__ __forceinline__ int perm32(int rho) { const int n = rho >> 4, i = rho & 15; return 8 * (i >> 2) + 4 * n + (i & 3); }
struct Unit { int pm, pn; };
struct Gemm { const bf16_t* A; const bf16_t* Bt; int M, N, K, lda; const bf16_t* A2; int lda2; int ksplit; };
struct StaticOrder {
    int nM, nN, nwg, G, c, reps;
    __device__ void init(int M, int N, int G_, int c_, int reps_ = 1) { nM = M / BM; nN = N / BM; nwg = nM * nN; G = G_; c = c_; reps = reps_; }
    __device__ bool next(int i, Unit& u) const {
        const int rounds = (nwg + G - 1) / G; if (i >= rounds * reps) return false;
        const long L = (long)(i % rounds) * G + c; if (L >= nwg) return false;
        int wgid = (int)L; { const int q = nwg / NXCD, r = nwg % NXCD, xcd = wgid % NXCD, off = wgid / NXCD; wgid = (xcd < r ? xcd * (q + 1) : r * (q + 1) + (xcd - r) * q) + off; }
        const int nig = WGM * nN, gid = wgid / nig, fm = gid * WGM, gsz = (nM - fm) < WGM ? (nM - fm) : WGM;
        u.pm = fm + ((wgid % nig) % gsz); u.pn = (wgid % nig) / gsz; return true;
    }
};

template <class Epi, bool DUAL = false>
__device__ __forceinline__ void gemm_phase(LAS unsigned char* lds, const Gemm g, const StaticOrder& S, Epi& E) {
    const int tid = threadIdx.x, wid = __builtin_amdgcn_readfirstlane(tid >> 6), lane = tid & 63, wr = wid >> 2, wc = wid & 3, fr = lane & 15, fq = lane >> 4;
    const int K = g.K, nt = K / BK, lda = g.lda, lda2 = g.lda2, ksplit = g.ksplit;
    unsigned voffA[2], voffA2[2], voffB[2];
#pragma unroll
    for (int i = 0; i < 2; ++i) { int R, C; stage_rc(tid * 16 + i * 8192, R, C); const int Rb = Epi::PERM ? ((R & ~31) + perm32(R & 31)) : R;
        voffA[i] = (unsigned)(R * lda + C) * 2u; voffA2[i] = DUAL ? (unsigned)(R * lda2 + C) * 2u : 0u; voffB[i] = (unsigned)(Rb * K + C) * 2u; }
    const size_t kstep = (size_t)(BK * 2);
    const size_t hstepA = (size_t)HALF * lda * 2, hstepA2 = (size_t)HALF * lda2 * 2, hstepB = (size_t)HALF * K * 2;
    const unsigned ldsw = (unsigned)wid * 1024u;
    const int aoff = lds_byte(wr * 64 + fr, fq * 8), boff = lds_byte(wc * 32 + fr, fq * 8);
#define PG8_SA(b, h) (((b) * 2 + (h)) * HTB)
#define PG8_SB(b, h) ((4 + (b) * 2 + (h)) * HTB)
    auto stA = [&](int bufoff, int pm, int kt, int half) {
        const char* base; unsigned v0, v1;
        if (DUAL && kt >= ksplit) { base = (const char*)g.A2 + (size_t)(2 * pm + half) * hstepA2 + (size_t)(kt - ksplit) * kstep; v0 = voffA2[0]; v1 = voffA2[1]; }
        else                      { base = (const char*)g.A  + (size_t)(2 * pm + half) * hstepA  + (size_t)kt * kstep;            v0 = voffA[0];  v1 = voffA[1]; }
        __builtin_amdgcn_global_load_lds((const unsigned*)(base + v0), (LAS unsigned*)(lds + bufoff + ldsw), 16, 0, 0);
        __builtin_amdgcn_global_load_lds((const unsigned*)(base + v1), (LAS unsigned*)(lds + bufoff + ldsw + 8192), 16, 0, 0);
    };
    auto stB = [&](int bufoff, int pn, int kt, int half) {
        const char* base = (const char*)g.Bt + (size_t)(2 * pn + half) * hstepB + (size_t)kt * kstep;
        __builtin_amdgcn_global_load_lds((const unsigned*)(base + voffB[0]), (LAS unsigned*)(lds + bufoff + ldsw), 16, 0, 0);
        __builtin_amdgcn_global_load_lds((const unsigned*)(base + voffB[1]), (LAS unsigned*)(lds + bufoff + ldsw + 8192), 16, 0, 0);
    };
#define PG8_LDA(dst, b, h) do { _Pragma("unroll") for (int m = 0; m < 4; ++m) _Pragma("unroll") for (int k = 0; k < 2; ++k) dst[m][k] = *(const LAS bf16x8*)(lds + PG8_SA(b, h) + aoff + m * 2048 + k * 1024); } while (0)
#define PG8_LDB(dst, b, h) do { _Pragma("unroll") for (int n = 0; n < 2; ++n) _Pragma("unroll") for (int k = 0; k < 2; ++k) dst[n][k] = *(const LAS bf16x8*)(lds + PG8_SB(b, h) + boff + n * 2048 + k * 1024); } while (0)
#define PG8_MMA(ai, bj, At, Bt) do { __builtin_amdgcn_s_setprio(1); _Pragma("unroll") for (int m = 0; m < 4; ++m) _Pragma("unroll") for (int n = 0; n < 2; ++n) _Pragma("unroll") for (int k = 0; k < 2; ++k) \
        acc[ai][bj][m][n] = __builtin_amdgcn_mfma_f32_16x16x32_bf16(Bt[n][k], At[m][k], acc[ai][bj][m][n], 0, 0, 0); __builtin_amdgcn_s_setprio(0); } while (0)
#define PG8_WAIT_V(n) asm volatile("s_waitcnt vmcnt(" #n ")" ::: "memory")
#define PG8_WAIT_L(n) asm volatile("s_waitcnt lgkmcnt(" #n ")" ::: "memory")
#define PG8_BAR __builtin_amdgcn_s_barrier()
#define PG8_SCHED __builtin_amdgcn_sched_barrier(0)
    Unit cur, nxt; int ui = 0;
    if (!S.next(0, cur)) return;
    f32x4 acc[2][2][4][2];
#pragma unroll
    for (int a = 0; a < 2; ++a)
#pragma unroll
        for (int b = 0; b < 2; ++b)
#pragma unroll
            for (int m = 0; m < 4; ++m)
#pragma unroll
                for (int n = 0; n < 2; ++n) acc[a][b][m][n] = (f32x4){0.f, 0.f, 0.f, 0.f};
    bf16x8 At[4][2], B0[2][2], B1[2][2];
    stB(PG8_SB(0, 0), cur.pn, 0, 0); stA(PG8_SA(0, 0), cur.pm, 0, 0); stB(PG8_SB(0, 1), cur.pn, 0, 1); stA(PG8_SA(0, 1), cur.pm, 0, 1);
    if (wr == 1) PG8_BAR;
    PG8_WAIT_V(4); PG8_BAR;
    stB(PG8_SB(1, 0), cur.pn, 1, 0); stA(PG8_SA(1, 0), cur.pm, 1, 0); stB(PG8_SB(1, 1), cur.pn, 1, 1);
    PG8_WAIT_V(6); PG8_BAR;
    for (;;) {
        const bool has_next = S.next(ui + 1, nxt);
        const int npm = has_next ? nxt.pm : cur.pm, npn = has_next ? nxt.pn : cur.pn;
        for (int t = 0; t < nt; t += 2) {
            const bool last = (t == nt - 2);
            const int pm2 = last ? npm : cur.pm, pn2 = last ? npn : cur.pn, k2 = last ? 0 : t + 2, k3 = k2 + 1;
            if constexpr (DUAL) { if (t == ksplit) E.mid(acc, cur, wr, wc, fr, fq); }
            PG8_LDB(B0, 0, 0); PG8_SCHED; PG8_LDA(At, 0, 0); stA(PG8_SA(1, 1), cur.pm, t + 1, 1);
            PG8_WAIT_L(8); PG8_BAR; PG8_WAIT_L(0); PG8_MMA(0, 0, At, B0); PG8_BAR; PG8_SCHED;
            PG8_LDB(B1, 0, 1); stB(PG8_SB(0, 0), pn2, k2, 0);
            PG8_BAR; PG8_WAIT_L(0); PG8_MMA(0, 1, At, B1); PG8_BAR;
            PG8_LDA(At, 0, 1); stA(PG8_SA(0, 0), pm2, k2, 0);
            PG8_BAR; PG8_WAIT_L(0); PG8_MMA(1, 0, At, B0); PG8_BAR; PG8_SCHED;
            stB(PG8_SB(0, 1), pn2, k2, 1);
            PG8_WAIT_V(6); PG8_BAR; PG8_MMA(1, 1, At, B1); PG8_BAR;
            PG8_LDB(B0, 1, 0); PG8_SCHED; PG8_LDA(At, 1, 0); stA(PG8_SA(0, 1), pm2, k2, 1);
            PG8_WAIT_L(8); PG8_BAR; PG8_WAIT_L(0); PG8_MMA(0, 0, At, B0); PG8_BAR; PG8_SCHED;
            PG8_LDB(B1, 1, 1); stB(PG8_SB(1, 0), pn2, k3, 0);
            PG8_BAR; PG8_WAIT_L(0); PG8_MMA(0, 1, At, B1); PG8_BAR;
            PG8_LDA(At, 1, 1); stA(PG8_SA(1, 0), pm2, k3, 0);
            PG8_BAR; PG8_WAIT_L(0); PG8_MMA(1, 0, At, B0); PG8_BAR; PG8_SCHED;
            stB(PG8_SB(1, 1), pn2, k3, 1);
            PG8_WAIT_V(6); PG8_BAR; PG8_MMA(1, 1, At, B1); PG8_BAR;
        }
        E(acc, cur, wr, wc, fr, fq);
        if (!has_next) break;
#pragma unroll
        for (int a = 0; a < 2; ++a)
#pragma unroll
            for (int b = 0; b < 2; ++b)
#pragma unroll
                for (int m = 0; m < 4; ++m)
#pragma unroll
                    for (int n = 0; n < 2; ++n) acc[a][b][m][n] = (f32x4){0.f, 0.f, 0.f, 0.f};
        cur = nxt; ++ui;
    }
    PG8_WAIT_V(0);
    if (wr == 0) PG8_BAR;
    PG8_BAR;
#undef PG8_SA
#undef PG8_SB
#undef PG8_LDA
#undef PG8_LDB
#undef PG8_MMA
#undef PG8_WAIT_V
#undef PG8_WAIT_L
#undef PG8_BAR
#undef PG8_SCHED
}
}
using pg8::Unit;

struct EpiProj {
    static constexpr bool PERM = true;
    unsigned char* ws; unsigned short* mgate; const float* colscale;
    __device__ __forceinline__ void operator()(const f32x4 (&acc)[2][2][4][2], const Unit& u, int wr, int wc, int fr, int fq) const {
        const int pn = u.pn;
        unsigned short* base; int ld, colt; float c0, c1, c2, sgn; bool f16 = false;
        if (pn < 4)       { base = (unsigned short*)(ws + OFF_CVG); ld = 1024; colt = pn * 256; if (pn < 2) { c0 = 1.f; c1 = 0.f; c2 = 0.f; } else { c0 = 0.f; c1 = 1.f; c2 = 0.f; } sgn = 1.f; }
        else if (pn < 8)  { base = (unsigned short*)(ws + OFF_Q);   ld = 1024; colt = (pn - 4) * 256;  c0 = 0.f; c1 = 0.f; c2 = 1.f; sgn = 1.f; }
        else if (pn < 12) { base = (unsigned short*)(ws + OFF_KIN); ld = 1024; colt = (pn - 8) * 256;  c0 = 0.f; c1 = 1.f; c2 = 0.f; sgn = -1.f; f16 = true; }
        else if (pn < 16) { base = (unsigned short*)(ws + OFF_V);   ld = 1024; colt = (pn - 12) * 256; c0 = 1.f; c1 = 0.f; c2 = 0.f; sgn = 1.f; }
        else if (pn < 20) { base = (unsigned short*)(ws + OFF_G);   ld = 1024; colt = (pn - 16) * 256; c0 = 0.f; c1 = 0.f; c2 = 1.f; sgn = 1.f; }
        else              { base = mgate;                           ld = 2048; colt = (pn - 20) * 256; c0 = 0.f; c1 = 1.f; c2 = 0.f; sgn = 1.f; }
        const int row0 = u.pm * 256 + wr * 64 + fr, coll = wc * 32 + 8 * fq;
        f32x4 cs[2][2];
#pragma unroll
        for (int bj = 0; bj < 2; ++bj)
#pragma unroll
            for (int n = 0; n < 2; ++n) cs[bj][n] = f16 ? *(const f32x4*)(colscale + pn * 256 + bj * 128 + coll + 4 * n) : (f32x4){1.f, 1.f, 1.f, 1.f};
#pragma unroll
        for (int ai = 0; ai < 2; ++ai)
#pragma unroll
            for (int m = 0; m < 4; ++m) {
                unsigned short* rowp = base + (size_t)(row0 + ai * 128 + m * 16) * ld + colt + coll;
#pragma unroll
                for (int bj = 0; bj < 2; ++bj) {
                    float o[8];
#pragma unroll
                    for (int n = 0; n < 2; ++n)
#pragma unroll
                        for (int j = 0; j < 4; ++j) { const float z = acc[ai][bj][m][n][j]; const float s = __builtin_amdgcn_rcpf(1.0f + __expf(-sgn * z)); o[n * 4 + j] = (c0 * z + s * (c1 + c2 * z)) * cs[bj][n][j]; }
                    const u32x4 pkh = (u32x4){pk_f16(o[0], o[1]), pk_f16(o[2], o[3]), pk_f16(o[4], o[5]), pk_f16(o[6], o[7])};
                    const u32x4 pkb = (u32x4){cvt_pk_bf16(o[0], o[1]), cvt_pk_bf16(o[2], o[3]), cvt_pk_bf16(o[4], o[5]), cvt_pk_bf16(o[6], o[7])};
                    u32x4 pk;
#pragma unroll
                    for (int q = 0; q < 4; ++q) pk[q] = f16 ? pkh[q] : pkb[q];
                    *(u32x4*)(rowp + bj * 128) = pk;
                }
            }
    }
};
struct EpiMix {
    static constexpr bool PERM = false;
    const unsigned short* mgate; unsigned short* mixed;
    __device__ __forceinline__ void mid(f32x4 (&acc)[2][2][4][2], const Unit& u, int wr, int wc, int fr, int fq) const {
        const int row0 = u.pm * 256 + wr * 64 + fr, col0 = u.pn * 256 + wc * 32 + 4 * fq;
#pragma unroll
        for (int ai = 0; ai < 2; ++ai)
#pragma unroll
            for (int m = 0; m < 4; ++m) { const size_t r = (size_t)(row0 + ai * 128 + m * 16);
#pragma unroll
                for (int bj = 0; bj < 2; ++bj)
#pragma unroll
                    for (int n = 0; n < 2; ++n) { const int c = col0 + bj * 128 + n * 16;
                        const u32x2 ga = *(const u32x2*)(mgate + r * 2048 + c), gb = *(const u32x2*)(mgate + r * 2048 + 1024 + c);
                        acc[ai][bj][m][n][0] *= bflo(ga[0]) * __builtin_amdgcn_rcpf(bflo(gb[0])); acc[ai][bj][m][n][1] *= bfhi(ga[0]) * __builtin_amdgcn_rcpf(bfhi(gb[0]));
                        acc[ai][bj][m][n][2] *= bflo(ga[1]) * __builtin_amdgcn_rcpf(bflo(gb[1])); acc[ai][bj][m][n][3] *= bfhi(ga[1]) * __builtin_amdgcn_rcpf(bfhi(gb[1])); } }
    }
    __device__ __forceinline__ void operator()(const f32x4 (&acc)[2][2][4][2], const Unit& u, int wr, int wc, int fr, int fq) const {
        const int row0 = u.pm * 256 + wr * 64 + fr, col0 = u.pn * 256 + wc * 32 + 4 * fq;
#pragma unroll
        for (int ai = 0; ai < 2; ++ai)
#pragma unroll
            for (int m = 0; m < 4; ++m) { const size_t r = (size_t)(row0 + ai * 128 + m * 16);
#pragma unroll
                for (int bj = 0; bj < 2; ++bj)
#pragma unroll
                    for (int n = 0; n < 2; ++n) { const int c = col0 + bj * 128 + n * 16;
                        const u32x2 gb = *(const u32x2*)(mgate + r * 2048 + 1024 + c);
                        const f32x4 v = acc[ai][bj][m][n];
                        *(u32x2*)(mixed + r * 1024 + c) = (u32x2){cvt_pk_bf16(v[0] * bflo(gb[0]), v[1] * bfhi(gb[0])), cvt_pk_bf16(v[2] * bflo(gb[1]), v[3] * bfhi(gb[1]))}; } }
    }
};
struct EpiRes {
    static constexpr bool PERM = false;
    const float* res; float* dst;
    __device__ __forceinline__ void operator()(const f32x4 (&acc)[2][2][4][2], const Unit& u, int wr, int wc, int fr, int fq) const {
        const int row0 = u.pm * 256 + wr * 64 + fr, col0 = u.pn * 256 + wc * 32 + 4 * fq;
#pragma unroll
        for (int ai = 0; ai < 2; ++ai)
#pragma unroll
            for (int m = 0; m < 4; ++m) { const size_t r = (size_t)(row0 + ai * 128 + m * 16);
#pragma unroll
                for (int bj = 0; bj < 2; ++bj)
#pragma unroll
                    for (int n = 0; n < 2; ++n) { const int c = col0 + bj * 128 + n * 16;
                        const f32x4 t = *(const f32x4*)(res + r * 1024 + c);
                        *(f32x4*)(dst + r * 1024 + c) = t * ALPHA + acc[ai][bj][m][n]; } }
    }
};
struct EpiResB {
    static constexpr bool PERM = false;
    const unsigned short* res; float* dst;
    __device__ __forceinline__ void operator()(const f32x4 (&acc)[2][2][4][2], const Unit& u, int wr, int wc, int fr, int fq) const {
        const int row0 = u.pm * 256 + wr * 64 + fr, col0 = u.pn * 256 + wc * 32 + 4 * fq;
#pragma unroll
        for (int ai = 0; ai < 2; ++ai)
#pragma unroll
            for (int m = 0; m < 4; ++m) { const size_t r = (size_t)(row0 + ai * 128 + m * 16);
#pragma unroll
                for (int bj = 0; bj < 2; ++bj)
#pragma unroll
                    for (int n = 0; n < 2; ++n) { const int c = col0 + bj * 128 + n * 16;
                        const u32x2 t = *(const u32x2*)(res + r * 1024 + c);
                        const f32x4 tv = (f32x4){bflo(t[0]), bfhi(t[0]), bflo(t[1]), bfhi(t[1])};
                        *(f32x4*)(dst + r * 1024 + c) = tv * ALPHA + acc[ai][bj][m][n]; } }
    }
};
template <int MODE  > struct EpiLn {
    static constexpr bool PERM = false;
    const void* res; void* outp; const float* gam; const float* bet; float* part; unsigned* cnt; LAS unsigned char* ldsx;
    __device__ __forceinline__ void operator()(f32x4 (&acc)[2][2][4][2], const Unit& u, int wr, int wc, int fr, int fq) const {
        const int row0 = u.pm * 256 + wr * 64 + fr, col0 = u.pn * 256 + wc * 32 + 4 * fq;
        LAS float* red = (LAS float*)ldsx;
        LAS float* stats = (LAS float*)(ldsx + 8192);
#pragma unroll
        for (int ai = 0; ai < 2; ++ai)
#pragma unroll
            for (int m = 0; m < 4; ++m) { const size_t r = (size_t)(row0 + ai * 128 + m * 16);
                float s1 = 0.f, s2 = 0.f;
#pragma unroll
                for (int bj = 0; bj < 2; ++bj)
#pragma unroll
                    for (int n = 0; n < 2; ++n) { const int c = col0 + bj * 128 + n * 16;
                        f32x4 tv;
                        if (MODE == 0) tv = *(const f32x4*)((const float*)res + r * 1024 + c);
                        else { const u32x2 t = *(const u32x2*)((const unsigned short*)res + r * 1024 + c); tv = (f32x4){bflo(t[0]), bfhi(t[0]), bflo(t[1]), bfhi(t[1])}; }
                        const f32x4 v = tv * ALPHA + acc[ai][bj][m][n];
                        acc[ai][bj][m][n] = v;
                        s1 += v[0] + v[1] + v[2] + v[3]; s2 += v[0] * v[0] + v[1] * v[1] + v[2] * v[2] + v[3] * v[3]; }
                s1 += __shfl_xor(s1, 16); s1 += __shfl_xor(s1, 32); s2 += __shfl_xor(s2, 16); s2 += __shfl_xor(s2, 32);
                if (fq == 0) { const int rl = ai * 128 + wr * 64 + m * 16 + fr; red[(rl * 4 + wc) * 2] = s1; red[(rl * 4 + wc) * 2 + 1] = s2; } }
        __syncthreads();
        if (wc == 0) {
            const int lane = fq * 16 + fr;
            unsigned* cw = cnt + (size_t)(u.pm * 2 + wr) * 64;
            float* mypart = part + ((size_t)(u.pm * 4 + u.pn) * 256) * 2;
#pragma unroll
            for (int q = 0; q < 2; ++q) { const int i = lane + 64 * q, rl = (i >> 6) * 128 + wr * 64 + (i & 63);
                float t1 = 0.f, t2 = 0.f;
#pragma unroll
                for (int w4 = 0; w4 < 4; ++w4) { t1 += red[(rl * 4 + w4) * 2]; t2 += red[(rl * 4 + w4) * 2 + 1]; }
                const unsigned long long pv = (unsigned long long)__float_as_uint(t1) | ((unsigned long long)__float_as_uint(t2) << 32);
                __hip_atomic_store((unsigned long long*)(mypart + rl * 2), pv, __ATOMIC_RELAXED, __HIP_MEMORY_SCOPE_AGENT); }
            asm volatile("s_waitcnt vmcnt(0)" ::: "memory");
            if (lane == 0) (void)__hip_atomic_fetch_add(cw, 1u, __ATOMIC_RELAXED, __HIP_MEMORY_SCOPE_AGENT);
            { unsigned sp = 0;
              while ((unsigned)__builtin_amdgcn_readfirstlane(__hip_atomic_load(cw, __ATOMIC_RELAXED, __HIP_MEMORY_SCOPE_AGENT)) < 4u) { __builtin_amdgcn_s_sleep(1); if (++sp > (1u << 22)) break; } }
            asm volatile("" ::: "memory");
#pragma unroll
            for (int q = 0; q < 2; ++q) { const int i = lane + 64 * q, rl = (i >> 6) * 128 + wr * 64 + (i & 63);
                float t1 = 0.f, t2 = 0.f;
#pragma unroll
                for (int pn = 0; pn < 4; ++pn) { const unsigned long long pv = __hip_atomic_load((unsigned long long*)(part + ((size_t)(u.pm * 4 + pn) * 256 + rl) * 2), __ATOMIC_RELAXED, __HIP_MEMORY_SCOPE_AGENT);
                    t1 += __uint_as_float((unsigned)pv); t2 += __uint_as_float((unsigned)(pv >> 32)); }
                const float mean = t1 * (1.0f / 1024.0f); const float var = fmaxf(t2 * (1.0f / 1024.0f) - mean * mean, 0.f);
                stats[rl * 2] = mean; stats[rl * 2 + 1] = rsqrtf(var + LN_EPS); }
        }
        __syncthreads();
#pragma unroll
        for (int ai = 0; ai < 2; ++ai)
#pragma unroll
            for (int m = 0; m < 4; ++m) { const size_t r = (size_t)(row0 + ai * 128 + m * 16); const int rl = ai * 128 + wr * 64 + m * 16 + fr;
                const float mean = stats[rl * 2], rstd = stats[rl * 2 + 1];
#pragma unroll
                for (int bj = 0; bj < 2; ++bj)
#pragma unroll
                    for (int n = 0; n < 2; ++n) { const int c = col0 + bj * 128 + n * 16;
                        const f32x4 gv = *(const f32x4*)(gam + c), bv = *(const f32x4*)(bet + c);
                        const f32x4 y = (acc[ai][bj][m][n] - mean) * rstd * gv + bv;
                        if (MODE == 0) *(u32x2*)((unsigned short*)outp + r * 1024 + c) = (u32x2){cvt_pk_bf16(y[0], y[1]), cvt_pk_bf16(y[2], y[3])};
                        else *(f32x4*)((float*)outp + r * 1024 + c) = y; } }
    }
};
struct EpiZ {
    static constexpr bool PERM = true;
    unsigned short* z; int ld;
    __device__ __forceinline__ void operator()(const f32x4 (&acc)[2][2][4][2], const Unit& u, int wr, int wc, int fr, int fq) const {
        const int row0 = u.pm * 256 + wr * 64 + fr, col0 = u.pn * 256 + wc * 32 + 8 * fq;
#pragma unroll
        for (int ai = 0; ai < 2; ++ai)
#pragma unroll
            for (int m = 0; m < 4; ++m) { unsigned short* rowp = z + (size_t)(row0 + ai * 128 + m * 16) * ld + col0;
#pragma unroll
                for (int bj = 0; bj < 2; ++bj) { const f32x4 v0 = acc[ai][bj][m][0], v1 = acc[ai][bj][m][1];
                    *(u32x4*)(rowp + bj * 128) = (u32x4){cvt_pk_bf16(v0[0], v0[1]), cvt_pk_bf16(v0[2], v0[3]), cvt_pk_bf16(v1[0], v1[1]), cvt_pk_bf16(v1[2], v1[3])}; } }
    }
};

__device__ void transpose_convert(const float* __restrict__ src, unsigned short* __restrict__ dst, int K, int N, float* tile  , int ldd = 0) {
    if (ldd == 0) ldd = K;
    const int tid = threadIdx.x; const int nk = K / 64, nn = N / 64, ntile = nk * nn;
    const int r = tid >> 3, c = (tid & 7) * 8;
    f32x4 a, b;
    int t = blockIdx.x;
    if (t < ntile) { const int tk = t / nn, tn = t % nn; const float* p = src + (size_t)(tk * 64 + r) * N + tn * 64 + c; a = *(const f32x4*)p; b = *(const f32x4*)(p + 4); }
    for (; t < ntile; t += gridDim.x) {
        const int tk = t / nn, tn = t % nn;
        { float* q = tile + r * 65 + c; q[0] = a[0]; q[1] = a[1]; q[2] = a[2]; q[3] = a[3]; q[4] = b[0]; q[5] = b[1]; q[6] = b[2]; q[7] = b[3]; }
        __syncthreads();
        { const int t2 = t + gridDim.x;
          if (t2 < ntile) { const int tk2 = t2 / nn, tn2 = t2 % nn; const float* p = src + (size_t)(tk2 * 64 + r) * N + tn2 * 64 + c; a = *(const f32x4*)p; b = *(const f32x4*)(p + 4); } }
        { const int n = tid >> 3, k0 = (tid & 7) * 8; float v[8];
#pragma unroll
          for (int j = 0; j < 8; ++j) v[j] = tile[(k0 + j) * 65 + n];
          *(u32x4*)(dst + (size_t)(tn * 64 + n) * ldd + tk * 64 + k0) = (u32x4){cvt_pk_bf16(v[0], v[1]), cvt_pk_bf16(v[2], v[3]), cvt_pk_bf16(v[4], v[5]), cvt_pk_bf16(v[6], v[7])}; }
        __syncthreads();
    }
}
__device__ void phase_prep(const Params& p, unsigned char* lds_generic) {
    float* tile = (float*)lds_generic;
    unsigned char* ws = p.ws;
    { const size_t n8 = (size_t)T_TOK * DM / 8; unsigned short* xb = (unsigned short*)(ws + OFF_XB);
      const size_t stride = (size_t)gridDim.x * NTHREADS;
      for (size_t i = (size_t)blockIdx.x * NTHREADS + threadIdx.x; i < n8; i += 4 * stride) {
          f32x4 a[4], b[4];
#pragma unroll
          for (int j = 0; j < 4; ++j) { const size_t ii = i + j * stride; if (ii < n8) { a[j] = *(const f32x4*)(p.x + ii * 8); b[j] = *(const f32x4*)(p.x + ii * 8 + 4); } }
#pragma unroll
          for (int j = 0; j < 4; ++j) { const size_t ii = i + j * stride; if (ii < n8)
              *(u32x4*)(xb + ii * 8) = (u32x4){cvt_pk_bf16(a[j][0], a[j][1]), cvt_pk_bf16(a[j][2], a[j][3]), cvt_pk_bf16(b[j][0], b[j][1]), cvt_pk_bf16(b[j][2], b[j][3])}; } } }
    { float* cs = (float*)(ws + OFF_MISC);
      for (int i = blockIdx.x * NTHREADS + threadIdx.x; i < IN_COLS; i += gridDim.x * NTHREADS) {
          float v = 1.0f;
          if (i >= 2048 && i < 3072) { const int c = i - 2048; const float l0 = p.lb_logits[c], l1 = p.lb_logits[HG + c]; const float lb = 1.0f / (1.0f + expf(l1 - l0)); v = 1.0f - lb; }
          cs[i] = v; } }
    transpose_convert(p.w_in, (unsigned short*)(ws + OFF_WIN), DM, IN_COLS, tile);
    transpose_convert(p.w_conv_out, (unsigned short*)(ws + OFF_WCO), CONV_DIM, DM, tile, CONV_DIM + HG);
    transpose_convert(p.w_hgrn_out, (unsigned short*)(ws + OFF_WCO) + CONV_DIM, HG, DM, tile, CONV_DIM + HG);
    transpose_convert(p.w_out, (unsigned short*)(ws + OFF_WOUT), DM, DM, tile);
    transpose_convert(p.w_ffn_in, (unsigned short*)(ws + OFF_WFI), DM, 2 * DFF, tile);
    transpose_convert(p.w_ffn_out, (unsigned short*)(ws + OFF_WFO), DFF, DM, tile);
}

__device__ void phase_conv(const Params& p, unsigned char* lds) {
    unsigned short* gin = (unsigned short*)lds;
    float* obuf = (float*)(lds + 96256);
    const unsigned short* cvg = (const unsigned short*)(p.ws + OFF_CVG);
    unsigned short* cout = (unsigned short*)(p.ws + OFF_XB);
    const int tid = threadIdx.x, wid = tid >> 6, lane = tid & 63;
    float w[CONV_K];
#pragma unroll
    for (int k = 0; k < CONV_K; ++k) w[k] = p.w_conv_dw[k * CONV_DIM + tid];
    const float bias = p.b_conv_dw[tid];
    float lg[8], lb[8];
#pragma unroll
    for (int j = 0; j < 8; ++j) { lg[j] = p.conv_ln_g[lane * 8 + j]; lb[j] = p.conv_ln_b[lane * 8 + j]; }
    for (int tile = blockIdx.x; tile < T_TOK / 64; tile += gridDim.x) {
        const int t0 = tile * 64, pos0 = t0 % SEQ;
        __syncthreads();
#pragma unroll
        for (int it0 = 0; it0 < 12; it0 += 4) {
            u32x4 av[4], bv[4];
#pragma unroll
            for (int q = 0; q < 4; ++q) { const int i = tid + (it0 + q) * NTHREADS; const int row = i >> 6, c8 = (i & 63) * 8; const int pos = pos0 + row - 30;
                const bool valid = (i < 94 * 64) && (pos >= 0);
                const size_t tk = valid ? (size_t)(t0 + row - 30) : (size_t)t0;
                av[q] = *(const u32x4*)(cvg + tk * 1024 + c8); bv[q] = *(const u32x4*)(cvg + tk * 1024 + 512 + c8);
                if (!valid) { av[q] = (u32x4){0u, 0u, 0u, 0u}; bv[q] = av[q]; } }
#pragma unroll
            for (int q = 0; q < 4; ++q) { const int i = tid + (it0 + q) * NTHREADS; const int row = i >> 6, c8 = (i & 63) * 8;
                if (i < 94 * 64) { u32x4 o;
#pragma unroll
                    for (int j = 0; j < 4; ++j) o[j] = cvt_pk_bf16(bflo(av[q][j]) * bflo(bv[q][j]), bfhi(av[q][j]) * bfhi(bv[q][j]));
                    *(u32x4*)(gin + row * 512 + c8) = o; } }
        }
        __syncthreads();
        for (int rr = 0; rr < 4; ++rr) {
            float in[46];
#pragma unroll
            for (int j = 0; j < 46; ++j) in[j] = bf2f(gin[(rr * 16 + j) * 512 + tid]);
#pragma unroll
            for (int i = 0; i < 16; ++i) { float a = bias;
#pragma unroll
                for (int k = 0; k < CONV_K; ++k) a += w[k] * in[i + k];
                obuf[i * 512 + tid] = a; }
            __syncthreads();
#pragma unroll
            for (int q = 0; q < 2; ++q) { const int i = wid * 2 + q; const float* rp = obuf + i * 512 + lane * 8;
                const f32x4 a = *(const f32x4*)rp, b = *(const f32x4*)(rp + 4);
                float v[8] = {a[0], a[1], a[2], a[3], b[0], b[1], b[2], b[3]};
                float s = 0.f;
#pragma unroll
                for (int j = 0; j < 8; ++j) s += v[j];
                const float mean = wave_sum(s) * (1.0f / 512.0f);
                float ss = 0.f;
#pragma unroll
                for (int j = 0; j < 8; ++j) { v[j] -= mean; ss += v[j] * v[j]; }
                const float rstd = rsqrtf(wave_sum(ss) * (1.0f / 512.0f) + LN_EPS);
                float y[8];
#pragma unroll
                for (int j = 0; j < 8; ++j) { const float t = v[j] * rstd * lg[j] + lb[j]; y[j] = t * sigmoidf_(t); }
                *(u32x4*)(cout + (size_t)(t0 + rr * 16 + i) * 512 + lane * 8) = (u32x4){cvt_pk_bf16(y[0], y[1]), cvt_pk_bf16(y[2], y[3]), cvt_pk_bf16(y[4], y[5]), cvt_pk_bf16(y[6], y[7])}; }
            __syncthreads();
        }
    }
}

constexpr int H_QT = 0;
constexpr int H_KN = H_QT + 64 * 272;
constexpr int H_KT = H_KN + 64 * 272;
constexpr int H_VT = H_KT + 128 * 144;
constexpr int H_PP = H_VT + 128 * 144;
constexpr int H_SB = H_PP + 64 * 144;
constexpr int H_SEG = H_SB + 128 * 272;
constexpr int H_ER = H_SEG + 8192;
constexpr int H_EBL = H_ER + 512;
constexpr int H_SS = H_EBL + 512;
constexpr int H_END = H_SS + 2048;
static_assert(H_END <= LDS_BYTES, "hgrn lds");

template <bool OUT>
__device__ void hgrn_phase(const Params& p, unsigned char* lds, const int reps = 1) {
    const int tid = threadIdx.x, w = tid >> 6, lane = tid & 63, g = lane >> 4, c16 = lane & 15;
    const unsigned short* qg = (const unsigned short*)(p.ws + OFF_Q);
    const unsigned short* king = (const unsigned short*)(p.ws + OFF_KIN);
    const unsigned short* vg = (const unsigned short*)(p.ws + OFF_V);
    const unsigned short* gg = (const unsigned short*)(p.ws + OFF_G);
    unsigned short* og = (unsigned short*)(p.ws + OFF_CVG);
    float* segsum = (float*)(lds + H_SEG); float* er = (float*)(lds + H_ER); float* ebl = (float*)(lds + H_EBL); float* ssb = (float*)(lds + H_SS);
    const int kp = tid & 63;
    const int nchain = (256 - (int)blockIdx.x + (int)gridDim.x - 1) / (int)gridDim.x, nstep = nchain * 16 * reps;

    unsigned kraw[8], vraw[8], qraw[8];
    auto chunk_base = [&](int step) -> size_t {
        const int chain = blockIdx.x + ((step >> 4) % nchain) * gridDim.x, item = chain * 4 + ((step >> 2) & 3), c = step & 3;
        const int bh = item >> 5, sc = item & 31, b = bh >> 3, h = bh & 7;
        return ((size_t)b * SEQ + (size_t)sc * 256 + 64 * c + 8 * w) * 1024 + h * 128 + 2 * kp;
    };
    auto load_raw = [&](int step) {
        const size_t gbase = chunk_base(step);
#pragma unroll
        for (int tt = 0; tt < 8; ++tt) kraw[tt] = *(const unsigned*)(king + gbase + (size_t)tt * 1024);
#pragma unroll
        for (int tt = 0; tt < 8; ++tt) vraw[tt] = *(const unsigned*)(vg + gbase + (size_t)tt * 1024);
        if (OUT) {
#pragma unroll
            for (int tt = 0; tt < 8; ++tt) qraw[tt] = *(const unsigned*)(qg + gbase + (size_t)tt * 1024);
        }
    };
    float lf0[8], lf1[8], k0[8], k1[8];
    auto part1 = [&](int step) {
        float run0 = 0.f, run1 = 0.f;
#pragma unroll
        for (int tt = 0; tt < 8; ++tt) {
            const unsigned short lo = (unsigned short)(kraw[tt] & 0xffffu), hi = (unsigned short)(kraw[tt] >> 16);
            _Float16 hl, hh; __builtin_memcpy(&hl, &lo, 2); __builtin_memcpy(&hh, &hi, 2);
            k0[tt] = (float)hl; k1[tt] = (float)hh;
            run0 += __logf(1.0f - k0[tt]); lf0[tt] = run0; run1 += __logf(1.0f - k1[tt]); lf1[tt] = run1; }
        *(f32x2*)(segsum + (step & 1) * 1024 + w * 128 + 2 * kp) = (f32x2){run0, run1};
    };
    if (nstep > 0) { load_raw(0); part1(0); }

    f32x4 S[8];
    f32x4 gn = (f32x4){0.f, 0.f, 0.f, 0.f};
    float btot0 = 0.f, btot1 = 0.f;
    for (int step = 0; step < nstep; ++step) {
        const int chain = blockIdx.x + ((step >> 4) % nchain) * gridDim.x, jj = (step >> 2) & 3, item = chain * 4 + jj, c = step & 3;
        const int bh = item >> 5, sc = item & 31, b = bh >> 3, h = bh & 7;
        const size_t tc = (size_t)b * SEQ + (size_t)sc * 256 + 64 * c; const int ch0 = h * 128;
        unsigned short* Lg = (unsigned short*)(p.ws + OFF_L) + (size_t)chain * 16384;
        if (c == 0 && jj == 0) {
#pragma unroll
            for (int kt = 0; kt < 8; ++kt) {
                S[kt] = (f32x4){0.f, 0.f, 0.f, 0.f};
            }
            if (OUT) {
                const int nprev = chain & 7;
                for (int j = 0; j < nprev; ++j) {
                    const unsigned short* Lj = (const unsigned short*)(p.ws + OFF_L) + (size_t)((chain & ~7) + j) * 16384;
                    const float* Dj = (const float*)(p.ws + OFF_D) + (size_t)((chain & ~7) + j) * 128;
#pragma unroll
                    for (int kt = 0; kt < 8; ++kt) {
                        const u32x2 lv = *(const u32x2*)(Lj + (16 * w + c16) * 128 + 16 * kt + 4 * g);
                        const f32x4 dv = *(const f32x4*)(Dj + 16 * kt + 4 * g);
                        S[kt] = S[kt] * dv + (f32x4){bflo(lv[0]), bfhi(lv[0]), bflo(lv[1]), bfhi(lv[1])}; }
                }
            }
            if (OUT) gn = *(const f32x4*)(p.hgrn_norm_g + ch0 + 16 * w + 4 * g);
            btot0 = 0.f; btot1 = 0.f;
        }
        {
            __syncthreads();
            float off0 = 0.f, off1 = 0.f, r0 = 0.f, r1 = 0.f, bl0 = 0.f, bl1 = 0.f;
#pragma unroll
            for (int sg = 0; sg < 8; ++sg) { const f32x2 sv = *(const f32x2*)(segsum + (step & 1) * 1024 + sg * 128 + 2 * kp);
                if (sg < w) { off0 += sv[0]; off1 += sv[1]; }
                if (sg < 4) { r0 += sv[0]; r1 += sv[1]; }
                bl0 += sv[0]; bl1 += sv[1]; }
            unsigned short kb0[8], kb1[8];
#pragma unroll
            for (int tt = 0; tt < 8; ++tt) {
                const float b0 = off0 + lf0[tt], b1 = off1 + lf1[tt];
                const float kt0 = k0[tt] * __expf(fminf(r0 - b0, 80.f)), kt1 = k1[tt] * __expf(fminf(r1 - b1, 80.f));
                const unsigned kpk = cvt_pk_bf16(kt0, kt1);
                kb0[tt] = (unsigned short)(kpk & 0xffffu); kb1[tt] = (unsigned short)(kpk >> 16);
                if (OUT) {
                    *(unsigned*)(lds + H_KN + (8 * w + tt) * 272 + kp * 4) = kpk;
                    const float q0 = bflo(qraw[tt]) * __expf(fminf(b0 - r0, 80.f)), q1 = bfhi(qraw[tt]) * __expf(fminf(b1 - r1, 80.f));
                    *(unsigned*)(lds + H_QT + (8 * w + tt) * 272 + kp * 4) = cvt_pk_bf16(q0, q1);
                }
            }
            u32x4 ka, kbv, va, vb;
#pragma unroll
            for (int j = 0; j < 4; ++j) {
                ka[j] = (unsigned)kb0[2 * j] | ((unsigned)kb0[2 * j + 1] << 16);
                kbv[j] = (unsigned)kb1[2 * j] | ((unsigned)kb1[2 * j + 1] << 16);
                va[j] = (vraw[2 * j] & 0xffffu) | (vraw[2 * j + 1] << 16);
                vb[j] = (vraw[2 * j] >> 16) | (vraw[2 * j + 1] & 0xffff0000u); }
            *(u32x4*)(lds + H_KT + (2 * kp) * 144 + w * 16) = ka;
            *(u32x4*)(lds + H_KT + (2 * kp + 1) * 144 + w * 16) = kbv;
            *(u32x4*)(lds + H_VT + (2 * kp) * 144 + w * 16) = va;
            *(u32x4*)(lds + H_VT + (2 * kp + 1) * 144 + w * 16) = vb;
            if (w == 0) { *(f32x2*)(er + 2 * kp) = (f32x2){__expf(r0), __expf(r1)}; *(f32x2*)(ebl + 2 * kp) = (f32x2){__expf(bl0 - r0), __expf(bl1 - r1)}; btot0 += bl0; btot1 += bl1; }
        }
        __syncthreads();
        if (step + 1 < nstep) load_raw(step + 1);
#pragma unroll
        for (int kt = 0; kt < 8; ++kt) {
            const f32x4 e = *(const f32x4*)(er + 16 * kt + 4 * g);
            S[kt] = S[kt] * e;
            if (OUT) *(u32x2*)(lds + H_SB + (16 * w + c16) * 272 + (16 * kt + 4 * g) * 2) = (u32x2){cvt_pk_bf16(S[kt][0], S[kt][1]), cvt_pk_bf16(S[kt][2], S[kt][3])};
        }
        if (OUT) {
#pragma unroll
            for (int i = 0; i < 2; ++i) {
                const int id = 2 * w + i, st = id >> 2, tt = id & 3;
                f32x4 a4 = (f32x4){0.f, 0.f, 0.f, 0.f};
                if (st <= tt) {
#pragma unroll
                    for (int ks = 0; ks < 4; ++ks) {
                        const bf16x8 af = *(const bf16x8*)(lds + H_KN + (16 * st + c16) * 272 + (32 * ks + 8 * g) * 2);
                        const bf16x8 bf = *(const bf16x8*)(lds + H_QT + (16 * tt + c16) * 272 + (32 * ks + 8 * g) * 2);
                        a4 = __builtin_amdgcn_mfma_f32_16x16x32_bf16(af, bf, a4, 0, 0, 0);
                    }
                    const int tcol = 16 * tt + c16;
#pragma unroll
                    for (int r = 0; r < 4; ++r) { const int srow = 16 * st + 4 * g + r; if (srow > tcol) a4[r] = 0.f; }
                }
                *(u32x2*)(lds + H_PP + (16 * tt + c16) * 144 + (16 * st + 4 * g) * 2) = (u32x2){cvt_pk_bf16(a4[0], a4[1]), cvt_pk_bf16(a4[2], a4[3])};
            }
        }
        __syncthreads();
        f32x4 O[4];
        u32x2 gzv[4];
        if (OUT) {
#pragma unroll
            for (int tt = 0; tt < 4; ++tt) gzv[tt] = *(const u32x2*)(gg + (tc + 16 * tt + c16) * 1024 + ch0 + 16 * w + 4 * g);
        }
        if (OUT) {
#pragma unroll
            for (int tt = 0; tt < 4; ++tt) {
                f32x4 a4 = (f32x4){0.f, 0.f, 0.f, 0.f};
#pragma unroll
                for (int ks = 0; ks < 2; ++ks) {
                    const bf16x8 af = *(const bf16x8*)(lds + H_VT + (16 * w + c16) * 144 + (32 * ks + 8 * g) * 2);
                    const bf16x8 bf = *(const bf16x8*)(lds + H_PP + (16 * tt + c16) * 144 + (32 * ks + 8 * g) * 2);
                    a4 = __builtin_amdgcn_mfma_f32_16x16x32_bf16(af, bf, a4, 0, 0, 0);
                }
#pragma unroll
                for (int ks = 0; ks < 4; ++ks) {
                    const bf16x8 af = *(const bf16x8*)(lds + H_SB + (16 * w + c16) * 272 + (32 * ks + 8 * g) * 2);
                    const bf16x8 bf = *(const bf16x8*)(lds + H_QT + (16 * tt + c16) * 272 + (32 * ks + 8 * g) * 2);
                    a4 = __builtin_amdgcn_mfma_f32_16x16x32_bf16(af, bf, a4, 0, 0, 0);
                }
                O[tt] = a4;
            }
        }
#pragma unroll
        for (int kt = 0; kt < 8; ++kt) {
#pragma unroll
            for (int ks = 0; ks < 2; ++ks) {
                const bf16x8 af = *(const bf16x8*)(lds + H_KT + (16 * kt + c16) * 144 + (32 * ks + 8 * g) * 2);
                const bf16x8 bf = *(const bf16x8*)(lds + H_VT + (16 * w + c16) * 144 + (32 * ks + 8 * g) * 2);
                S[kt] = __builtin_amdgcn_mfma_f32_16x16x32_bf16(af, bf, S[kt], 0, 0, 0);
            }
            const f32x4 e = *(const f32x4*)(ebl + 16 * kt + 4 * g);
            S[kt] = S[kt] * e;
        }
        if (OUT) {
#pragma unroll
            for (int tt = 0; tt < 4; ++tt) {
                float s = O[tt][0] * O[tt][0] + O[tt][1] * O[tt][1] + O[tt][2] * O[tt][2] + O[tt][3] * O[tt][3];
                s += __shfl_xor(s, 16); s += __shfl_xor(s, 32);
                if (g == 0) ssb[w * 64 + 16 * tt + c16] = s;
            }
            __syncthreads();
#pragma unroll
            for (int tt = 0; tt < 4; ++tt) {
                const int t = 16 * tt + c16; float tot = 0.f;
#pragma unroll
                for (int ww = 0; ww < 8; ++ww) tot += ssb[ww * 64 + t];
                const float rs = rsqrtf(tot * (1.0f / 128.0f) + RMS_EPS);
                const size_t gi = (tc + t) * 1024 + ch0 + 16 * w + 4 * g;
                const u32x2 gz = gzv[tt];
                const float o0 = bf2f(f2bf(O[tt][0] * rs * gn[0])) * bflo(gz[0]), o1 = bf2f(f2bf(O[tt][1] * rs * gn[1])) * bfhi(gz[0]);
                const float o2 = bf2f(f2bf(O[tt][2] * rs * gn[2])) * bflo(gz[1]), o3 = bf2f(f2bf(O[tt][3] * rs * gn[3])) * bfhi(gz[1]);
                *(u32x2*)(og + gi) = (u32x2){cvt_pk_bf16(o0, o1), cvt_pk_bf16(o2, o3)};
            }
        }
        if (!OUT && c == 3 && jj == 3) {
            float* Dg = (float*)(p.ws + OFF_D) + (size_t)chain * 128;
#pragma unroll
            for (int kt = 0; kt < 8; ++kt)
                *(u32x2*)(Lg + (16 * w + c16) * 128 + 16 * kt + 4 * g) = (u32x2){cvt_pk_bf16(S[kt][0], S[kt][1]), cvt_pk_bf16(S[kt][2], S[kt][3])};
            if (w == 0) *(f32x2*)(Dg + 2 * kp) = (f32x2){__expf(btot0), __expf(btot1)};
        }
        if (step + 1 < nstep) part1(step + 1);
    }
    __syncthreads();
}

__device__ void phase_scan(const Params& p) {
    unsigned short* L = (unsigned short*)(p.ws + OFF_L); const float* D = (const float*)(p.ws + OFF_D);
    for (int i = blockIdx.x * NTHREADS + threadIdx.x; i < 32 * 4096; i += gridDim.x * NTHREADS) {
        const int bh = i >> 12, e4 = i & 4095, k0 = (e4 & 31) * 4;
        f32x4 carry = (f32x4){0.f, 0.f, 0.f, 0.f};
        u32x2 v[8]; f32x4 d[8];
#pragma unroll
        for (int s = 0; s < 8; ++s) { const int chain = bh * 8 + s; v[s] = *(const u32x2*)(L + (size_t)chain * 16384 + e4 * 4); d[s] = *(const f32x4*)(D + chain * 128 + k0); }
#pragma unroll
        for (int s = 0; s < 8; ++s) { const int chain = bh * 8 + s;
            *(u32x2*)(L + (size_t)chain * 16384 + e4 * 4) = (u32x2){cvt_pk_bf16(carry[0], carry[1]), cvt_pk_bf16(carry[2], carry[3])};
            const f32x4 lv = (f32x4){bflo(v[s][0]), bfhi(v[s][0]), bflo(v[s][1]), bfhi(v[s][1])};
            carry = carry * d[s] + lv; }
    }
}

__device__ void phase_ln(float* buf, const float* gam, const float* bet, unsigned short* copyb) {
    const int lane = threadIdx.x & 63, wv = blockIdx.x * 8 + (threadIdx.x >> 6), nw = gridDim.x * 8;
    f32x4 gv[4], bv[4];
#pragma unroll
    for (int i = 0; i < 4; ++i) { gv[i] = *(const f32x4*)(gam + i * 256 + lane * 4); bv[i] = *(const f32x4*)(bet + i * 256 + lane * 4); }
    for (int r = wv; r < T_TOK; r += nw) {
        float* rp = buf + (size_t)r * 1024;
        f32x4 v[4]; float s = 0.f;
#pragma unroll
        for (int i = 0; i < 4; ++i) { v[i] = *(const f32x4*)(rp + i * 256 + lane * 4); s += v[i][0] + v[i][1] + v[i][2] + v[i][3]; }
        const float mean = wave_sum(s) * (1.0f / 1024.0f);
        float ss = 0.f;
#pragma unroll
        for (int i = 0; i < 4; ++i) { v[i] = v[i] - mean; ss += v[i][0] * v[i][0] + v[i][1] * v[i][1] + v[i][2] * v[i][2] + v[i][3] * v[i][3]; }
        const float rstd = rsqrtf(wave_sum(ss) * (1.0f / 1024.0f) + LN_EPS);
#pragma unroll
        for (int i = 0; i < 4; ++i) { const f32x4 y = v[i] * rstd * gv[i] + bv[i];
            if (copyb) *(u32x2*)(copyb + (size_t)r * 1024 + i * 256 + lane * 4) = (u32x2){cvt_pk_bf16(y[0], y[1]), cvt_pk_bf16(y[2], y[3])};
            else *(f32x4*)(rp + i * 256 + lane * 4) = y; }
    }
}

__device__ __forceinline__ float gelu_tanh(float x) {
    const float y = 0.7978845608028654f * (x + 0.044715f * x * x * x);
    const float t = 1.0f - 2.0f * __builtin_amdgcn_rcpf(1.0f + __expf(2.0f * y));
    return 0.5f * x * (1.0f + t);
}
__device__ void phase_act(const Params& p) {
    unsigned short* z = (unsigned short*)(p.ws + OFF_Z);
    constexpr int NCG = DFF / 8, RUN = 16, NRUN = T_TOK / RUN;
    for (int i = blockIdx.x * NTHREADS + threadIdx.x; i < NCG * NRUN; i += gridDim.x * NTHREADS) {
        const int cgi = i % NCG, run = i / NCG; const int c = cgi * 8; const size_t t0 = (size_t)run * RUN;
        float w0[8], w1[8], w2[8], bb[8];
#pragma unroll
        for (int j = 0; j < 8; ++j) { w0[j] = p.w_ffn_dw[c + j]; w1[j] = p.w_ffn_dw[DFF + c + j]; w2[j] = p.w_ffn_dw[2 * DFF + c + j]; bb[j] = p.b_ffn_dw[c + j]; }
        float um2[8], um1[8];
        if ((t0 % SEQ) == 0) {
#pragma unroll
            for (int j = 0; j < 8; ++j) { um2[j] = 0.f; um1[j] = 0.f; }
        } else {
            const u32x4 a = *(const u32x4*)(z + (t0 - 2) * (2 * DFF) + c), b = *(const u32x4*)(z + (t0 - 1) * (2 * DFF) + c);
#pragma unroll
            for (int j = 0; j < 4; ++j) { um2[2 * j] = bflo(a[j]); um2[2 * j + 1] = bfhi(a[j]); um1[2 * j] = bflo(b[j]); um1[2 * j + 1] = bfhi(b[j]); }
        }
#pragma unroll 4
        for (int tt = 0; tt < RUN; ++tt) {
            unsigned short* rowp = z + (t0 + tt) * (2 * DFF);
            const u32x4 a = *(const u32x4*)(rowp + c), gq = *(const u32x4*)(rowp + DFF + c);
            float u[8], gvv[8], o[8];
#pragma unroll
            for (int j = 0; j < 4; ++j) { u[2 * j] = bflo(a[j]); u[2 * j + 1] = bfhi(a[j]); gvv[2 * j] = bflo(gq[j]); gvv[2 * j + 1] = bfhi(gq[j]); }
#pragma unroll
            for (int j = 0; j < 8; ++j) { const float cv = w0[j] * um2[j] + w1[j] * um1[j] + w2[j] * u[j] + bb[j]; o[j] = gelu_tanh(cv) * gvv[j]; um2[j] = um1[j]; um1[j] = u[j]; }
            *(u32x4*)(rowp + DFF + c) = (u32x4){cvt_pk_bf16(o[0], o[1]), cvt_pk_bf16(o[2], o[3]), cvt_pk_bf16(o[4], o[5]), cvt_pk_bf16(o[6], o[7])};
        }
    }
}


#define XB_TMO      128
#define XB_XCNT(j)  (256  + 64 * (j))
#define XB_XSUB(j)  (1280 + 64 * (j))
#define XB_XGEN(j)  (2304 + 64 * (j))
#define XB_TOP      3328
#define XB_TOPGEN   3392
#define XCD_BAR_WORDS 3456
#define XB_SPIN_CAP (1u << 22)
__device__ __forceinline__ unsigned xb_ld(unsigned* p)              { return __hip_atomic_load(p, __ATOMIC_RELAXED, __HIP_MEMORY_SCOPE_AGENT); }
__device__ __forceinline__ unsigned xb_add(unsigned* p, unsigned v) { return __hip_atomic_fetch_add(p, v, __ATOMIC_RELAXED, __HIP_MEMORY_SCOPE_AGENT); }
__device__ __forceinline__ unsigned xb_xcc_id() { return (unsigned)__builtin_amdgcn_s_getreg((3 << 11) | 20) & 0xFu; }
#define XB_SPIN(cond, bar) do { unsigned _sp = 0; while (cond) { __builtin_amdgcn_s_sleep(1); \
    if ((++_sp & 255u) == 0u) { if (xb_ld(&(bar)[XB_TMO])) break; if (_sp > XB_SPIN_CAP) { atomicAdd(&(bar)[XB_TMO], 1u); break; } } } } while (0)
struct XcdBarrier { unsigned* bar; unsigned x; volatile LAS unsigned* st; };
__device__ __forceinline__ XcdBarrier xcd_barrier_post(unsigned* bar, volatile LAS unsigned* st) {
    XcdBarrier b; b.bar = bar; b.x = xb_xcc_id(); b.st = st;
    if (threadIdx.x == 0) (void)xb_add(&bar[XB_XCNT(b.x)], 1u);
    return b;
}
__device__ __forceinline__ void xcd_barrier_complete(unsigned* bar, unsigned x, unsigned& nloc, unsigned& nx) {
    const unsigned G = gridDim.x * gridDim.y * gridDim.z;
    unsigned sum, cnt, mine, sp = 0u;
    for (;;) {
        sum = 0u; cnt = 0u; mine = 0u;
#pragma unroll
        for (unsigned j = 0; j < 16; ++j) { const unsigned c = xb_ld(&bar[XB_XCNT(j)]); sum += c; cnt += (c > 0u) ? 1u : 0u; mine = (j == x) ? c : mine; }
        if (sum == G) break;
        __builtin_amdgcn_s_sleep(1);
        if ((++sp & 255u) == 0u) { if (xb_ld(&bar[XB_TMO])) break; if (sp > XB_SPIN_CAP) { atomicAdd(&bar[XB_TMO], 1u); break; } }
    }
    nloc = mine > 0u ? mine : 1u; nx = cnt > 0u ? cnt : 1u;
}
__device__ __forceinline__ void xcd_barrier(const XcdBarrier& b) {
    asm volatile("s_waitcnt vmcnt(0)" ::: "memory");
    __syncthreads();
    if (threadIdx.x == 0) {
        unsigned* bar = b.bar;
        __builtin_amdgcn_s_waitcnt(0);
        unsigned nloc = b.st[0], nx = b.st[1];
        if (nloc == 0u) { xcd_barrier_complete(bar, b.x, nloc, nx); b.st[0] = nloc; b.st[1] = nx; }
        const unsigned old = xb_add(&bar[XB_XSUB(b.x)], 1u);
        const unsigned gen = old / nloc;
        if (old + 1u == (gen + 1u) * nloc) {
            __builtin_amdgcn_fence(__ATOMIC_RELEASE, "agent");
            asm volatile("s_waitcnt vmcnt(0)" ::: "memory");
            const unsigned og = xb_add(&bar[XB_TOP], 1u);
            const unsigned tg = og / nx;
            if (og + 1u == (tg + 1u) * nx) xb_add(&bar[XB_TOPGEN], 1u);
            else XB_SPIN(xb_ld(&bar[XB_TOPGEN]) == tg, bar);
            __builtin_amdgcn_fence(__ATOMIC_ACQUIRE, "agent");
            xb_add(&bar[XB_XGEN(b.x)], 1u);
            asm volatile("s_waitcnt vmcnt(0)" ::: "memory");
        } else {
            XB_SPIN(xb_ld(&bar[XB_XGEN(b.x)]) == gen, bar);
            __builtin_amdgcn_fence(__ATOMIC_ACQUIRE, "agent");
            asm volatile("s_waitcnt vmcnt(0)" ::: "memory");
        }
    }
    __syncthreads();
}

#ifndef PHASE_MASK
#define PHASE_MASK 0x1fff
#endif
#ifndef DUP_MASK
#define DUP_MASK 0
#endif
#define PHASE(n) if ((PHASE_MASK & (1 << (n))) && (ph_only < 0 || ph_only == (n))) for (int rep_ = 0; rep_ < 1 + ((DUP_MASK >> (n)) & 1); ++rep_)
#define SYNC() do { if (ph_only < 0) xcd_barrier(xb); } while (0)
__global__ void __launch_bounds__(NTHREADS, 2) fwd_megakernel(Params p, int ph_only) {
    extern __shared__ __attribute__((aligned(16))) unsigned char shm[];
    cg::grid_group grid = cg::this_grid();
    LAS unsigned char* lds3 = (LAS unsigned char*)shm;
    volatile LAS unsigned* xst = (volatile LAS unsigned*)(lds3 + LDS_BYTES - 16);
    if (threadIdx.x == 0) { xst[0] = 0u; xst[1] = 0u; }
    __syncthreads();
    const XcdBarrier xb = xcd_barrier_post((unsigned*)(p.ws + OFF_BAR), xst);
    PHASE(0) { phase_prep(p, shm); }
    if (ph_only == -12345) grid.sync();
    SYNC();
    PHASE(1) { pg8::StaticOrder S; S.init(T_TOK, IN_COLS, gridDim.x, blockIdx.x);
               pg8::Gemm g{(const bf16_t*)(p.ws + OFF_XB), (const bf16_t*)(p.ws + OFF_WIN), T_TOK, IN_COLS, DM, DM, nullptr, 0, 0};
               EpiProj e{p.ws, (unsigned short*)p.out, (const float*)(p.ws + OFF_MISC)}; pg8::gemm_phase(lds3, g, S, e); }
    SYNC();
    PHASE(2) { phase_conv(p, shm);
               hgrn_phase<false>(p, shm); }
    SYNC();
    PHASE(4) { hgrn_phase<true>(p, shm); }
    SYNC();
    PHASE(5) { pg8::StaticOrder S; S.init(T_TOK, DM, gridDim.x, blockIdx.x);
               pg8::Gemm g{(const bf16_t*)(p.ws + OFF_XB), (const bf16_t*)(p.ws + OFF_WCO), T_TOK, DM, CONV_DIM + HG, CONV_DIM, (const bf16_t*)(p.ws + OFF_CVG), HG, CONV_DIM / 64};
               EpiMix e{(const unsigned short*)p.out, (unsigned short*)(p.ws + OFF_V)}; pg8::gemm_phase<EpiMix, true>(lds3, g, S, e); }
    SYNC();
    PHASE(7) { pg8::StaticOrder S; S.init(T_TOK, DM, gridDim.x, blockIdx.x);
               pg8::Gemm g{(const bf16_t*)(p.ws + OFF_V), (const bf16_t*)(p.ws + OFF_WOUT), T_TOK, DM, DM, DM, nullptr, 0, 0};
               EpiLn<0> e{p.x, p.ws + OFF_G, p.ln1_g, p.ln1_b, (float*)(p.ws + OFF_PART7), (unsigned*)(p.ws + OFF_CNT), lds3 + 131072}; pg8::gemm_phase(lds3, g, S, e); }
    SYNC();
    PHASE(9) { pg8::StaticOrder S; S.init(T_TOK, 2 * DFF, gridDim.x, blockIdx.x);
               pg8::Gemm g{(const bf16_t*)(p.ws + OFF_G), (const bf16_t*)(p.ws + OFF_WFI), T_TOK, 2 * DFF, DM, DM, nullptr, 0, 0};
               EpiZ e{(unsigned short*)(p.ws + OFF_Z), 2 * DFF}; pg8::gemm_phase(lds3, g, S, e); }
    SYNC();
    PHASE(10) { phase_act(p); }
    SYNC();
    PHASE(11) { pg8::StaticOrder S; S.init(T_TOK, DM, gridDim.x, blockIdx.x);
                pg8::Gemm g{(const bf16_t*)(p.ws + OFF_Z) + DFF, (const bf16_t*)(p.ws + OFF_WFO), T_TOK, DM, DFF, 2 * DFF, nullptr, 0, 0};
                EpiLn<1> e{p.ws + OFF_G, p.out, p.ln2_g, p.ln2_b, (float*)(p.ws + OFF_PART11), (unsigned*)(p.ws + OFF_CNT) + 128 * 2 * 64, lds3 + 131072}; pg8::gemm_phase(lds3, g, S, e); }
}

extern "C" void kernel_launch(void* const* d_in, const int* in_sizes, int n_in, void* d_out, int out_size, void* d_ws, size_t ws_size, hipStream_t stream) {
    static int grid_blocks = 0;
    if (!grid_blocks) {
        int dev = 0, cus = 0, per_cu = 0;
        hipGetDevice(&dev);
        hipDeviceGetAttribute(&cus, hipDeviceAttributeMultiprocessorCount, dev);
        hipFuncSetAttribute((const void*)fwd_megakernel, hipFuncAttributeMaxDynamicSharedMemorySize, LDS_BYTES);
        hipOccupancyMaxActiveBlocksPerMultiprocessor(&per_cu, (const void*)fwd_megakernel, NTHREADS, LDS_BYTES);
        if (per_cu < 1) per_cu = 1;
        if (per_cu > 1) per_cu = 1;
        grid_blocks = cus * per_cu;
        if (ws_size < WS_NEED) fprintf(stderr, "kernel_launch: workspace too small: %zu < %zu\n", ws_size, (size_t)WS_NEED);
    }
    hipMemsetAsync((unsigned char*)d_ws + OFF_BAR, 0, ZERO_BYTES, stream);
    Params p{};
    p.x = (const float*)d_in[0]; p.w_in = (const float*)d_in[1]; p.w_conv_dw = (const float*)d_in[2]; p.b_conv_dw = (const float*)d_in[3];
    p.conv_ln_g = (const float*)d_in[4]; p.conv_ln_b = (const float*)d_in[5]; p.w_conv_out = (const float*)d_in[6]; p.lb_logits = (const float*)d_in[7];
    p.hgrn_norm_g = (const float*)d_in[8]; p.w_hgrn_out = (const float*)d_in[9]; p.w_out = (const float*)d_in[10]; p.ln1_g = (const float*)d_in[11];
    p.ln1_b = (const float*)d_in[12]; p.w_ffn_in = (const float*)d_in[13]; p.w_ffn_dw = (const float*)d_in[14]; p.b_ffn_dw = (const float*)d_in[15];
    p.w_ffn_out = (const float*)d_in[16]; p.ln2_g = (const float*)d_in[17]; p.ln2_b = (const float*)d_in[18];
    p.out = (float*)d_out; p.ws = (unsigned char*)d_ws;
#if defined(MULTI_LAUNCH)
    for (int ph = 0; ph < 13; ++ph) hipLaunchKernelGGL(fwd_megakernel, dim3(grid_blocks), dim3(NTHREADS), LDS_BYTES, stream, p, ph);
#else
    int ph_only = -1;
    void* args[] = {&p, &ph_only};
    hipError_t e = hipLaunchCooperativeKernel((const void*)fwd_megakernel, dim3(grid_blocks), dim3(NTHREADS), args, LDS_BYTES, stream);
    if (e != hipSuccess) fprintf(stderr, "cooperative launch failed: %s (grid %d)\n", hipGetErrorString(e), grid_blocks);
#endif
}
```

```cpp
#include <hip/hip_runtime.h>
#include <hip/hip_cooperative_groups.h>
#include <cstdio>
namespace cg = cooperative_groups;

#define LAS __attribute__((address_space(3)))
typedef unsigned short bf16_t;
typedef short bf16x8 __attribute__((ext_vector_type(8)));
typedef float f32x4 __attribute__((ext_vector_type(4)));
typedef float f32x2 __attribute__((ext_vector_type(2)));
typedef unsigned u32x4 __attribute__((ext_vector_type(4)));
typedef unsigned u32x2 __attribute__((ext_vector_type(2)));

constexpr int T_TOK = 32768, SEQ = 8192, DM = 1024, IN_COLS = 7168, CONV_DIM = 512, CONV_K = 31, HG = 1024, DFF = 2816;
constexpr float ALPHA = 1.189207115002721f;
constexpr float LN_EPS = 1e-5f, RMS_EPS = 1e-6f;
constexpr int NTHREADS = 512;
constexpr int LDS_BYTES = 140 * 1024;

constexpr size_t MiB = 1024ull * 1024ull;
constexpr size_t OFF_W    = 0;
constexpr size_t OFF_WIN  = OFF_W;
constexpr size_t OFF_WCO  = OFF_WIN + (size_t)IN_COLS * DM * 2;
constexpr size_t OFF_WHO  = OFF_WCO + (size_t)DM * CONV_DIM * 2;
constexpr size_t OFF_WOUT = OFF_WHO + (size_t)DM * HG * 2;
constexpr size_t OFF_WFI  = OFF_WOUT + (size_t)DM * DM * 2;
constexpr size_t OFF_WFO  = OFF_WFI + (size_t)2 * DFF * DM * 2;
constexpr size_t OFF_G    = 36 * MiB;
constexpr size_t OFF_Q    = 100 * MiB;
constexpr size_t OFF_KIN  = 164 * MiB;
constexpr size_t OFF_V    = 228 * MiB;
constexpr size_t OFF_XB   = 292 * MiB;
constexpr size_t OFF_CVG  = 356 * MiB;
constexpr size_t OFF_L    = 420 * MiB;
constexpr size_t OFF_D    = 484 * MiB;
constexpr size_t OFF_MISC = 485 * MiB;
constexpr size_t OFF_Z    = OFF_Q;
constexpr size_t OFF_PART7  = 486 * MiB;
constexpr size_t OFF_PART11 = 487 * MiB;
constexpr size_t OFF_BAR  = 489 * MiB;
constexpr size_t OFF_CNT  = OFF_BAR + 64 * 1024;
constexpr size_t ZERO_BYTES = 64 * 1024 + 2 * 128 * 2 * 256;
constexpr size_t WS_NEED  = 490 * MiB;

struct Params {
    const float* x; const float* w_in; const float* w_conv_dw; const float* b_conv_dw; const float* conv_ln_g; const float* conv_ln_b;
    const float* w_conv_out; const float* lb_logits; const float* hgrn_norm_g; const float* w_hgrn_out; const float* w_out;
    const float* ln1_g; const float* ln1_b; const float* w_ffn_in; const float* w_ffn_dw; const float* b_ffn_dw; const float* w_ffn_out;
    const float* ln2_g; const float* ln2_b;
    float* out; unsigned char* ws;
};

__device__ __forceinline__ unsigned cvt_pk_bf16(float lo, float hi) { unsigned r; asm("v_cvt_pk_bf16_f32 %0, %1, %2" : "=v"(r) : "v"(lo), "v"(hi)); return r; }
__device__ __forceinline__ float bf2f(unsigned short b) { return __uint_as_float(((unsigned)b) << 16); }
__device__ __forceinline__ float bflo(unsigned u) { return __uint_as_float(u << 16); }
__device__ __forceinline__ float bfhi(unsigned u) { return __uint_as_float(u & 0xffff0000u); }
__device__ __forceinline__ unsigned short f2bf(float f) { return (unsigned short)(cvt_pk_bf16(f, 0.f) & 0xffffu); }
__device__ __forceinline__ float sigmoidf_(float x) { return __builtin_amdgcn_rcpf(1.0f + __expf(-x)); }
__device__ __forceinline__ unsigned pk_f16(float lo, float hi) {
    _Float16 a = (_Float16)lo, b = (_Float16)hi; unsigned short ua, ub; __builtin_memcpy(&ua, &a, 2); __builtin_memcpy(&ub, &b, 2); return (unsigned)ua | ((unsigned)ub << 16); }
__device__ __forceinline__ float wave_sum(float v) {
#pragma unroll
    for (int o = 32; o >= 1; o >>= 1) v += __shfl_xor(v, o);
    return v; }

namespace pg8 {
constexpr int BM = 256, BK = 64, HALF = 128, HTB = HALF * BK * 2, STAGE_BYTES = 8 * HTB, NXCD = 8, WGM = 4;
__host__ __device__ __forceinline__ int lds_byte(int r, int c) { const int st = (r >> 4) * 2 + (c >> 5), rr = r & 15, cc = c & 31, ob = rr * 64 + cc * 2; return st * 1024 + (ob ^ (((ob >> 9) & 1) << 5)); }
__host__ __device__ __forceinline__ void stage_rc(int b, int& R, int& C) { const int st = b / 1024, sb = b % 1024, swz = sb ^ (((sb >> 9) & 1) << 5); R = (st >> 1) * 16 + swz / 64; C = (st & 1) * 32 + (swz % 64) / 2; }
__host__ __device__ __forceinline__ int perm32(int rho) { const int n = rho >> 4, i = rho & 15; return 8 * (i >> 2) + 4 * n + (i & 3); }
struct Unit { int pm, pn; };
struct Gemm { const bf16_t* A; const bf16_t* Bt; int M, N, K, lda; const bf16_t* A2; int lda2; int ksplit; };
struct StaticOrder {
    int nM, nN, nwg, G, c, reps;
    __device__ void init(int M, int N, int G_, int c_, int reps_ = 1) { nM = M / BM; nN = N / BM; nwg = nM * nN; G = G_; c = c_; reps = reps_; }
    __device__ bool next(int i, Unit& u) const {
        const int rounds = (nwg + G - 1) / G; if (i >= rounds * reps) return false;
        const long L = (long)(i % rounds) * G + c; if (L >= nwg) return false;
        int wgid = (int)L; { const int q = nwg / NXCD, r = nwg % NXCD, xcd = wgid % NXCD, off = wgid / NXCD; wgid = (xcd < r ? xcd * (q + 1) : r * (q + 1) + (xcd - r) * q) + off; }
        const int nig = WGM * nN, gid = wgid / nig, fm = gid * WGM, gsz = (nM - fm) < WGM ? (nM - fm) : WGM;
        u.pm = fm + ((wgid % nig) % gsz); u.pn = (wgid % nig) / gsz; return true;
    }
};

template <class Epi, bool DUAL = false>
__device__ __forceinline__ void gemm_phase(LAS unsigned char* lds, const Gemm g, const StaticOrder& S, Epi& E) {
    const int tid = threadIdx.x, wid = __builtin_amdgcn_readfirstlane(tid >> 6), lane = tid & 63, wr = wid >> 2, wc = wid & 3, fr = lane & 15, fq = lane >> 4;
    const int K = g.K, nt = K / BK, lda = g.lda, lda2 = g.lda2, ksplit = g.ksplit;
    unsigned voffA[2], voffA2[2], voffB[2];
#pragma unroll
    for (int i = 0; i < 2; ++i) { int R, C; stage_rc(tid * 16 + i * 8192, R, C); const int Rb = Epi::PERM ? ((R & ~31) + perm32(R & 31)) : R;
        voffA[i] = (unsigned)(R * lda + C) * 2u; voffA2[i] = DUAL ? (unsigned)(R * lda2 + C) * 2u : 0u; voffB[i] = (unsigned)(Rb * K + C) * 2u; }
    const size_t kstep = (size_t)(BK * 2);
    const size_t hstepA = (size_t)HALF * lda * 2, hstepA2 = (size_t)HALF * lda2 * 2, hstepB = (size_t)HALF * K * 2;
    const unsigned ldsw = (unsigned)wid * 1024u;
    const int aoff = lds_byte(wr * 64 + fr, fq * 8), boff = lds_byte(wc * 32 + fr, fq * 8);
#define PG8_SA(b, h) (((b) * 2 + (h)) * HTB)
#define PG8_SB(b, h) ((4 + (b) * 2 + (h)) * HTB)
    auto stA = [&](int bufoff, int pm, int kt, int half) {
        const char* base; unsigned v0, v1;
        if (DUAL && kt >= ksplit) { base = (const char*)g.A2 + (size_t)(2 * pm + half) * hstepA2 + (size_t)(kt - ksplit) * kstep; v0 = voffA2[0]; v1 = voffA2[1]; }
        else                      { base = (const char*)g.A  + (size_t)(2 * pm + half) * hstepA  + (size_t)kt * kstep;            v0 = voffA[0];  v1 = voffA[1]; }
        __builtin_amdgcn_global_load_lds((const unsigned*)(base + v0), (LAS unsigned*)(lds + bufoff + ldsw), 16, 0, 0);
        __builtin_amdgcn_global_load_lds((const unsigned*)(base + v1), (LAS unsigned*)(lds + bufoff + ldsw + 8192), 16, 0, 0);
    };
    auto stB = [&](int bufoff, int pn, int kt, int half) {
        const char* base = (const char*)g.Bt + (size_t)(2 * pn + half) * hstepB + (size_t)kt * kstep;
        __builtin_amdgcn_global_load_lds((const unsigned*)(base + voffB[0]), (LAS unsigned*)(lds + bufoff + ldsw), 16, 0, 0);
        __builtin_amdgcn_global_load_lds((const unsigned*)(base + voffB[1]), (LAS unsigned*)(lds + bufoff + ldsw + 8192), 16, 0, 0);
    };
#define PG8_LDA(dst, b, h) do { _Pragma("unroll") for (int m = 0; m < 4; ++m) _Pragma("unroll") for (int k = 0; k < 2; ++k) dst[m][k] = *(const LAS bf16x8*)(lds + PG8_SA(b, h) + aoff + m * 2048 + k * 1024); } while (0)
#define PG8_LDB(dst, b, h) do { _Pragma("unroll") for (int n = 0; n < 2; ++n) _Pragma("unroll") for (int k = 0; k < 2; ++k) dst[n][k] = *(const LAS bf16x8*)(lds + PG8_SB(b, h) + boff + n * 2048 + k * 1024); } while (0)
#define PG8_MMA(ai, bj, At, Bt) do { __builtin_amdgcn_s_setprio(1); _Pragma("unroll") for (int m = 0; m < 4; ++m) _Pragma("unroll") for (int n = 0; n < 2; ++n) _Pragma("unroll") for (int k = 0; k < 2; ++k) \
        acc[ai][bj][m][n] = __builtin_amdgcn_mfma_f32_16x16x32_bf16(Bt[n][k], At[m][k], acc[ai][bj][m][n], 0, 0, 0); __builtin_amdgcn_s_setprio(0); } while (0)
#define PG8_WAIT_V(n) asm volatile("s_waitcnt vmcnt(" #n ")" ::: "memory")
#define PG8_WAIT_L(n) asm volatile("s_waitcnt lgkmcnt(" #n ")" ::: "memory")
#define PG8_BAR __builtin_amdgcn_s_barrier()
#define PG8_SCHED __builtin_amdgcn_sched_barrier(0)
    Unit cur, nxt; int ui = 0;
    if (!S.next(0, cur)) return;
    f32x4 acc[2][2][4][2];
#pragma unroll
    for (int a = 0; a < 2; ++a)
#pragma unroll
        for (int b = 0; b < 2; ++b)
#pragma unroll
            for (int m = 0; m < 4; ++m)
#pragma unroll
                for (int n = 0; n < 2; ++n) acc[a][b][m][n] = (f32x4){0.f, 0.f, 0.f, 0.f};
    bf16x8 At[4][2], B0[2][2], B1[2][2];
    stB(PG8_SB(0, 0), cur.pn, 0, 0); stA(PG8_SA(0, 0), cur.pm, 0, 0); stB(PG8_SB(0, 1), cur.pn, 0, 1); stA(PG8_SA(0, 1), cur.pm, 0, 1);
    if (wr == 1) PG8_BAR;
    PG8_WAIT_V(4); PG8_BAR;
    stB(PG8_SB(1, 0), cur.pn, 1, 0); stA(PG8_SA(1, 0), cur.pm, 1, 0); stB(PG8_SB(1, 1), cur.pn, 1, 1);
    PG8_WAIT_V(6); PG8_BAR;
    for (;;) {
        const bool has_next = S.next(ui + 1, nxt);
        const int npm = has_next ? nxt.pm : cur.pm, npn = has_next ? nxt.pn : cur.pn;
        for (int t = 0; t < nt; t += 2) {
            const bool last = (t == nt - 2);
            const int pm2 = last ? npm : cur.pm, pn2 = last ? npn : cur.pn, k2 = last ? 0 : t + 2, k3 = k2 + 1;
            if constexpr (DUAL) { if (t == ksplit) E.mid(acc, cur, wr, wc, fr, fq); }
            PG8_LDB(B0, 0, 0); PG8_SCHED; PG8_LDA(At, 0, 0); stA(PG8_SA(1, 1), cur.pm, t + 1, 1);
            PG8_WAIT_L(8); PG8_BAR; PG8_WAIT_L(0); PG8_MMA(0, 0, At, B0); PG8_BAR; PG8_SCHED;
            PG8_LDB(B1, 0, 1); stB(PG8_SB(0, 0), pn2, k2, 0);
            PG8_BAR; PG8_WAIT_L(0); PG8_MMA(0, 1, At, B1); PG8_BAR;
            PG8_LDA(At, 0, 1); stA(PG8_SA(0, 0), pm2, k2, 0);
            PG8_BAR; PG8_WAIT_L(0); PG8_MMA(1, 0, At, B0); PG8_BAR; PG8_SCHED;
            stB(PG8_SB(0, 1), pn2, k2, 1);
            PG8_WAIT_V(6); PG8_BAR; PG8_MMA(1, 1, At, B1); PG8_BAR;
            PG8_LDB(B0, 1, 0); PG8_SCHED; PG8_LDA(At, 1, 0); stA(PG8_SA(0, 1), pm2, k2, 1);
            PG8_WAIT_L(8); PG8_BAR; PG8_WAIT_L(0); PG8_MMA(0, 0, At, B0); PG8_BAR; PG8_SCHED;
            PG8_LDB(B1, 1, 1); stB(PG8_SB(1, 0), pn2, k3, 0);
            PG8_BAR; PG8_WAIT_L(0); PG8_MMA(0, 1, At, B1); PG8_BAR;
            PG8_LDA(At, 1, 1); stA(PG8_SA(1, 0), pm2, k3, 0);
            PG8_BAR; PG8_WAIT_L(0); PG8_MMA(1, 0, At, B0); PG8_BAR; PG8_SCHED;
            stB(PG8_SB(1, 1), pn2, k3, 1);
            PG8_WAIT_V(6); PG8_BAR; PG8_MMA(1, 1, At, B1); PG8_BAR;
        }
        E(acc, cur, wr, wc, fr, fq);
        if (!has_next) break;
#pragma unroll
        for (int a = 0; a < 2; ++a)
#pragma unroll
            for (int b = 0; b < 2; ++b)
#pragma unroll
                for (int m = 0; m < 4; ++m)
#pragma unroll
                    for (int n = 0; n < 2; ++n) acc[a][b][m][n] = (f32x4){0.f, 0.f, 0.f, 0.f};
        cur = nxt; ++ui;
    }
    PG8_WAIT_V(0);
    if (wr == 0) PG8_BAR;
    PG8_BAR;
#undef PG8_SA
#undef PG8_SB
#undef PG8_LDA
#undef PG8_LDB
#undef PG8_MMA
#undef PG8_WAIT_V
#undef PG8_WAIT_L
#undef PG8_BAR
#undef PG8_SCHED
}
}
using pg8::Unit;

struct EpiProj {
    static constexpr bool PERM = true;
    unsigned char* ws; unsigned short* mgate; const float* colscale;
    __device__ __forceinline__ void operator()(const f32x4 (&acc)[2][2][4][2], const Unit& u, int wr, int wc, int fr, int fq) const {
        const int pn = u.pn;
        unsigned short* base; int ld, colt; float c0, c1, c2, sgn; bool f16 = false;
        if (pn < 4)       { base = (unsigned short*)(ws + OFF_CVG); ld = 1024; colt = pn * 256; if (pn < 2) { c0 = 1.f; c1 = 0.f; c2 = 0.f; } else { c0 = 0.f; c1 = 1.f; c2 = 0.f; } sgn = 1.f; }
        else if (pn < 8)  { base = (unsigned short*)(ws + OFF_Q);   ld = 1024; colt = (pn - 4) * 256;  c0 = 0.f; c1 = 0.f; c2 = 1.f; sgn = 1.f; }
        else if (pn < 12) { base = (unsigned short*)(ws + OFF_KIN); ld = 1024; colt = (pn - 8) * 256;  c0 = 0.f; c1 = 1.f; c2 = 0.f; sgn = -1.f; f16 = true; }
        else if (pn < 16) { base = (unsigned short*)(ws + OFF_V);   ld = 1024; colt = (pn - 12) * 256; c0 = 1.f; c1 = 0.f; c2 = 0.f; sgn = 1.f; }
        else if (pn < 20) { base = (unsigned short*)(ws + OFF_G);   ld = 1024; colt = (pn - 16) * 256; c0 = 0.f; c1 = 0.f; c2 = 1.f; sgn = 1.f; }
        else              { base = mgate;                           ld = 2048; colt = (pn - 20) * 256; c0 = 0.f; c1 = 1.f; c2 = 0.f; sgn = 1.f; }
        const int row0 = u.pm * 256 + wr * 64 + fr, coll = wc * 32 + 8 * fq;
        f32x4 cs[2][2];
#pragma unroll
        for (int bj = 0; bj < 2; ++bj)
#pragma unroll
            for (int n = 0; n < 2; ++n) cs[bj][n] = f16 ? *(const f32x4*)(colscale + pn * 256 + bj * 128 + coll + 4 * n) : (f32x4){1.f, 1.f, 1.f, 1.f};
#pragma unroll
        for (int ai = 0; ai < 2; ++ai)
#pragma unroll
            for (int m = 0; m < 4; ++m) {
                unsigned short* rowp = base + (size_t)(row0 + ai * 128 + m * 16) * ld + colt + coll;
#pragma unroll
                for (int bj = 0; bj < 2; ++bj) {
                    float o[8];
#pragma unroll
                    for (int n = 0; n < 2; ++n)
#pragma unroll
                        for (int j = 0; j < 4; ++j) { const float z = acc[ai][bj][m][n][j]; const float s = __builtin_amdgcn_rcpf(1.0f + __expf(-sgn * z)); o[n * 4 + j] = (c0 * z + s * (c1 + c2 * z)) * cs[bj][n][j]; }
                    const u32x4 pkh = (u32x4){pk_f16(o[0], o[1]), pk_f16(o[2], o[3]), pk_f16(o[4], o[5]), pk_f16(o[6], o[7])};
                    const u32x4 pkb = (u32x4){cvt_pk_bf16(o[0], o[1]), cvt_pk_bf16(o[2], o[3]), cvt_pk_bf16(o[4], o[5]), cvt_pk_bf16(o[6], o[7])};
                    u32x4 pk;
#pragma unroll
                    for (int q = 0; q < 4; ++q) pk[q] = f16 ? pkh[q] : pkb[q];
                    *(u32x4*)(rowp + bj * 128) = pk;
                }
            }
    }
};
struct EpiMix {
    static constexpr bool PERM = false;
    const unsigned short* mgate; unsigned short* mixed;
    __device__ __forceinline__ void mid(f32x4 (&acc)[2][2][4][2], const Unit& u, int wr, int wc, int fr, int fq) const {
        const int row0 = u.pm * 256 + wr * 64 + fr, col0 = u.pn * 256 + wc * 32 + 4 * fq;
#pragma unroll
        for (int ai = 0; ai < 2; ++ai)
#pragma unroll
            for (int m = 0; m < 4; ++m) { const size_t r = (size_t)(row0 + ai * 128 + m * 16);
#pragma unroll
                for (int bj = 0; bj < 2; ++bj)
#pragma unroll
                    for (int n = 0; n < 2; ++n) { const int c = col0 + bj * 128 + n * 16;
                        const u32x2 ga = *(const u32x2*)(mgate + r * 2048 + c), gb = *(const u32x2*)(mgate + r * 2048 + 1024 + c);
                        acc[ai][bj][m][n][0] *= bflo(ga[0]) * __builtin_amdgcn_rcpf(bflo(gb[0])); acc[ai][bj][m][n][1] *= bfhi(ga[0]) * __builtin_amdgcn_rcpf(bfhi(gb[0]));
                        acc[ai][bj][m][n][2] *= bflo(ga[1]) * __builtin_amdgcn_rcpf(bflo(gb[1])); acc[ai][bj][m][n][3] *= bfhi(ga[1]) * __builtin_amdgcn_rcpf(bfhi(gb[1])); } }
    }
    __device__ __forceinline__ void operator()(const f32x4 (&acc)[2][2][4][2], const Unit& u, int wr, int wc, int fr, int fq) const {
        const int row0 = u.pm * 256 + wr * 64 + fr, col0 = u.pn * 256 + wc * 32 + 4 * fq;
#pragma unroll
        for (int ai = 0; ai < 2; ++ai)
#pragma unroll
            for (int m = 0; m < 4; ++m) { const size_t r = (size_t)(row0 + ai * 128 + m * 16);
#pragma unroll
                for (int bj = 0; bj < 2; ++bj)
#pragma unroll
                    for (int n = 0; n < 2; ++n) { const int c = col0 + bj * 128 + n * 16;
                        const u32x2 gb = *(const u32x2*)(mgate + r * 2048 + 1024 + c);
                        const f32x4 v = acc[ai][bj][m][n];
                        *(u32x2*)(mixed + r * 1024 + c) = (u32x2){cvt_pk_bf16(v[0] * bflo(gb[0]), v[1] * bfhi(gb[0])), cvt_pk_bf16(v[2] * bflo(gb[1]), v[3] * bfhi(gb[1]))}; } }
    }
};
struct EpiRes {
    static constexpr bool PERM = false;
    const float* res; float* dst;
    __device__ __forceinline__ void operator()(const f32x4 (&acc)[2][2][4][2], const Unit& u, int wr, int wc, int fr, int fq) const {
        const int row0 = u.pm * 256 + wr * 64 + fr, col0 = u.pn * 256 + wc * 32 + 4 * fq;
#pragma unroll
        for (int ai = 0; ai < 2; ++ai)
#pragma unroll
            for (int m = 0; m < 4; ++m) { const size_t r = (size_t)(row0 + ai * 128 + m * 16);
#pragma unroll
                for (int bj = 0; bj < 2; ++bj)
#pragma unroll
                    for (int n = 0; n < 2; ++n) { const int c = col0 + bj * 128 + n * 16;
                        const f32x4 t = *(const f32x4*)(res + r * 1024 + c);
                        *(f32x4*)(dst + r * 1024 + c) = t * ALPHA + acc[ai][bj][m][n]; } }
    }
};
struct EpiResB {
    static constexpr bool PERM = false;
    const unsigned short* res; float* dst;
    __device__ __forceinline__ void operator()(const f32x4 (&acc)[2][2][4][2], const Unit& u, int wr, int wc, int fr, int fq) const {
        const int row0 = u.pm * 256 + wr * 64 + fr, col0 = u.pn * 256 + wc * 32 + 4 * fq;
#pragma unroll
        for (int ai = 0; ai < 2; ++ai)
#pragma unroll
            for (int m = 0; m < 4; ++m) { const size_t r = (size_t)(row0 + ai * 128 + m * 16);
#pragma unroll
                for (int bj = 0; bj < 2; ++bj)
#pragma unroll
                    for (int n = 0; n < 2; ++n) { const int c = col0 + bj * 128 + n * 16;
                        const u32x2 t = *(const u32x2*)(res + r * 1024 + c);
                        const f32x4 tv = (f32x4){bflo(t[0]), bfhi(t[0]), bflo(t[1]), bfhi(t[1])};
                        *(f32x4*)(dst + r * 1024 + c) = tv * ALPHA + acc[ai][bj][m][n]; } }
    }
};
template <int MODE  > struct EpiLn {
    static constexpr bool PERM = false;
    const void* res; void* outp; const float* gam; const float* bet; float* part; unsigned* cnt; LAS unsigned char* ldsx;
    __device__ __forceinline__ void operator()(f32x4 (&acc)[2][2][4][2], const Unit& u, int wr, int wc, int fr, int fq) const {
        const int row0 = u.pm * 256 + wr * 64 + fr, col0 = u.pn * 256 + wc * 32 + 4 * fq;
        LAS float* red = (LAS float*)ldsx;
        LAS float* stats = (LAS float*)(ldsx + 8192);
#pragma unroll
        for (int ai = 0; ai < 2; ++ai)
#pragma unroll
            for (int m = 0; m < 4; ++m) { const size_t r = (size_t)(row0 + ai * 128 + m * 16);
                float s1 = 0.f, s2 = 0.f;
#pragma unroll
                for (int bj = 0; bj < 2; ++bj)
#pragma unroll
                    for (int n = 0; n < 2; ++n) { const int c = col0 + bj * 128 + n * 16;
                        f32x4 tv;
                        if (MODE == 0) tv = *(const f32x4*)((const float*)res + r * 1024 + c);
                        else { const u32x2 t = *(const u32x2*)((const unsigned short*)res + r * 1024 + c); tv = (f32x4){bflo(t[0]), bfhi(t[0]), bflo(t[1]), bfhi(t[1])}; }
                        const f32x4 v = tv * ALPHA + acc[ai][bj][m][n];
                        acc[ai][bj][m][n] = v;
                        s1 += v[0] + v[1] + v[2] + v[3]; s2 += v[0] * v[0] + v[1] * v[1] + v[2] * v[2] + v[3] * v[3]; }
                s1 += __shfl_xor(s1, 16); s1 += __shfl_xor(s1, 32); s2 += __shfl_xor(s2, 16); s2 += __shfl_xor(s2, 32);
                if (fq == 0) { const int rl = ai * 128 + wr * 64 + m * 16 + fr; red[(rl * 4 + wc) * 2] = s1; red[(rl * 4 + wc) * 2 + 1] = s2; } }
        __syncthreads();
        if (wc == 0) {
            const int lane = fq * 16 + fr;
            unsigned* cw = cnt + (size_t)(u.pm * 2 + wr) * 64;
            float* mypart = part + ((size_t)(u.pm * 4 + u.pn) * 256) * 2;
#pragma unroll
            for (int q = 0; q < 2; ++q) { const int i = lane + 64 * q, rl = (i >> 6) * 128 + wr * 64 + (i & 63);
                float t1 = 0.f, t2 = 0.f;
#pragma unroll
                for (int w4 = 0; w4 < 4; ++w4) { t1 += red[(rl * 4 + w4) * 2]; t2 += red[(rl * 4 + w4) * 2 + 1]; }
                const unsigned long long pv = (unsigned long long)__float_as_uint(t1) | ((unsigned long long)__float_as_uint(t2) << 32);
                __hip_atomic_store((unsigned long long*)(mypart + rl * 2), pv, __ATOMIC_RELAXED, __HIP_MEMORY_SCOPE_AGENT); }
            asm volatile("s_waitcnt vmcnt(0)" ::: "memory");
            if (lane == 0) (void)__hip_atomic_fetch_add(cw, 1u, __ATOMIC_RELAXED, __HIP_MEMORY_SCOPE_AGENT);
            { unsigned sp = 0;
              while ((unsigned)__builtin_amdgcn_readfirstlane(__hip_atomic_load(cw, __ATOMIC_RELAXED, __HIP_MEMORY_SCOPE_AGENT)) < 4u) { __builtin_amdgcn_s_sleep(1); if (++sp > (1u << 22)) break; } }
            asm volatile("" ::: "memory");
#pragma unroll
            for (int q = 0; q < 2; ++q) { const int i = lane + 64 * q, rl = (i >> 6) * 128 + wr * 64 + (i & 63);
                float t1 = 0.f, t2 = 0.f;
#pragma unroll
                for (int pn = 0; pn < 4; ++pn) { const unsigned long long pv = __hip_atomic_load((unsigned long long*)(part + ((size_t)(u.pm * 4 + pn) * 256 + rl) * 2), __ATOMIC_RELAXED, __HIP_MEMORY_SCOPE_AGENT);
                    t1 += __uint_as_float((unsigned)pv); t2 += __uint_as_float((unsigned)(pv >> 32)); }
                const float mean = t1 * (1.0f / 1024.0f); const float var = fmaxf(t2 * (1.0f / 1024.0f) - mean * mean, 0.f);
                stats[rl * 2] = mean; stats[rl * 2 + 1] = rsqrtf(var + LN_EPS); }
        }
        __syncthreads();
#pragma unroll
        for (int ai = 0; ai < 2; ++ai)
#pragma unroll
            for (int m = 0; m < 4; ++m) { const size_t r = (size_t)(row0 + ai * 128 + m * 16); const int rl = ai * 128 + wr * 64 + m * 16 + fr;
                const float mean = stats[rl * 2], rstd = stats[rl * 2 + 1];
#pragma unroll
                for (int bj = 0; bj < 2; ++bj)
#pragma unroll
                    for (int n = 0; n < 2; ++n) { const int c = col0 + bj * 128 + n * 16;
                        const f32x4 gv = *(const f32x4*)(gam + c), bv = *(const f32x4*)(bet + c);
                        const f32x4 y = (acc[ai][bj][m][n] - mean) * rstd * gv + bv;
                        if (MODE == 0) *(u32x2*)((unsigned short*)outp + r * 1024 + c) = (u32x2){cvt_pk_bf16(y[0], y[1]), cvt_pk_bf16(y[2], y[3])};
                        else *(f32x4*)((float*)outp + r * 1024 + c) = y; } }
    }
};
struct EpiZ {
    static constexpr bool PERM = true;
    unsigned short* z; int ld;
    __device__ __forceinline__ void operator()(const f32x4 (&acc)[2][2][4][2], const Unit& u, int wr, int wc, int fr, int fq) const {
        const int row0 = u.pm * 256 + wr * 64 + fr, col0 = u.pn * 256 + wc * 32 + 8 * fq;
#pragma unroll
        for (int ai = 0; ai < 2; ++ai)
#pragma unroll
            for (int m = 0; m < 4; ++m) { unsigned short* rowp = z + (size_t)(row0 + ai * 128 + m * 16) * ld + col0;
#pragma unroll
                for (int bj = 0; bj < 2; ++bj) { const f32x4 v0 = acc[ai][bj][m][0], v1 = acc[ai][bj][m][1];
                    *(u32x4*)(rowp + bj * 128) = (u32x4){cvt_pk_bf16(v0[0], v0[1]), cvt_pk_bf16(v0[2], v0[3]), cvt_pk_bf16(v1[0], v1[1]), cvt_pk_bf16(v1[2], v1[3])}; } }
    }
};

__device__ void transpose_convert(const float* __restrict__ src, unsigned short* __restrict__ dst, int K, int N, float* tile  , int ldd = 0) {
    if (ldd == 0) ldd = K;
    const int tid = threadIdx.x; const int nk = K / 64, nn = N / 64, ntile = nk * nn;
    const int r = tid >> 3, c = (tid & 7) * 8;
    f32x4 a, b;
    int t = blockIdx.x;
    if (t < ntile) { const int tk = t / nn, tn = t % nn; const float* p = src + (size_t)(tk * 64 + r) * N + tn * 64 + c; a = *(const f32x4*)p; b = *(const f32x4*)(p + 4); }
    for (; t < ntile; t += gridDim.x) {
        const int tk = t / nn, tn = t % nn;
        { float* q = tile + r * 65 + c; q[0] = a[0]; q[1] = a[1]; q[2] = a[2]; q[3] = a[3]; q[4] = b[0]; q[5] = b[1]; q[6] = b[2]; q[7] = b[3]; }
        __syncthreads();
        { const int t2 = t + gridDim.x;
          if (t2 < ntile) { const int tk2 = t2 / nn, tn2 = t2 % nn; const float* p = src + (size_t)(tk2 * 64 + r) * N + tn2 * 64 + c; a = *(const f32x4*)p; b = *(const f32x4*)(p + 4); } }
        { const int n = tid >> 3, k0 = (tid & 7) * 8; float v[8];
#pragma unroll
          for (int j = 0; j < 8; ++j) v[j] = tile[(k0 + j) * 65 + n];
          *(u32x4*)(dst + (size_t)(tn * 64 + n) * ldd + tk * 64 + k0) = (u32x4){cvt_pk_bf16(v[0], v[1]), cvt_pk_bf16(v[2], v[3]), cvt_pk_bf16(v[4], v[5]), cvt_pk_bf16(v[6], v[7])}; }
        __syncthreads();
    }
}
__device__ void phase_prep(const Params& p, unsigned char* lds_generic) {
    float* tile = (float*)lds_generic;
    unsigned char* ws = p.ws;
    { const size_t n8 = (size_t)T_TOK * DM / 8; unsigned short* xb = (unsigned short*)(ws + OFF_XB);
      const size_t stride = (size_t)gridDim.x * NTHREADS;
      for (size_t i = (size_t)blockIdx.x * NTHREADS + threadIdx.x; i < n8; i += 4 * stride) {
          f32x4 a[4], b[4];
#pragma unroll
          for (int j = 0; j < 4; ++j) { const size_t ii = i + j * stride; if (ii < n8) { a[j] = *(const f32x4*)(p.x + ii * 8); b[j] = *(const f32x4*)(p.x + ii * 8 + 4); } }
#pragma unroll
          for (int j = 0; j < 4; ++j) { const size_t ii = i + j * stride; if (ii < n8)
              *(u32x4*)(xb + ii * 8) = (u32x4){cvt_pk_bf16(a[j][0], a[j][1]), cvt_pk_bf16(a[j][2], a[j][3]), cvt_pk_bf16(b[j][0], b[j][1]), cvt_pk_bf16(b[j][2], b[j][3])}; } } }
    { float* cs = (float*)(ws + OFF_MISC);
      for (int i = blockIdx.x * NTHREADS + threadIdx.x; i < IN_COLS; i += gridDim.x * NTHREADS) {
          float v = 1.0f;
          if (i >= 2048 && i < 3072) { const int c = i - 2048; const float l0 = p.lb_logits[c], l1 = p.lb_logits[HG + c]; const float lb = 1.0f / (1.0f + expf(l1 - l0)); v = 1.0f - lb; }
          cs[i] = v; } }
    transpose_convert(p.w_in, (unsigned short*)(ws + OFF_WIN), DM, IN_COLS, tile);
    transpose_convert(p.w_conv_out, (unsigned short*)(ws + OFF_WCO), CONV_DIM, DM, tile, CONV_DIM + HG);
    transpose_convert(p.w_hgrn_out, (unsigned short*)(ws + OFF_WCO) + CONV_DIM, HG, DM, tile, CONV_DIM + HG);
    transpose_convert(p.w_out, (unsigned short*)(ws + OFF_WOUT), DM, DM, tile);
    transpose_convert(p.w_ffn_in, (unsigned short*)(ws + OFF_WFI), DM, 2 * DFF, tile);
    transpose_convert(p.w_ffn_out, (unsigned short*)(ws + OFF_WFO), DFF, DM, tile);
}

__device__ void phase_conv(const Params& p, unsigned char* lds) {
    unsigned short* gin = (unsigned short*)lds;
    float* obuf = (float*)(lds + 96256);
    const unsigned short* cvg = (const unsigned short*)(p.ws + OFF_CVG);
    unsigned short* cout = (unsigned short*)(p.ws + OFF_XB);
    const int tid = threadIdx.x, wid = tid >> 6, lane = tid & 63;
    float w[CONV_K];
#pragma unroll
    for (int k = 0; k < CONV_K; ++k) w[k] = p.w_conv_dw[k * CONV_DIM + tid];
    const float bias = p.b_conv_dw[tid];
    float lg[8], lb[8];
#pragma unroll
    for (int j = 0; j < 8; ++j) { lg[j] = p.conv_ln_g[lane * 8 + j]; lb[j] = p.conv_ln_b[lane * 8 + j]; }
    for (int tile = blockIdx.x; tile < T_TOK / 64; tile += gridDim.x) {
        const int t0 = tile * 64, pos0 = t0 % SEQ;
        __syncthreads();
#pragma unroll
        for (int it0 = 0; it0 < 12; it0 += 4) {
            u32x4 av[4], bv[4];
#pragma unroll
            for (int q = 0; q < 4; ++q) { const int i = tid + (it0 + q) * NTHREADS; const int row = i >> 6, c8 = (i & 63) * 8; const int pos = pos0 + row - 30;
                const bool valid = (i < 94 * 64) && (pos >= 0);
                const size_t tk = valid ? (size_t)(t0 + row - 30) : (size_t)t0;
                av[q] = *(const u32x4*)(cvg + tk * 1024 + c8); bv[q] = *(const u32x4*)(cvg + tk * 1024 + 512 + c8);
                if (!valid) { av[q] = (u32x4){0u, 0u, 0u, 0u}; bv[q] = av[q]; } }
#pragma unroll
            for (int q = 0; q < 4; ++q) { const int i = tid + (it0 + q) * NTHREADS; const int row = i >> 6, c8 = (i & 63) * 8;
                if (i < 94 * 64) { u32x4 o;
#pragma unroll
                    for (int j = 0; j < 4; ++j) o[j] = cvt_pk_bf16(bflo(av[q][j]) * bflo(bv[q][j]), bfhi(av[q][j]) * bfhi(bv[q][j]));
                    *(u32x4*)(gin + row * 512 + c8) = o; } }
        }
        __syncthreads();
        for (int rr = 0; rr < 4; ++rr) {
            float in[46];
#pragma unroll
            for (int j = 0; j < 46; ++j) in[j] = bf2f(gin[(rr * 16 + j) * 512 + tid]);
#pragma unroll
            for (int i = 0; i < 16; ++i) { float a = bias;
#pragma unroll
                for (int k = 0; k < CONV_K; ++k) a += w[k] * in[i + k];
                obuf[i * 512 + tid] = a; }
            __syncthreads();
#pragma unroll
            for (int q = 0; q < 2; ++q) { const int i = wid * 2 + q; const float* rp = obuf + i * 512 + lane * 8;
                const f32x4 a = *(const f32x4*)rp, b = *(const f32x4*)(rp + 4);
                float v[8] = {a[0], a[1], a[2], a[3], b[0], b[1], b[2], b[3]};
                float s = 0.f;
#pragma unroll
                for (int j = 0; j < 8; ++j) s += v[j];
                const float mean = wave_sum(s) * (1.0f / 512.0f);
                float ss = 0.f;
#pragma unroll
                for (int j = 0; j < 8; ++j) { v[j] -= mean; ss += v[j] * v[j]; }
                const float rstd = rsqrtf(wave_sum(ss) * (1.0f / 512.0f) + LN_EPS);
                float y[8];
#pragma unroll
                for (int j = 0; j < 8; ++j) { const float t = v[j] * rstd * lg[j] + lb[j]; y[j] = t * sigmoidf_(t); }
                *(u32x4*)(cout + (size_t)(t0 + rr * 16 + i) * 512 + lane * 8) = (u32x4){cvt_pk_bf16(y[0], y[1]), cvt_pk_bf16(y[2], y[3]), cvt_pk_bf16(y[4], y[5]), cvt_pk_bf16(y[6], y[7])}; }
            __syncthreads();
        }
    }
}

constexpr int H_QT = 0;
constexpr int H_KN = H_QT + 64 * 272;
constexpr int H_KT = H_KN + 64 * 272;
constexpr int H_VT = H_KT + 128 * 144;
constexpr int H_PP = H_VT + 128 * 144;
constexpr int H_SB = H_PP + 64 * 144;
constexpr int H_SEG = H_SB + 128 * 272;
constexpr int H_ER = H_SEG + 8192;
constexpr int H_EBL = H_ER + 512;
constexpr int H_SS = H_EBL + 512;
constexpr int H_END = H_SS + 2048;
static_assert(H_END <= LDS_BYTES, "hgrn lds");

template <bool OUT>
__device__ void hgrn_phase(const Params& p, unsigned char* lds, const int reps = 1) {
    const int tid = threadIdx.x, w = tid >> 6, lane = tid & 63, g = lane >> 4, c16 = lane & 15;
    const unsigned short* qg = (const unsigned short*)(p.ws + OFF_Q);
    const unsigned short* king = (const unsigned short*)(p.ws + OFF_KIN);
    const unsigned short* vg = (const unsigned short*)(p.ws + OFF_V);
    const unsigned short* gg = (const unsigned short*)(p.ws + OFF_G);
    unsigned short* og = (unsigned short*)(p.ws + OFF_CVG);
    float* segsum = (float*)(lds + H_SEG); float* er = (float*)(lds + H_ER); float* ebl = (float*)(lds + H_EBL); float* ssb = (float*)(lds + H_SS);
    const int kp = tid & 63;
    const int nchain = (256 - (int)blockIdx.x + (int)gridDim.x - 1) / (int)gridDim.x, nstep = nchain * 16 * reps;

    unsigned kraw[8], vraw[8], qraw[8];
    auto chunk_base = [&](int step) -> size_t {
        const int chain = blockIdx.x + ((step >> 4) % nchain) * gridDim.x, item = chain * 4 + ((step >> 2) & 3), c = step & 3;
        const int bh = item >> 5, sc = item & 31, b = bh >> 3, h = bh & 7;
        return ((size_t)b * SEQ + (size_t)sc * 256 + 64 * c + 8 * w) * 1024 + h * 128 + 2 * kp;
    };
    auto load_raw = [&](int step) {
        const size_t gbase = chunk_base(step);
#pragma unroll
        for (int tt = 0; tt < 8; ++tt) kraw[tt] = *(const unsigned*)(king + gbase + (size_t)tt * 1024);
#pragma unroll
        for (int tt = 0; tt < 8; ++tt) vraw[tt] = *(const unsigned*)(vg + gbase + (size_t)tt * 1024);
        if (OUT) {
#pragma unroll
            for (int tt = 0; tt < 8; ++tt) qraw[tt] = *(const unsigned*)(qg + gbase + (size_t)tt * 1024);
        }
    };
    float lf0[8], lf1[8], k0[8], k1[8];
    auto part1 = [&](int step) {
        float run0 = 0.f, run1 = 0.f;
#pragma unroll
        for (int tt = 0; tt < 8; ++tt) {
            const unsigned short lo = (unsigned short)(kraw[tt] & 0xffffu), hi = (unsigned short)(kraw[tt] >> 16);
            _Float16 hl, hh; __builtin_memcpy(&hl, &lo, 2); __builtin_memcpy(&hh, &hi, 2);
            k0[tt] = (float)hl; k1[tt] = (float)hh;
            run0 += __logf(fmaxf(1.0f - k0[tt], 1e-30f)); lf0[tt] = run0; run1 += __logf(fmaxf(1.0f - k1[tt], 1e-30f)); lf1[tt] = run1; }
        *(f32x2*)(segsum + (step & 1) * 1024 + w * 128 + 2 * kp) = (f32x2){run0, run1};
    };
    if (nstep > 0) { load_raw(0); part1(0); }

    f32x4 S[8];
    f32x4 gn = (f32x4){0.f, 0.f, 0.f, 0.f};
    float btot0 = 0.f, btot1 = 0.f;
    for (int step = 0; step < nstep; ++step) {
        const int chain = blockIdx.x + ((step >> 4) % nchain) * gridDim.x, jj = (step >> 2) & 3, item = chain * 4 + jj, c = step & 3;
        const int bh = item >> 5, sc = item & 31, b = bh >> 3, h = bh & 7;
        const size_t tc = (size_t)b * SEQ + (size_t)sc * 256 + 64 * c; const int ch0 = h * 128;
        unsigned short* Lg = (unsigned short*)(p.ws + OFF_L) + (size_t)chain * 16384;
        if (c == 0 && jj == 0) {
#pragma unroll
            for (int kt = 0; kt < 8; ++kt) {
                S[kt] = (f32x4){0.f, 0.f, 0.f, 0.f};
            }
            if (OUT) {
                const int nprev = chain & 7;
                for (int j = 0; j < nprev; ++j) {
                    const unsigned short* Lj = (const unsigned short*)(p.ws + OFF_L) + (size_t)((chain & ~7) + j) * 16384;
                    const float* Dj = (const float*)(p.ws + OFF_D) + (size_t)((chain & ~7) + j) * 128;
#pragma unroll
                    for (int kt = 0; kt < 8; ++kt) {
                        const u32x2 lv = *(const u32x2*)(Lj + (16 * w + c16) * 128 + 16 * kt + 4 * g);
                        const f32x4 dv = *(const f32x4*)(Dj + 16 * kt + 4 * g);
                        S[kt] = S[kt] * dv + (f32x4){bflo(lv[0]), bfhi(lv[0]), bflo(lv[1]), bfhi(lv[1])}; }
                }
            }
            if (OUT) gn = *(const f32x4*)(p.hgrn_norm_g + ch0 + 16 * w + 4 * g);
            btot0 = 0.f; btot1 = 0.f;
        }
        {
            __syncthreads();
            float off0 = 0.f, off1 = 0.f, r0 = 0.f, r1 = 0.f, bl0 = 0.f, bl1 = 0.f;
#pragma unroll
            for (int sg = 0; sg < 8; ++sg) { const f32x2 sv = *(const f32x2*)(segsum + (step & 1) * 1024 + sg * 128 + 2 * kp);
                if (sg < w) { off0 += sv[0]; off1 += sv[1]; }
                if (sg < 4) { r0 += sv[0]; r1 += sv[1]; }
                bl0 += sv[0]; bl1 += sv[1]; }
            unsigned short kb0[8], kb1[8];
#pragma unroll
            for (int tt = 0; tt < 8; ++tt) {
                const float b0 = off0 + lf0[tt], b1 = off1 + lf1[tt];
                const float kt0 = k0[tt] * __expf(fminf(r0 - b0, 80.f)), kt1 = k1[tt] * __expf(fminf(r1 - b1, 80.f));
                const unsigned kpk = cvt_pk_bf16(kt0, kt1);
                kb0[tt] = (unsigned short)(kpk & 0xffffu); kb1[tt] = (unsigned short)(kpk >> 16);
                if (OUT) {
                    *(unsigned*)(lds + H_KN + (8 * w + tt) * 272 + kp * 4) = kpk;
                    const float q0 = bflo(qraw[tt]) * __expf(fminf(b0 - r0, 80.f)), q1 = bfhi(qraw[tt]) * __expf(fminf(b1 - r1, 80.f));
                    *(unsigned*)(lds + H_QT + (8 * w + tt) * 272 + kp * 4) = cvt_pk_bf16(q0, q1);
                }
            }
            u32x4 ka, kbv, va, vb;
#pragma unroll
            for (int j = 0; j < 4; ++j) {
                ka[j] = (unsigned)kb0[2 * j] | ((unsigned)kb0[2 * j + 1] << 16);
                kbv[j] = (unsigned)kb1[2 * j] | ((unsigned)kb1[2 * j + 1] << 16);
                va[j] = (vraw[2 * j] & 0xffffu) | (vraw[2 * j + 1] << 16);
                vb[j] = (vraw[2 * j] >> 16) | (vraw[2 * j + 1] & 0xffff0000u); }
            *(u32x4*)(lds + H_KT + (2 * kp) * 144 + w * 16) = ka;
            *(u32x4*)(lds + H_KT + (2 * kp + 1) * 144 + w * 16) = kbv;
            *(u32x4*)(lds + H_VT + (2 * kp) * 144 + w * 16) = va;
            *(u32x4*)(lds + H_VT + (2 * kp + 1) * 144 + w * 16) = vb;
            if (w == 0) { *(f32x2*)(er + 2 * kp) = (f32x2){__expf(r0), __expf(r1)}; *(f32x2*)(ebl + 2 * kp) = (f32x2){__expf(bl0 - r0), __expf(bl1 - r1)}; btot0 += bl0; btot1 += bl1; }
        }
        __syncthreads();
        if (step + 1 < nstep) load_raw(step + 1);
#pragma unroll
        for (int kt = 0; kt < 8; ++kt) {
            const f32x4 e = *(const f32x4*)(er + 16 * kt + 4 * g);
            S[kt] = S[kt] * e;
            if (OUT) *(u32x2*)(lds + H_SB + (16 * w + c16) * 272 + (16 * kt + 4 * g) * 2) = (u32x2){cvt_pk_bf16(S[kt][0], S[kt][1]), cvt_pk_bf16(S[kt][2], S[kt][3])};
        }
        if (OUT) {
#pragma unroll
            for (int i = 0; i < 2; ++i) {
                const int id = 2 * w + i, st = id >> 2, tt = id & 3;
                f32x4 a4 = (f32x4){0.f, 0.f, 0.f, 0.f};
                if (st <= tt) {
#pragma unroll
                    for (int ks = 0; ks < 4; ++ks) {
                        const bf16x8 af = *(const bf16x8*)(lds + H_KN + (16 * st + c16) * 272 + (32 * ks + 8 * g) * 2);
                        const bf16x8 bf = *(const bf16x8*)(lds + H_QT + (16 * tt + c16) * 272 + (32 * ks + 8 * g) * 2);
                        a4 = __builtin_amdgcn_mfma_f32_16x16x32_bf16(af, bf, a4, 0, 0, 0);
                    }
                    const int tcol = 16 * tt + c16;
#pragma unroll
                    for (int r = 0; r < 4; ++r) { const int srow = 16 * st + 4 * g + r; if (srow > tcol) a4[r] = 0.f; }
                }
                *(u32x2*)(lds + H_PP + (16 * tt + c16) * 144 + (16 * st + 4 * g) * 2) = (u32x2){cvt_pk_bf16(a4[0], a4[1]), cvt_pk_bf16(a4[2], a4[3])};
            }
        }
        __syncthreads();
        f32x4 O[4];
        u32x2 gzv[4];
        if (OUT) {
#pragma unroll
            for (int tt = 0; tt < 4; ++tt) gzv[tt] = *(const u32x2*)(gg + (tc + 16 * tt + c16) * 1024 + ch0 + 16 * w + 4 * g);
        }
        if (OUT) {
#pragma unroll
            for (int tt = 0; tt < 4; ++tt) {
                f32x4 a4 = (f32x4){0.f, 0.f, 0.f, 0.f};
#pragma unroll
                for (int ks = 0; ks < 2; ++ks) {
                    const bf16x8 af = *(const bf16x8*)(lds + H_VT + (16 * w + c16) * 144 + (32 * ks + 8 * g) * 2);
                    const bf16x8 bf = *(const bf16x8*)(lds + H_PP + (16 * tt + c16) * 144 + (32 * ks + 8 * g) * 2);
                    a4 = __builtin_amdgcn_mfma_f32_16x16x32_bf16(af, bf, a4, 0, 0, 0);
                }
#pragma unroll
                for (int ks = 0; ks < 4; ++ks) {
                    const bf16x8 af = *(const bf16x8*)(lds + H_SB + (16 * w + c16) * 272 + (32 * ks + 8 * g) * 2);
                    const bf16x8 bf = *(const bf16x8*)(lds + H_QT + (16 * tt + c16) * 272 + (32 * ks + 8 * g) * 2);
                    a4 = __builtin_amdgcn_mfma_f32_16x16x32_bf16(af, bf, a4, 0, 0, 0);
                }
                O[tt] = a4;
            }
        }
#pragma unroll
        for (int kt = 0; kt < 8; ++kt) {
#pragma unroll
            for (int ks = 0; ks < 2; ++ks) {
                const bf16x8 af = *(const bf16x8*)(lds + H_KT + (16 * kt + c16) * 144 + (32 * ks + 8 * g) * 2);
                const bf16x8 bf = *(const bf16x8*)(lds + H_VT + (16 * w + c16) * 144 + (32 * ks + 8 * g) * 2);
                S[kt] = __builtin_amdgcn_mfma_f32_16x16x32_bf16(af, bf, S[kt], 0, 0, 0);
            }
            const f32x4 e = *(const f32x4*)(ebl + 16 * kt + 4 * g);
            S[kt] = S[kt] * e;
        }
        if (OUT) {
#pragma unroll
            for (int tt = 0; tt < 4; ++tt) {
                float s = O[tt][0] * O[tt][0] + O[tt][1] * O[tt][1] + O[tt][2] * O[tt][2] + O[tt][3] * O[tt][3];
                s += __shfl_xor(s, 16); s += __shfl_xor(s, 32);
                if (g == 0) ssb[w * 64 + 16 * tt + c16] = s;
            }
            __syncthreads();
#pragma unroll
            for (int tt = 0; tt < 4; ++tt) {
                const int t = 16 * tt + c16; float tot = 0.f;
#pragma unroll
                for (int ww = 0; ww < 8; ++ww) tot += ssb[ww * 64 + t];
                const float rs = rsqrtf(tot * (1.0f / 128.0f) + RMS_EPS);
                const size_t gi = (tc + t) * 1024 + ch0 + 16 * w + 4 * g;
                const u32x2 gz = gzv[tt];
                const float o0 = bf2f(f2bf(O[tt][0] * rs * gn[0])) * bflo(gz[0]), o1 = bf2f(f2bf(O[tt][1] * rs * gn[1])) * bfhi(gz[0]);
                const float o2 = bf2f(f2bf(O[tt][2] * rs * gn[2])) * bflo(gz[1]), o3 = bf2f(f2bf(O[tt][3] * rs * gn[3])) * bfhi(gz[1]);
                *(u32x2*)(og + gi) = (u32x2){cvt_pk_bf16(o0, o1), cvt_pk_bf16(o2, o3)};
            }
        }
        if (!OUT && c == 3 && jj == 3) {
            float* Dg = (float*)(p.ws + OFF_D) + (size_t)chain * 128;
#pragma unroll
            for (int kt = 0; kt < 8; ++kt)
                *(u32x2*)(Lg + (16 * w + c16) * 128 + 16 * kt + 4 * g) = (u32x2){cvt_pk_bf16(S[kt][0], S[kt][1]), cvt_pk_bf16(S[kt][2], S[kt][3])};
            if (w == 0) *(f32x2*)(Dg + 2 * kp) = (f32x2){__expf(btot0), __expf(btot1)};
        }
        if (step + 1 < nstep) part1(step + 1);
    }
    __syncthreads();
}

__device__ void phase_scan(const Params& p) {
    unsigned short* L = (unsigned short*)(p.ws + OFF_L); const float* D = (const float*)(p.ws + OFF_D);
    for (int i = blockIdx.x * NTHREADS + threadIdx.x; i < 32 * 4096; i += gridDim.x * NTHREADS) {
        const int bh = i >> 12, e4 = i & 4095, k0 = (e4 & 31) * 4;
        f32x4 carry = (f32x4){0.f, 0.f, 0.f, 0.f};
        u32x2 v[8]; f32x4 d[8];
#pragma unroll
        for (int s = 0; s < 8; ++s) { const int chain = bh * 8 + s; v[s] = *(const u32x2*)(L + (size_t)chain * 16384 + e4 * 4); d[s] = *(const f32x4*)(D + chain * 128 + k0); }
#pragma unroll
        for (int s = 0; s < 8; ++s) { const int chain = bh * 8 + s;
            *(u32x2*)(L + (size_t)chain * 16384 + e4 * 4) = (u32x2){cvt_pk_bf16(carry[0], carry[1]), cvt_pk_bf16(carry[2], carry[3])};
            const f32x4 lv = (f32x4){bflo(v[s][0]), bfhi(v[s][0]), bflo(v[s][1]), bfhi(v[s][1])};
            carry = carry * d[s] + lv; }
    }
}

__device__ void phase_ln(float* buf, const float* gam, const float* bet, unsigned short* copyb) {
    const int lane = threadIdx.x & 63, wv = blockIdx.x * 8 + (threadIdx.x >> 6), nw = gridDim.x * 8;
    f32x4 gv[4], bv[4];
#pragma unroll
    for (int i = 0; i < 4; ++i) { gv[i] = *(const f32x4*)(gam + i * 256 + lane * 4); bv[i] = *(const f32x4*)(bet + i * 256 + lane * 4); }
    for (int r = wv; r < T_TOK; r += nw) {
        float* rp = buf + (size_t)r * 1024;
        f32x4 v[4]; float s = 0.f;
#pragma unroll
        for (int i = 0; i < 4; ++i) { v[i] = *(const f32x4*)(rp + i * 256 + lane * 4); s += v[i][0] + v[i][1] + v[i][2] + v[i][3]; }
        const float mean = wave_sum(s) * (1.0f / 1024.0f);
        float ss = 0.f;
#pragma unroll
        for (int i = 0; i < 4; ++i) { v[i] = v[i] - mean; ss += v[i][0] * v[i][0] + v[i][1] * v[i][1] + v[i][2] * v[i][2] + v[i][3] * v[i][3]; }
        const float rstd = rsqrtf(wave_sum(ss) * (1.0f / 1024.0f) + LN_EPS);
#pragma unroll
        for (int i = 0; i < 4; ++i) { const f32x4 y = v[i] * rstd * gv[i] + bv[i];
            if (copyb) *(u32x2*)(copyb + (size_t)r * 1024 + i * 256 + lane * 4) = (u32x2){cvt_pk_bf16(y[0], y[1]), cvt_pk_bf16(y[2], y[3])};
            else *(f32x4*)(rp + i * 256 + lane * 4) = y; }
    }
}

__device__ __forceinline__ float gelu_tanh(float x) {
    const float y = 0.7978845608028654f * (x + 0.044715f * x * x * x);
    const float t = 1.0f - 2.0f * __builtin_amdgcn_rcpf(1.0f + __expf(2.0f * y));
    return 0.5f * x * (1.0f + t);
}
__device__ void phase_act(const Params& p) {
    unsigned short* z = (unsigned short*)(p.ws + OFF_Z);
    constexpr int NCG = DFF / 8, RUN = 16, NRUN = T_TOK / RUN;
    for (int i = blockIdx.x * NTHREADS + threadIdx.x; i < NCG * NRUN; i += gridDim.x * NTHREADS) {
        const int cgi = i % NCG, run = i / NCG; const int c = cgi * 8; const size_t t0 = (size_t)run * RUN;
        float w0[8], w1[8], w2[8], bb[8];
#pragma unroll
        for (int j = 0; j < 8; ++j) { w0[j] = p.w_ffn_dw[c + j]; w1[j] = p.w_ffn_dw[DFF + c + j]; w2[j] = p.w_ffn_dw[2 * DFF + c + j]; bb[j] = p.b_ffn_dw[c + j]; }
        float um2[8], um1[8];
        if ((t0 % SEQ) == 0) {
#pragma unroll
            for (int j = 0; j < 8; ++j) { um2[j] = 0.f; um1[j] = 0.f; }
        } else {
            const u32x4 a = *(const u32x4*)(z + (t0 - 2) * (2 * DFF) + c), b = *(const u32x4*)(z + (t0 - 1) * (2 * DFF) + c);
#pragma unroll
            for (int j = 0; j < 4; ++j) { um2[2 * j] = bflo(a[j]); um2[2 * j + 1] = bfhi(a[j]); um1[2 * j] = bflo(b[j]); um1[2 * j + 1] = bfhi(b[j]); }
        }
#pragma unroll 4
        for (int tt = 0; tt < RUN; ++tt) {
            unsigned short* rowp = z + (t0 + tt) * (2 * DFF);
            const u32x4 a = *(const u32x4*)(rowp + c), gq = *(const u32x4*)(rowp + DFF + c);
            float u[8], gvv[8], o[8];
#pragma unroll
            for (int j = 0; j < 4; ++j) { u[2 * j] = bflo(a[j]); u[2 * j + 1] = bfhi(a[j]); gvv[2 * j] = bflo(gq[j]); gvv[2 * j + 1] = bfhi(gq[j]); }
#pragma unroll
            for (int j = 0; j < 8; ++j) { const float cv = w0[j] * um2[j] + w1[j] * um1[j] + w2[j] * u[j] + bb[j]; o[j] = gelu_tanh(cv) * gvv[j]; um2[j] = um1[j]; um1[j] = u[j]; }
            *(u32x4*)(rowp + DFF + c) = (u32x4){cvt_pk_bf16(o[0], o[1]), cvt_pk_bf16(o[2], o[3]), cvt_pk_bf16(o[4], o[5]), cvt_pk_bf16(o[6], o[7])};
        }
    }
}


#define XB_TMO      128
#define XB_XCNT(j)  (256  + 64 * (j))
#define XB_XSUB(j)  (1280 + 64 * (j))
#define XB_XGEN(j)  (2304 + 64 * (j))
#define XB_TOP      3328
#define XB_TOPGEN   3392
#define XCD_BAR_WORDS 3456
#define XB_SPIN_CAP (1u << 22)
__device__ __forceinline__ unsigned xb_ld(unsigned* p)              { return __hip_atomic_load(p, __ATOMIC_RELAXED, __HIP_MEMORY_SCOPE_AGENT); }
__device__ __forceinline__ unsigned xb_add(unsigned* p, unsigned v) { return __hip_atomic_fetch_add(p, v, __ATOMIC_RELAXED, __HIP_MEMORY_SCOPE_AGENT); }
__device__ __forceinline__ unsigned xb_xcc_id() { return (unsigned)__builtin_amdgcn_s_getreg((3 << 11) | 20) & 0xFu; }
#define XB_SPIN(cond, bar) do { unsigned _sp = 0; while (cond) { __builtin_amdgcn_s_sleep(1); \
    if ((++_sp & 255u) == 0u) { if (xb_ld(&(bar)[XB_TMO])) break; if (_sp > XB_SPIN_CAP) { atomicAdd(&(bar)[XB_TMO], 1u); break; } } } } while (0)
struct XcdBarrier { unsigned* bar; unsigned x; volatile LAS unsigned* st; };
__device__ __forceinline__ XcdBarrier xcd_barrier_post(unsigned* bar, volatile LAS unsigned* st) {
    XcdBarrier b; b.bar = bar; b.x = xb_xcc_id(); b.st = st;
    if (threadIdx.x == 0) (void)xb_add(&bar[XB_XCNT(b.x)], 1u);
    return b;
}
__device__ __forceinline__ void xcd_barrier_complete(unsigned* bar, unsigned x, unsigned& nloc, unsigned& nx) {
    const unsigned G = gridDim.x * gridDim.y * gridDim.z;
    unsigned sum, cnt, mine, sp = 0u;
    for (;;) {
        sum = 0u; cnt = 0u; mine = 0u;
#pragma unroll
        for (unsigned j = 0; j < 16; ++j) { const unsigned c = xb_ld(&bar[XB_XCNT(j)]); sum += c; cnt += (c > 0u) ? 1u : 0u; mine = (j == x) ? c : mine; }
        if (sum == G) break;
        __builtin_amdgcn_s_sleep(1);
        if ((++sp & 255u) == 0u) { if (xb_ld(&bar[XB_TMO])) break; if (sp > XB_SPIN_CAP) { atomicAdd(&bar[XB_TMO], 1u); break; } }
    }
    nloc = mine > 0u ? mine : 1u; nx = cnt > 0u ? cnt : 1u;
}
__device__ __forceinline__ void xcd_barrier(const XcdBarrier& b) {
    asm volatile("s_waitcnt vmcnt(0)" ::: "memory");
    __syncthreads();
    if (threadIdx.x == 0) {
        unsigned* bar = b.bar;
        __builtin_amdgcn_s_waitcnt(0);
        unsigned nloc = b.st[0], nx = b.st[1];
        if (nloc == 0u) { xcd_barrier_complete(bar, b.x, nloc, nx); b.st[0] = nloc; b.st[1] = nx; }
        const unsigned old = xb_add(&bar[XB_XSUB(b.x)], 1u);
        const unsigned gen = old / nloc;
        if (old + 1u == (gen + 1u) * nloc) {
            __builtin_amdgcn_fence(__ATOMIC_RELEASE, "agent");
            asm volatile("s_waitcnt vmcnt(0)" ::: "memory");
            const unsigned og = xb_add(&bar[XB_TOP], 1u);
            const unsigned tg = og / nx;
            if (og + 1u == (tg + 1u) * nx) xb_add(&bar[XB_TOPGEN], 1u);
            else XB_SPIN(xb_ld(&bar[XB_TOPGEN]) == tg, bar);
            __builtin_amdgcn_fence(__ATOMIC_ACQUIRE, "agent");
            xb_add(&bar[XB_XGEN(b.x)], 1u);
            asm volatile("s_waitcnt vmcnt(0)" ::: "memory");
        } else {
            XB_SPIN(xb_ld(&bar[XB_XGEN(b.x)]) == gen, bar);
            __builtin_amdgcn_fence(__ATOMIC_ACQUIRE, "agent");
            asm volatile("s_waitcnt vmcnt(0)" ::: "memory");
        }
    }
    __syncthreads();
}

#ifndef PHASE_MASK
#define PHASE_MASK 0x1fff
#endif
#ifndef DUP_MASK
#define DUP_MASK 0
#endif
#define PHASE(n) if ((PHASE_MASK & (1 << (n))) && (ph_only < 0 || ph_only == (n))) for (int rep_ = 0; rep_ < 1 + ((DUP_MASK >> (n)) & 1); ++rep_)
#define SYNC() do { if (ph_only < 0) xcd_barrier(xb); } while (0)
__global__ void __launch_bounds__(NTHREADS, 2) fwd_megakernel(Params p, int ph_only) {
    extern __shared__ __attribute__((aligned(16))) unsigned char shm[];
    cg::grid_group grid = cg::this_grid();
    LAS unsigned char* lds3 = (LAS unsigned char*)shm;
    volatile LAS unsigned* xst = (volatile LAS unsigned*)(lds3 + LDS_BYTES - 16);
    if (threadIdx.x == 0) { xst[0] = 0u; xst[1] = 0u; }
    __syncthreads();
    const XcdBarrier xb = xcd_barrier_post((unsigned*)(p.ws + OFF_BAR), xst);
    PHASE(0) { phase_prep(p, shm); }
    if (ph_only == -12345) grid.sync();
    SYNC();
    PHASE(1) { pg8::StaticOrder S; S.init(T_TOK, IN_COLS, gridDim.x, blockIdx.x);
               pg8::Gemm g{(const bf16_t*)(p.ws + OFF_XB), (const bf16_t*)(p.ws + OFF_WIN), T_TOK, IN_COLS, DM, DM, nullptr, 0, 0};
               EpiProj e{p.ws, (unsigned short*)p.out, (const float*)(p.ws + OFF_MISC)}; pg8::gemm_phase(lds3, g, S, e); }
    SYNC();
    PHASE(2) { phase_conv(p, shm);
               hgrn_phase<false>(p, shm); }
    SYNC();
    PHASE(4) { hgrn_phase<true>(p, shm); }
    SYNC();
    PHASE(5) { pg8::StaticOrder S; S.init(T_TOK, DM, gridDim.x, blockIdx.x);
               pg8::Gemm g{(const bf16_t*)(p.ws + OFF_XB), (const bf16_t*)(p.ws + OFF_WCO), T_TOK, DM, CONV_DIM + HG, CONV_DIM, (const bf16_t*)(p.ws + OFF_CVG), HG, CONV_DIM / 64};
               EpiMix e{(const unsigned short*)p.out, (unsigned short*)(p.ws + OFF_V)}; pg8::gemm_phase<EpiMix, true>(lds3, g, S, e); }
    SYNC();
    PHASE(7) { pg8::StaticOrder S; S.init(T_TOK, DM, gridDim.x, blockIdx.x);
               pg8::Gemm g{(const bf16_t*)(p.ws + OFF_V), (const bf16_t*)(p.ws + OFF_WOUT), T_TOK, DM, DM, DM, nullptr, 0, 0};
               EpiLn<0> e{p.x, p.ws + OFF_G, p.ln1_g, p.ln1_b, (float*)(p.ws + OFF_PART7), (unsigned*)(p.ws + OFF_CNT), lds3 + 131072}; pg8::gemm_phase(lds3, g, S, e); }
    SYNC();
    PHASE(9) { pg8::StaticOrder S; S.init(T_TOK, 2 * DFF, gridDim.x, blockIdx.x);
               pg8::Gemm g{(const bf16_t*)(p.ws + OFF_G), (const bf16_t*)(p.ws + OFF_WFI), T_TOK, 2 * DFF, DM, DM, nullptr, 0, 0};
               EpiZ e{(unsigned short*)(p.ws + OFF_Z), 2 * DFF}; pg8::gemm_phase(lds3, g, S, e); }
    SYNC();
    PHASE(10) { phase_act(p); }
    SYNC();
    PHASE(11) { pg8::StaticOrder S; S.init(T_TOK, DM, gridDim.x, blockIdx.x);
                pg8::Gemm g{(const bf16_t*)(p.ws + OFF_Z) + DFF, (const bf16_t*)(p.ws + OFF_WFO), T_TOK, DM, DFF, 2 * DFF, nullptr, 0, 0};
                EpiLn<1> e{p.ws + OFF_G, p.out, p.ln2_g, p.ln2_b, (float*)(p.ws + OFF_PART11), (unsigned*)(p.ws + OFF_CNT) + 128 * 2 * 64, lds3 + 131072}; pg8::gemm_phase(lds3, g, S, e); }
}

extern "C" void kernel_launch(void* const* d_in, const int* in_sizes, int n_in, void* d_out, int out_size, void* d_ws, size_t ws_size, hipStream_t stream) {
    static int grid_blocks = 0;
    if (!grid_blocks) {
        int dev = 0, cus = 0, per_cu = 0;
        hipGetDevice(&dev);
        hipDeviceGetAttribute(&cus, hipDeviceAttributeMultiprocessorCount, dev);
        hipFuncSetAttribute((const void*)fwd_megakernel, hipFuncAttributeMaxDynamicSharedMemorySize, LDS_BYTES);
        hipOccupancyMaxActiveBlocksPerMultiprocessor(&per_cu, (const void*)fwd_megakernel, NTHREADS, LDS_BYTES);
        if (per_cu < 1) per_cu = 1;
        if (per_cu > 1) per_cu = 1;
        grid_blocks = cus * per_cu;
        if (ws_size < WS_NEED) fprintf(stderr, "kernel_launch: workspace too small: %zu < %zu\n", ws_size, (size_t)WS_NEED);
    }
    hipMemsetAsync((unsigned char*)d_ws + OFF_BAR, 0, ZERO_BYTES, stream);
    Params p{};
    p.x = (const float*)d_in[0]; p.w_in = (const float*)d_in[1]; p.w_conv_dw = (const float*)d_in[2]; p.b_conv_dw = (const float*)d_in[3];
    p.conv_ln_g = (const float*)d_in[4]; p.conv_ln_b = (const float*)d_in[5]; p.w_conv_out = (const float*)d_in[6]; p.lb_logits = (const float*)d_in[7];
    p.hgrn_norm_g = (const float*)d_in[8]; p.w_hgrn_out = (const float*)d_in[9]; p.w_out = (const float*)d_in[10]; p.ln1_g = (const float*)d_in[11];
    p.ln1_b = (const float*)d_in[12]; p.w_ffn_in = (const float*)d_in[13]; p.w_ffn_dw = (const float*)d_in[14]; p.b_ffn_dw = (const float*)d_in[15];
    p.w_ffn_out = (const float*)d_in[16]; p.ln2_g = (const float*)d_in[17]; p.ln2_b = (const float*)d_in[18];
    p.out = (float*)d_out; p.ws = (unsigned char*)d_ws;
#if defined(MULTI_LAUNCH)
    for (int ph = 0; ph < 13; ++ph) hipLaunchKernelGGL(fwd_megakernel, dim3(grid_blocks), dim3(NTHREADS), LDS_BYTES, stream, p, ph);
#else
    int ph_only = -1;
    void* args[] = {&p, &ph_only};
    hipError_t e = hipLaunchCooperativeKernel((const void*)fwd_megakernel, dim3(grid_blocks), dim3(NTHREADS), args, LDS_BYTES, stream);
    if (e != hipSuccess) fprintf(stderr, "cooperative launch failed: %s (grid %d)\n", hipGetErrorString(e), grid_blocks);
#endif
}
```

```cpp
#include <hip/hip_runtime.h>
#include <hip/hip_cooperative_groups.h>
#include <cstdio>
namespace cg = cooperative_groups;

#define LAS __attribute__((address_space(3)))
typedef unsigned short bf16_t;
typedef short bf16x8 __attribute__((ext_vector_type(8)));
typedef float f32x4 __attribute__((ext_vector_type(4)));
typedef float f32x2 __attribute__((ext_vector_type(2)));
typedef unsigned u32x4 __attribute__((ext_vector_type(4)));
typedef unsigned u32x2 __attribute__((ext_vector_type(2)));

constexpr int T_TOK = 32768, SEQ = 8192, DM = 1024, IN_COLS = 7168, CONV_DIM = 512, CONV_K = 31, HG = 1024, DFF = 2816;
constexpr float ALPHA = 1.189207115002721f;
constexpr float LN_EPS = 1e-5f, RMS_EPS = 1e-6f;
constexpr int NTHREADS = 512;
constexpr int LDS_BYTES = 140 * 1024;

constexpr size_t MiB = 1024ull * 1024ull;
constexpr size_t OFF_W    = 0;
constexpr size_t OFF_WIN  = OFF_W;
constexpr size_t OFF_WCO  = OFF_WIN + (size_t)IN_COLS * DM * 2;
constexpr size_t OFF_WHO  = OFF_WCO + (size_t)DM * CONV_DIM * 2;
constexpr size_t OFF_WOUT = OFF_WHO + (size_t)DM * HG * 2;
constexpr size_t OFF_WFI  = OFF_WOUT + (size_t)DM * DM * 2;
constexpr size_t OFF_WFO  = OFF_WFI + (size_t)2 * DFF * DM * 2;
constexpr size_t OFF_G    = 36 * MiB;
constexpr size_t OFF_Q    = 100 * MiB;
constexpr size_t OFF_KIN  = 164 * MiB;
constexpr size_t OFF_V    = 228 * MiB;
constexpr size_t OFF_XB   = 292 * MiB;
constexpr size_t OFF_CVG  = 356 * MiB;
constexpr size_t OFF_L    = 420 * MiB;
constexpr size_t OFF_D    = 484 * MiB;
constexpr size_t OFF_MISC = 485 * MiB;
constexpr size_t OFF_Z    = OFF_Q;
constexpr size_t OFF_PART7  = 486 * MiB;
constexpr size_t OFF_PART11 = 487 * MiB;
constexpr size_t OFF_BAR  = 489 * MiB;
constexpr size_t OFF_CNT  = OFF_BAR + 64 * 1024;
constexpr size_t ZERO_BYTES = 64 * 1024 + 2 * 128 * 2 * 256;
constexpr size_t WS_NEED  = 490 * MiB;

struct Params {
    const float* x; const float* w_in; const float* w_conv_dw; const float* b_conv_dw; const float* conv_ln_g; const float* conv_ln_b;
    const float* w_conv_out; const float* lb_logits; const float* hgrn_norm_g; const float* w_hgrn_out; const float* w_out;
    const float* ln1_g; const float* ln1_b; const float* w_ffn_in; const float* w_ffn_dw; const float* b_ffn_dw; const float* w_ffn_out;
    const float* ln2_g; const float* ln2_b;
    float* out; unsigned char* ws;
};

__device__ __forceinline__ unsigned cvt_pk_bf16(float lo, float hi) { unsigned r; asm("v_cvt_pk_bf16_f32 %0, %1, %2" : "=v"(r) : "v"(lo), "v"(hi)); return r; }
__device__ __forceinline__ float bf2f(unsigned short b) { return __uint_as_float(((unsigned)b) << 16); }
__device__ __forceinline__ float bflo(unsigned u) { return __uint_as_float(u << 16); }
__device__ __forceinline__ float bfhi(unsigned u) { return __uint_as_float(u & 0xffff0000u); }
__device__ __forceinline__ unsigned short f2bf(float f) { return (unsigned short)(cvt_pk_bf16(f, 0.f) & 0xffffu); }
__device__ __forceinline__ float sigmoidf_(float x) { return __builtin_amdgcn_rcpf(1.0f + __expf(-x)); }
__device__ __forceinline__ unsigned pk_f16(float lo, float hi) {
    _Float16 a = (_Float16)lo, b = (_Float16)hi; unsigned short ua, ub; __builtin_memcpy(&ua, &a, 2); __builtin_memcpy(&ub, &b, 2); return (unsigned)ua | ((unsigned)ub << 16); }
__device__ __forceinline__ float wave_sum(float v) {
#pragma unroll
    for (int o = 32; o >= 1; o >>= 1) v += __shfl_xor(v, o);
    return v; }

namespace pg8 {
constexpr int BM = 256, BK = 64, HALF = 128, HTB = HALF * BK * 2, STAGE_BYTES = 8 * HTB, NXCD = 8, WGM = 4;
__host__ __device__ __forceinline__ int lds_byte(int r, int c) { const int st = (r >> 4) * 2 + (c >> 5), rr = r & 15, cc = c & 31, ob = rr * 64 + cc * 2; return st * 1024 + (ob ^ (((ob >> 9) & 1) << 5)); }
__host__ __device__ __forceinline__ void stage_rc(int b, int& R, int& C) { const int st = b / 1024, sb = b % 1024, swz = sb ^ (((sb >> 9) & 1) << 5); R = (st >> 1) * 16 + swz / 64; C = (st & 1) * 32 + (swz % 64) / 2; }
__host__ __device__ __forceinline__ int perm32(int rho) { const int n = rho >> 4, i = rho & 15; return 8 * (i >> 2) + 4 * n + (i & 3); }
struct Unit { int pm, pn; };
struct Gemm { const bf16_t* A; const bf16_t* Bt; int M, N, K, lda; const bf16_t* A2; int lda2; int ksplit; };
struct StaticOrder {
    int nM, nN, nwg, G, c, reps;
    __device__ void init(int M, int N, int G_, int c_, int reps_ = 1) { nM = M / BM; nN = N / BM; nwg = nM * nN; G = G_; c = c_; reps = reps_; }
    __device__ bool next(int i, Unit& u) const {
        const int rounds = (nwg + G - 1) / G; if (i >= rounds * reps) return false;
        const long L = (long)(i % rounds) * G + c; if (L >= nwg) return false;
        int wgid = (int)L; { const int q = nwg / NXCD, r = nwg % NXCD, xcd = wgid % NXCD, off = wgid / NXCD; wgid = (xcd < r ? xcd * (q + 1) : r * (q + 1) + (xcd - r) * q) + off; }
        const int nig = WGM * nN, gid = wgid / nig, fm = gid * WGM, gsz = (nM - fm) < WGM ? (nM - fm) : WGM;
        u.pm = fm + ((wgid % nig) % gsz); u.pn = (wgid % nig) / gsz; return true;
    }
};

template <class Epi, bool DUAL = false>
__device__ __forceinline__ void gemm_phase(LAS unsigned char* lds, const Gemm g, const StaticOrder& S, Epi& E) {
    const int tid = threadIdx.x, wid = __builtin_amdgcn_readfirstlane(tid >> 6), lane = tid & 63, wr = wid >> 2, wc = wid & 3, fr = lane & 15, fq = lane >> 4;
    const int K = g.K, nt = K / BK, lda = g.lda, lda2 = g.lda2, ksplit = g.ksplit;
    unsigned voffA[2], voffA2[2], voffB[2];
#pragma unroll
    for (int i = 0; i < 2; ++i) { int R, C; stage_rc(tid * 16 + i * 8192, R, C); const int Rb = Epi::PERM ? ((R & ~31) + perm32(R & 31)) : R;
        voffA[i] = (unsigned)(R * lda + C) * 2u; voffA2[i] = DUAL ? (unsigned)(R * lda2 + C) * 2u : 0u; voffB[i] = (unsigned)(Rb * K + C) * 2u; }
    const size_t kstep = (size_t)(BK * 2);
    const size_t hstepA = (size_t)HALF * lda * 2, hstepA2 = (size_t)HALF * lda2 * 2, hstepB = (size_t)HALF * K * 2;
    const unsigned ldsw = (unsigned)wid * 1024u;
    const int aoff = lds_byte(wr * 64 + fr, fq * 8), boff = lds_byte(wc * 32 + fr, fq * 8);
#define PG8_SA(b, h) (((b) * 2 + (h)) * HTB)
#define PG8_SB(b, h) ((4 + (b) * 2 + (h)) * HTB)
    auto stA = [&](int bufoff, int pm, int kt, int half) {
        const char* base; unsigned v0, v1;
        if (DUAL && kt >= ksplit) { base = (const char*)g.A2 + (size_t)(2 * pm + half) * hstepA2 + (size_t)(kt - ksplit) * kstep; v0 = voffA2[0]; v1 = voffA2[1]; }
        else                      { base = (const char*)g.A  + (size_t)(2 * pm + half) * hstepA  + (size_t)kt * kstep;            v0 = voffA[0];  v1 = voffA[1]; }
        __builtin_amdgcn_global_load_lds((const unsigned*)(base + v0), (LAS unsigned*)(lds + bufoff + ldsw), 16, 0, 0);
        __builtin_amdgcn_global_load_lds((const unsigned*)(base + v1), (LAS unsigned*)(lds + bufoff + ldsw + 8192), 16, 0, 0);
    };
    auto stB = [&](int bufoff, int pn, int kt, int half) {
        const char* base = (const char*)g.Bt + (size_t)(2 * pn + half) * hstepB + (size_t)kt * kstep;
        __builtin_amdgcn_global_load_lds((const unsigned*)(base + voffB[0]), (LAS unsigned*)(lds + bufoff + ldsw), 16, 0, 0);
        __builtin_amdgcn_global_load_lds((const unsigned*)(base + voffB[1]), (LAS unsigned*)(lds + bufoff + ldsw + 8192), 16, 0, 0);
    };
#define PG8_LDA(dst, b, h) do { _Pragma("unroll") for (int m = 0; m < 4; ++m) _Pragma("unroll") for (int k = 0; k < 2; ++k) dst[m][k] = *(const LAS bf16x8*)(lds + PG8_SA(b, h) + aoff + m * 2048 + k * 1024); } while (0)
#define PG8_LDB(dst, b, h) do { _Pragma("unroll") for (int n = 0; n < 2; ++n) _Pragma("unroll") for (int k = 0; k < 2; ++k) dst[n][k] = *(const LAS bf16x8*)(lds + PG8_SB(b, h) + boff + n * 2048 + k * 1024); } while (0)
#define PG8_MMA(ai, bj, At, Bt) do { __builtin_amdgcn_s_setprio(1); _Pragma("unroll") for (int m = 0; m < 4; ++m) _Pragma("unroll") for (int n = 0; n < 2; ++n) _Pragma("unroll") for (int k = 0; k < 2; ++k) \
        acc[ai][bj][m][n] = __builtin_amdgcn_mfma_f32_16x16x32_bf16(Bt[n][k], At[m][k], acc[ai][bj][m][n], 0, 0, 0); __builtin_amdgcn_s_setprio(0); } while (0)
#define PG8_WAIT_V(n) asm volatile("s_waitcnt vmcnt(" #n ")" ::: "memory")
#define PG8_WAIT_L(n) asm volatile("s_waitcnt lgkmcnt(" #n ")" ::: "memory")
#define PG8_BAR __builtin_amdgcn_s_barrier()
#define PG8_SCHED __builtin_amdgcn_sched_barrier(0)
    Unit cur, nxt; int ui = 0;
    if (!S.next(0, cur)) return;
    f32x4 acc[2][2][4][2];
#pragma unroll
    for (int a = 0; a < 2; ++a)
#pragma unroll
        for (int b = 0; b < 2; ++b)
#pragma unroll
            for (int m = 0; m < 4; ++m)
#pragma unroll
                for (int n = 0; n < 2; ++n) acc[a][b][m][n] = (f32x4){0.f, 0.f, 0.f, 0.f};
    bf16x8 At[4][2], B0[2][2], B1[2][2];
    stB(PG8_SB(0, 0), cur.pn, 0, 0); stA(PG8_SA(0, 0), cur.pm, 0, 0); stB(PG8_SB(0, 1), cur.pn, 0, 1); stA(PG8_SA(0, 1), cur.pm, 0, 1);
    if (wr == 1) PG8_BAR;
    PG8_WAIT_V(4); PG8_BAR;
    stB(PG8_SB(1, 0), cur.pn, 1, 0); stA(PG8_SA(1, 0), cur.pm, 1, 0); stB(PG8_SB(1, 1), cur.pn, 1, 1);
    PG8_WAIT_V(6); PG8_BAR;
    for (;;) {
        const bool has_next = S.next(ui + 1, nxt);
        const int npm = has_next ? nxt.pm : cur.pm, npn = has_next ? nxt.pn : cur.pn;
        for (int t = 0; t < nt; t += 2) {
            const bool last = (t == nt - 2);
            const int pm2 = last ? npm : cur.pm, pn2 = last ? npn : cur.pn, k2 = last ? 0 : t + 2, k3 = k2 + 1;
            if constexpr (DUAL) { if (t == ksplit) E.mid(acc, cur, wr, wc, fr, fq); }
            PG8_LDB(B0, 0, 0); PG8_SCHED; PG8_LDA(At, 0, 0); stA(PG8_SA(1, 1), cur.pm, t + 1, 1);
            PG8_WAIT_L(8); PG8_BAR; PG8_WAIT_L(0); PG8_MMA(0, 0, At, B0); PG8_BAR; PG8_SCHED;
            PG8_LDB(B1, 0, 1); stB(PG8_SB(0, 0), pn2, k2, 0);
            PG8_BAR; PG8_WAIT_L(0); PG8_MMA(0, 1, At, B1); PG8_BAR;
            PG8_LDA(At, 0, 1); stA(PG8_SA(0, 0), pm2, k2, 0);
            PG8_BAR; PG8_WAIT_L(0); PG8_MMA(1, 0, At, B0); PG8_BAR; PG8_SCHED;
            stB(PG8_SB(0, 1), pn2, k2, 1);
            PG8_WAIT_V(6); PG8_BAR; PG8_MMA(1, 1, At, B1); PG8_BAR;
            PG8_LDB(B0, 1, 0); PG8_SCHED; PG8_LDA(At, 1, 0); stA(PG8_SA(0, 1), pm2, k2, 1);
            PG8_WAIT_L(8); PG8_BAR; PG8_WAIT_L(0); PG8_MMA(0, 0, At, B0); PG8_BAR; PG8_SCHED;
            PG8_LDB(B1, 1, 1); stB(PG8_SB(1, 0), pn2, k3, 0);
            PG8_BAR; PG8_WAIT_L(0); PG8_MMA(0, 1, At, B1); PG8_BAR;
            PG8_LDA(At, 1, 1); stA(PG8_SA(1, 0), pm2, k3, 0);
            PG8_BAR; PG8_WAIT_L(0); PG8_MMA(1, 0, At, B0); PG8_BAR; PG8_SCHED;
            stB(PG8_SB(1, 1), pn2, k3, 1);
            PG8_WAIT_V(6); PG8_BAR; PG8_MMA(1, 1, At, B1); PG8_BAR;
        }
        E(acc, cur, wr, wc, fr, fq);
        if (!has_next) break;
#pragma unroll
        for (int a = 0; a < 2; ++a)
#pragma unroll
            for (int b = 0; b < 2; ++b)
#pragma unroll
                for (int m = 0; m < 4; ++m)
#pragma unroll
                    for (int n = 0; n < 2; ++n) acc[a][b][m][n] = (f32x4){0.f, 0.f, 0.f, 0.f};
        cur = nxt; ++ui;
    }
    PG8_WAIT_V(0);
    if (wr == 0) PG8_BAR;
    PG8_BAR;
#undef PG8_SA
#undef PG8_SB
#undef PG8_LDA
#undef PG8_LDB
#undef PG8_MMA
#undef PG8_WAIT_V
#undef PG8_WAIT_L
#undef PG8_BAR
#undef PG8_SCHED
}
}
using pg8::Unit;

struct EpiProj {
    static constexpr bool PERM = true;
    unsigned char* ws; unsigned short* mgate; const float* colscale;
    __device__ __forceinline__ void operator()(const f32x4 (&acc)[2][2][4][2], const Unit& u, int wr, int wc, int fr, int fq) const {
        const int pn = u.pn;
        if (pn >= 20) {
            const int rowg = u.pm * 256 + wr * 64 + fr, chl = (pn - 20) * 128 + wc * 32 + 8 * fq;
#pragma unroll
            for (int ai = 0; ai < 2; ++ai)
#pragma unroll
                for (int m = 0; m < 4; ++m) {
                    float ra[8], g1[8];
#pragma unroll
                    for (int n = 0; n < 2; ++n)
#pragma unroll
                        for (int j = 0; j < 4; ++j) { const float d0 = 1.0f + __expf(-acc[ai][0][m][n][j]), d1 = 1.0f + __expf(-acc[ai][1][m][n][j]);
                            g1[n * 4 + j] = __builtin_amdgcn_rcpf(d1); ra[n * 4 + j] = d1 * __builtin_amdgcn_rcpf(d0); }
                    unsigned short* rowp = mgate + (size_t)(rowg + ai * 128 + m * 16) * 2048 + chl;
                    *(u32x4*)rowp = (u32x4){cvt_pk_bf16(ra[0], ra[1]), cvt_pk_bf16(ra[2], ra[3]), cvt_pk_bf16(ra[4], ra[5]), cvt_pk_bf16(ra[6], ra[7])};
                    *(u32x4*)(rowp + 1024) = (u32x4){cvt_pk_bf16(g1[0], g1[1]), cvt_pk_bf16(g1[2], g1[3]), cvt_pk_bf16(g1[4], g1[5]), cvt_pk_bf16(g1[6], g1[7])};
                }
            return;
        }
        unsigned short* base; int ld, colt; float c0, c1, c2, sgn; bool f16 = false;
        if (pn < 4)       { base = (unsigned short*)(ws + OFF_CVG); ld = 1024; colt = pn * 256; if (pn < 2) { c0 = 1.f; c1 = 0.f; c2 = 0.f; } else { c0 = 0.f; c1 = 1.f; c2 = 0.f; } sgn = 1.f; }
        else if (pn < 8)  { base = (unsigned short*)(ws + OFF_Q);   ld = 1024; colt = (pn - 4) * 256;  c0 = 0.f; c1 = 0.f; c2 = 1.f; sgn = 1.f; }
        else if (pn < 12) { base = (unsigned short*)(ws + OFF_KIN); ld = 1024; colt = (pn - 8) * 256;  c0 = 0.f; c1 = 1.f; c2 = 0.f; sgn = -1.f; f16 = true; }
        else if (pn < 16) { base = (unsigned short*)(ws + OFF_V);   ld = 1024; colt = (pn - 12) * 256; c0 = 1.f; c1 = 0.f; c2 = 0.f; sgn = 1.f; }
        else if (pn < 20) { base = (unsigned short*)(ws + OFF_G);   ld = 1024; colt = (pn - 16) * 256; c0 = 0.f; c1 = 0.f; c2 = 1.f; sgn = 1.f; }
        else              { base = mgate;                           ld = 2048; colt = (pn - 20) * 256; c0 = 0.f; c1 = 1.f; c2 = 0.f; sgn = 1.f; }
        const int row0 = u.pm * 256 + wr * 64 + fr, coll = wc * 32 + 8 * fq;
        f32x4 cs[2][2];
#pragma unroll
        for (int bj = 0; bj < 2; ++bj)
#pragma unroll
            for (int n = 0; n < 2; ++n) cs[bj][n] = f16 ? *(const f32x4*)(colscale + pn * 256 + bj * 128 + coll + 4 * n) : (f32x4){1.f, 1.f, 1.f, 1.f};
#pragma unroll
        for (int ai = 0; ai < 2; ++ai)
#pragma unroll
            for (int m = 0; m < 4; ++m) {
                unsigned short* rowp = base + (size_t)(row0 + ai * 128 + m * 16) * ld + colt + coll;
#pragma unroll
                for (int bj = 0; bj < 2; ++bj) {
                    float o[8];
#pragma unroll
                    for (int n = 0; n < 2; ++n)
#pragma unroll
                        for (int j = 0; j < 4; ++j) { const float z = acc[ai][bj][m][n][j]; const float s = __builtin_amdgcn_rcpf(1.0f + __expf(-sgn * z)); o[n * 4 + j] = (c0 * z + s * (c1 + c2 * z)) * cs[bj][n][j]; }
                    const u32x4 pkh = (u32x4){pk_f16(o[0], o[1]), pk_f16(o[2], o[3]), pk_f16(o[4], o[5]), pk_f16(o[6], o[7])};
                    const u32x4 pkb = (u32x4){cvt_pk_bf16(o[0], o[1]), cvt_pk_bf16(o[2], o[3]), cvt_pk_bf16(o[4], o[5]), cvt_pk_bf16(o[6], o[7])};
                    u32x4 pk;
#pragma unroll
                    for (int q = 0; q < 4; ++q) pk[q] = f16 ? pkh[q] : pkb[q];
                    *(u32x4*)(rowp + bj * 128) = pk;
                }
            }
    }
};
struct EpiMix {
    static constexpr bool PERM = false;
    const unsigned short* mgate; unsigned short* mixed;
    __device__ __forceinline__ void mid(f32x4 (&acc)[2][2][4][2], const Unit& u, int wr, int wc, int fr, int fq) const {
        const int row0 = u.pm * 256 + wr * 64 + fr, col0 = u.pn * 256 + wc * 32 + 4 * fq;
#pragma unroll
        for (int ai = 0; ai < 2; ++ai)
#pragma unroll
            for (int m = 0; m < 4; ++m) { const size_t r = (size_t)(row0 + ai * 128 + m * 16);
#pragma unroll
                for (int bj = 0; bj < 2; ++bj)
#pragma unroll
                    for (int n = 0; n < 2; ++n) { const int c = col0 + bj * 128 + n * 16;
                        const u32x2 ga = *(const u32x2*)(mgate + r * 2048 + c);
                        acc[ai][bj][m][n][0] *= bflo(ga[0]); acc[ai][bj][m][n][1] *= bfhi(ga[0]);
                        acc[ai][bj][m][n][2] *= bflo(ga[1]); acc[ai][bj][m][n][3] *= bfhi(ga[1]); } }
    }
    __device__ __forceinline__ void operator()(const f32x4 (&acc)[2][2][4][2], const Unit& u, int wr, int wc, int fr, int fq) const {
        const int row0 = u.pm * 256 + wr * 64 + fr, col0 = u.pn * 256 + wc * 32 + 4 * fq;
#pragma unroll
        for (int ai = 0; ai < 2; ++ai)
#pragma unroll
            for (int m = 0; m < 4; ++m) { const size_t r = (size_t)(row0 + ai * 128 + m * 16);
#pragma unroll
                for (int bj = 0; bj < 2; ++bj)
#pragma unroll
                    for (int n = 0; n < 2; ++n) { const int c = col0 + bj * 128 + n * 16;
                        const u32x2 gb = *(const u32x2*)(mgate + r * 2048 + 1024 + c);
                        const f32x4 v = acc[ai][bj][m][n];
                        *(u32x2*)(mixed + r * 1024 + c) = (u32x2){cvt_pk_bf16(v[0] * bflo(gb[0]), v[1] * bfhi(gb[0])), cvt_pk_bf16(v[2] * bflo(gb[1]), v[3] * bfhi(gb[1]))}; } }
    }
};
struct EpiRes {
    static constexpr bool PERM = false;
    const float* res; float* dst;
    __device__ __forceinline__ void operator()(const f32x4 (&acc)[2][2][4][2], const Unit& u, int wr, int wc, int fr, int fq) const {
        const int row0 = u.pm * 256 + wr * 64 + fr, col0 = u.pn * 256 + wc * 32 + 4 * fq;
#pragma unroll
        for (int ai = 0; ai < 2; ++ai)
#pragma unroll
            for (int m = 0; m < 4; ++m) { const size_t r = (size_t)(row0 + ai * 128 + m * 16);
#pragma unroll
                for (int bj = 0; bj < 2; ++bj)
#pragma unroll
                    for (int n = 0; n < 2; ++n) { const int c = col0 + bj * 128 + n * 16;
                        const f32x4 t = *(const f32x4*)(res + r * 1024 + c);
                        *(f32x4*)(dst + r * 1024 + c) = t * ALPHA + acc[ai][bj][m][n]; } }
    }
};
struct EpiResB {
    static constexpr bool PERM = false;
    const unsigned short* res; float* dst;
    __device__ __forceinline__ void operator()(const f32x4 (&acc)[2][2][4][2], const Unit& u, int wr, int wc, int fr, int fq) const {
        const int row0 = u.pm * 256 + wr * 64 + fr, col0 = u.pn * 256 + wc * 32 + 4 * fq;
#pragma unroll
        for (int ai = 0; ai < 2; ++ai)
#pragma unroll
            for (int m = 0; m < 4; ++m) { const size_t r = (size_t)(row0 + ai * 128 + m * 16);
#pragma unroll
                for (int bj = 0; bj < 2; ++bj)
#pragma unroll
                    for (int n = 0; n < 2; ++n) { const int c = col0 + bj * 128 + n * 16;
                        const u32x2 t = *(const u32x2*)(res + r * 1024 + c);
                        const f32x4 tv = (f32x4){bflo(t[0]), bfhi(t[0]), bflo(t[1]), bfhi(t[1])};
                        *(f32x4*)(dst + r * 1024 + c) = tv * ALPHA + acc[ai][bj][m][n]; } }
    }
};
template <int MODE  > struct EpiLn {
    static constexpr bool PERM = false;
    const void* res; void* outp; const float* gam; const float* bet; float* part; unsigned* cnt; LAS unsigned char* ldsx;
    __device__ __forceinline__ void operator()(f32x4 (&acc)[2][2][4][2], const Unit& u, int wr, int wc, int fr, int fq) const {
        const int row0 = u.pm * 256 + wr * 64 + fr, col0 = u.pn * 256 + wc * 32 + 4 * fq;
        LAS float* red = (LAS float*)ldsx;
        LAS float* stats = (LAS float*)(ldsx + 8192);
#pragma unroll
        for (int ai = 0; ai < 2; ++ai)
#pragma unroll
            for (int m = 0; m < 4; ++m) { const size_t r = (size_t)(row0 + ai * 128 + m * 16);
                float s1 = 0.f, s2 = 0.f;
#pragma unroll
                for (int bj = 0; bj < 2; ++bj)
#pragma unroll
                    for (int n = 0; n < 2; ++n) { const int c = col0 + bj * 128 + n * 16;
                        f32x4 tv;
                        if (MODE == 0) tv = *(const f32x4*)((const float*)res + r * 1024 + c);
                        else { const u32x2 t = *(const u32x2*)((const unsigned short*)res + r * 1024 + c); tv = (f32x4){bflo(t[0]), bfhi(t[0]), bflo(t[1]), bfhi(t[1])}; }
                        const f32x4 v = tv * ALPHA + acc[ai][bj][m][n];
                        acc[ai][bj][m][n] = v;
                        s1 += v[0] + v[1] + v[2] + v[3]; s2 += v[0] * v[0] + v[1] * v[1] + v[2] * v[2] + v[3] * v[3]; }
                s1 += __shfl_xor(s1, 16); s1 += __shfl_xor(s1, 32); s2 += __shfl_xor(s2, 16); s2 += __shfl_xor(s2, 32);
                if (fq == 0) { const int rl = ai * 128 + wr * 64 + m * 16 + fr; red[(rl * 4 + wc) * 2] = s1; red[(rl * 4 + wc) * 2 + 1] = s2; } }
        __syncthreads();
        if (wc == 0) {
            const int lane = fq * 16 + fr;
            unsigned* cw = cnt + (size_t)(u.pm * 2 + wr) * 64;
            float* mypart = part + ((size_t)(u.pm * 4 + u.pn) * 256) * 2;
#pragma unroll
            for (int q = 0; q < 2; ++q) { const int i = lane + 64 * q, rl = (i >> 6) * 128 + wr * 64 + (i & 63);
                float t1 = 0.f, t2 = 0.f;
#pragma unroll
                for (int w4 = 0; w4 < 4; ++w4) { t1 += red[(rl * 4 + w4) * 2]; t2 += red[(rl * 4 + w4) * 2 + 1]; }
                const unsigned long long pv = (unsigned long long)__float_as_uint(t1) | ((unsigned long long)__float_as_uint(t2) << 32);
                __hip_atomic_store((unsigned long long*)(mypart + rl * 2), pv, __ATOMIC_RELAXED, __HIP_MEMORY_SCOPE_AGENT); }
            asm volatile("s_waitcnt vmcnt(0)" ::: "memory");
            if (lane == 0) (void)__hip_atomic_fetch_add(cw, 1u, __ATOMIC_RELAXED, __HIP_MEMORY_SCOPE_AGENT);
            { unsigned sp = 0;
              while ((unsigned)__builtin_amdgcn_readfirstlane(__hip_atomic_load(cw, __ATOMIC_RELAXED, __HIP_MEMORY_SCOPE_AGENT)) < 4u) { __builtin_amdgcn_s_sleep(1); if (++sp > (1u << 22)) break; } }
            asm volatile("" ::: "memory");
#pragma unroll
            for (int q = 0; q < 2; ++q) { const int i = lane + 64 * q, rl = (i >> 6) * 128 + wr * 64 + (i & 63);
                float t1 = 0.f, t2 = 0.f;
#pragma unroll
                for (int pn = 0; pn < 4; ++pn) { const unsigned long long pv = __hip_atomic_load((unsigned long long*)(part + ((size_t)(u.pm * 4 + pn) * 256 + rl) * 2), __ATOMIC_RELAXED, __HIP_MEMORY_SCOPE_AGENT);
                    t1 += __uint_as_float((unsigned)pv); t2 += __uint_as_float((unsigned)(pv >> 32)); }
                const float mean = t1 * (1.0f / 1024.0f); const float var = fmaxf(t2 * (1.0f / 1024.0f) - mean * mean, 0.f);
                stats[rl * 2] = mean; stats[rl * 2 + 1] = rsqrtf(var + LN_EPS); }
        }
        __syncthreads();
#pragma unroll
        for (int ai = 0; ai < 2; ++ai)
#pragma unroll
            for (int m = 0; m < 4; ++m) { const size_t r = (size_t)(row0 + ai * 128 + m * 16); const int rl = ai * 128 + wr * 64 + m * 16 + fr;
                const float mean = stats[rl * 2], rstd = stats[rl * 2 + 1];
#pragma unroll
                for (int bj = 0; bj < 2; ++bj)
#pragma unroll
                    for (int n = 0; n < 2; ++n) { const int c = col0 + bj * 128 + n * 16;
                        const f32x4 gv = *(const f32x4*)(gam + c), bv = *(const f32x4*)(bet + c);
                        const f32x4 y = (acc[ai][bj][m][n] - mean) * rstd * gv + bv;
                        if (MODE == 0) *(u32x2*)((unsigned short*)outp + r * 1024 + c) = (u32x2){cvt_pk_bf16(y[0], y[1]), cvt_pk_bf16(y[2], y[3])};
                        else *(f32x4*)((float*)outp + r * 1024 + c) = y; } }
    }
};
struct EpiZ {
    static constexpr bool PERM = true;
    unsigned short* z; int ld;
    __device__ __forceinline__ void operator()(const f32x4 (&acc)[2][2][4][2], const Unit& u, int wr, int wc, int fr, int fq) const {
        const int row0 = u.pm * 256 + wr * 64 + fr, col0 = u.pn * 256 + wc * 32 + 8 * fq;
#pragma unroll
        for (int ai = 0; ai < 2; ++ai)
#pragma unroll
            for (int m = 0; m < 4; ++m) { unsigned short* rowp = z + (size_t)(row0 + ai * 128 + m * 16) * ld + col0;
#pragma unroll
                for (int bj = 0; bj < 2; ++bj) { const f32x4 v0 = acc[ai][bj][m][0], v1 = acc[ai][bj][m][1];
                    *(u32x4*)(rowp + bj * 128) = (u32x4){cvt_pk_bf16(v0[0], v0[1]), cvt_pk_bf16(v0[2], v0[3]), cvt_pk_bf16(v1[0], v1[1]), cvt_pk_bf16(v1[2], v1[3])}; } }
    }
};

__device__ void transpose_convert(const float* __restrict__ src, unsigned short* __restrict__ dst, int K, int N, float* tile  , int ldd = 0, const bool pair_m = false) {
    if (ldd == 0) ldd = K;
    auto srcblk = [&](int tn) -> int { if (!pair_m || tn < 80) return tn; const int q = tn - 80, tt = q >> 2, r4 = q & 3; return (r4 < 2) ? (80 + tt * 2 + r4) : (96 + tt * 2 + (r4 - 2)); };
    const int tid = threadIdx.x; const int nk = K / 64, nn = N / 64, ntile = nk * nn;
    const int r = tid >> 3, c = (tid & 7) * 8;
    f32x4 a, b;
    int t = blockIdx.x;
    if (t < ntile) { const int tk = t / nn, tn = t % nn; const float* p = src + (size_t)(tk * 64 + r) * N + srcblk(tn) * 64 + c; a = *(const f32x4*)p; b = *(const f32x4*)(p + 4); }
    for (; t < ntile; t += gridDim.x) {
        const int tk = t / nn, tn = t % nn;
        { float* q = tile + r * 65 + c; q[0] = a[0]; q[1] = a[1]; q[2] = a[2]; q[3] = a[3]; q[4] = b[0]; q[5] = b[1]; q[6] = b[2]; q[7] = b[3]; }
        __syncthreads();
        { const int t2 = t + gridDim.x;
          if (t2 < ntile) { const int tk2 = t2 / nn, tn2 = t2 % nn; const float* p = src + (size_t)(tk2 * 64 + r) * N + srcblk(tn2) * 64 + c; a = *(const f32x4*)p; b = *(const f32x4*)(p + 4); } }
        { const int n = tid >> 3, k0 = (tid & 7) * 8; float v[8];
#pragma unroll
          for (int j = 0; j < 8; ++j) v[j] = tile[(k0 + j) * 65 + n];
          *(u32x4*)(dst + (size_t)(tn * 64 + n) * ldd + tk * 64 + k0) = (u32x4){cvt_pk_bf16(v[0], v[1]), cvt_pk_bf16(v[2], v[3]), cvt_pk_bf16(v[4], v[5]), cvt_pk_bf16(v[6], v[7])}; }
        __syncthreads();
    }
}
__device__ void phase_prep(const Params& p, unsigned char* lds_generic) {
    float* tile = (float*)lds_generic;
    unsigned char* ws = p.ws;
    { const size_t n8 = (size_t)T_TOK * DM / 8; unsigned short* xb = (unsigned short*)(ws + OFF_XB);
      const size_t stride = (size_t)gridDim.x * NTHREADS;
      for (size_t i = (size_t)blockIdx.x * NTHREADS + threadIdx.x; i < n8; i += 4 * stride) {
          f32x4 a[4], b[4];
#pragma unroll
          for (int j = 0; j < 4; ++j) { const size_t ii = i + j * stride; if (ii < n8) { a[j] = *(const f32x4*)(p.x + ii * 8); b[j] = *(const f32x4*)(p.x + ii * 8 + 4); } }
#pragma unroll
          for (int j = 0; j < 4; ++j) { const size_t ii = i + j * stride; if (ii < n8)
              *(u32x4*)(xb + ii * 8) = (u32x4){cvt_pk_bf16(a[j][0], a[j][1]), cvt_pk_bf16(a[j][2], a[j][3]), cvt_pk_bf16(b[j][0], b[j][1]), cvt_pk_bf16(b[j][2], b[j][3])}; } } }
    { float* cs = (float*)(ws + OFF_MISC);
      for (int i = blockIdx.x * NTHREADS + threadIdx.x; i < IN_COLS; i += gridDim.x * NTHREADS) {
          float v = 1.0f;
          if (i >= 2048 && i < 3072) { const int c = i - 2048; const float l0 = p.lb_logits[c], l1 = p.lb_logits[HG + c]; const float lb = 1.0f / (1.0f + expf(l1 - l0)); v = 1.0f - lb; }
          cs[i] = v; } }
    transpose_convert(p.w_in, (unsigned short*)(ws + OFF_WIN), DM, IN_COLS, tile, 0, true);
    transpose_convert(p.w_conv_out, (unsigned short*)(ws + OFF_WCO), CONV_DIM, DM, tile, CONV_DIM + HG);
    transpose_convert(p.w_hgrn_out, (unsigned short*)(ws + OFF_WCO) + CONV_DIM, HG, DM, tile, CONV_DIM + HG);
    transpose_convert(p.w_out, (unsigned short*)(ws + OFF_WOUT), DM, DM, tile);
    transpose_convert(p.w_ffn_in, (unsigned short*)(ws + OFF_WFI), DM, 2 * DFF, tile);
    transpose_convert(p.w_ffn_out, (unsigned short*)(ws + OFF_WFO), DFF, DM, tile);
}

__device__ void phase_conv(const Params& p, unsigned char* lds) {
    unsigned short* gin = (unsigned short*)lds;
    float* obuf = (float*)(lds + 96256);
    const unsigned short* cvg = (const unsigned short*)(p.ws + OFF_CVG);
    unsigned short* cout = (unsigned short*)(p.ws + OFF_XB);
    const int tid = threadIdx.x, wid = tid >> 6, lane = tid & 63;
    float w[CONV_K];
#pragma unroll
    for (int k = 0; k < CONV_K; ++k) w[k] = p.w_conv_dw[k * CONV_DIM + tid];
    const float bias = p.b_conv_dw[tid];
    float lg[8], lb[8];
#pragma unroll
    for (int j = 0; j < 8; ++j) { lg[j] = p.conv_ln_g[lane * 8 + j]; lb[j] = p.conv_ln_b[lane * 8 + j]; }
    for (int tile = blockIdx.x; tile < T_TOK / 64; tile += gridDim.x) {
        const int t0 = tile * 64, pos0 = t0 % SEQ;
        __syncthreads();
#pragma unroll
        for (int it0 = 0; it0 < 12; it0 += 4) {
            u32x4 av[4], bv[4];
#pragma unroll
            for (int q = 0; q < 4; ++q) { const int i = tid + (it0 + q) * NTHREADS; const int row = i >> 6, c8 = (i & 63) * 8; const int pos = pos0 + row - 30;
                const bool valid = (i < 94 * 64) && (pos >= 0);
                const size_t tk = valid ? (size_t)(t0 + row - 30) : (size_t)t0;
                av[q] = *(const u32x4*)(cvg + tk * 1024 + c8); bv[q] = *(const u32x4*)(cvg + tk * 1024 + 512 + c8);
                if (!valid) { av[q] = (u32x4){0u, 0u, 0u, 0u}; bv[q] = av[q]; } }
#pragma unroll
            for (int q = 0; q < 4; ++q) { const int i = tid + (it0 + q) * NTHREADS; const int row = i >> 6, c8 = (i & 63) * 8;
                if (i < 94 * 64) { u32x4 o;
#pragma unroll
                    for (int j = 0; j < 4; ++j) o[j] = cvt_pk_bf16(bflo(av[q][j]) * bflo(bv[q][j]), bfhi(av[q][j]) * bfhi(bv[q][j]));
                    *(u32x4*)(gin + row * 512 + c8) = o; } }
        }
        __syncthreads();
        for (int rr = 0; rr < 4; ++rr) {
            float in[46];
#pragma unroll
            for (int j = 0; j < 46; ++j) in[j] = bf2f(gin[(rr * 16 + j) * 512 + tid]);
#pragma unroll
            for (int i = 0; i < 16; ++i) { float a = bias;
#pragma unroll
                for (int k = 0; k < CONV_K; ++k) a += w[k] * in[i + k];
                obuf[i * 512 + tid] = a; }
            __syncthreads();
#pragma unroll
            for (int q = 0; q < 2; ++q) { const int i = wid * 2 + q; const float* rp = obuf + i * 512 + lane * 8;
                const f32x4 a = *(const f32x4*)rp, b = *(const f32x4*)(rp + 4);
                float v[8] = {a[0], a[1], a[2], a[3], b[0], b[1], b[2], b[3]};
                float s = 0.f;
#pragma unroll
                for (int j = 0; j < 8; ++j) s += v[j];
                const float mean = wave_sum(s) * (1.0f / 512.0f);
                float ss = 0.f;
#pragma unroll
                for (int j = 0; j < 8; ++j) { v[j] -= mean; ss += v[j] * v[j]; }
                const float rstd = rsqrtf(wave_sum(ss) * (1.0f / 512.0f) + LN_EPS);
                float y[8];
#pragma unroll
                for (int j = 0; j < 8; ++j) { const float t = v[j] * rstd * lg[j] + lb[j]; y[j] = t * sigmoidf_(t); }
                *(u32x4*)(cout + (size_t)(t0 + rr * 16 + i) * 512 + lane * 8) = (u32x4){cvt_pk_bf16(y[0], y[1]), cvt_pk_bf16(y[2], y[3]), cvt_pk_bf16(y[4], y[5]), cvt_pk_bf16(y[6], y[7])}; }
            __syncthreads();
        }
    }
}

constexpr int H_QT = 0;
constexpr int H_KN = H_QT + 64 * 272;
constexpr int H_KT = H_KN + 64 * 272;
constexpr int H_VT = H_KT + 128 * 144;
constexpr int H_PP = H_VT + 128 * 144;
constexpr int H_SB = H_PP + 64 * 144;
constexpr int H_SEG = H_SB + 128 * 272;
constexpr int H_ER = H_SEG + 8192;
constexpr int H_EBL = H_ER + 512;
constexpr int H_SS = H_EBL + 512;
constexpr int H_END = H_SS + 2048;
static_assert(H_END <= LDS_BYTES, "hgrn lds");

template <bool OUT>
__device__ void hgrn_phase(const Params& p, unsigned char* lds, const int reps = 1) {
    const int tid = threadIdx.x, w = tid >> 6, lane = tid & 63, g = lane >> 4, c16 = lane & 15;
    const unsigned short* qg = (const unsigned short*)(p.ws + OFF_Q);
    const unsigned short* king = (const unsigned short*)(p.ws + OFF_KIN);
    const unsigned short* vg = (const unsigned short*)(p.ws + OFF_V);
    const unsigned short* gg = (const unsigned short*)(p.ws + OFF_G);
    unsigned short* og = (unsigned short*)(p.ws + OFF_CVG);
    float* segsum = (float*)(lds + H_SEG); float* er = (float*)(lds + H_ER); float* ebl = (float*)(lds + H_EBL); float* ssb = (float*)(lds + H_SS);
    const int kp = tid & 63;
    const int nchain = (256 - (int)blockIdx.x + (int)gridDim.x - 1) / (int)gridDim.x, nstep = nchain * 16 * reps;

    unsigned kraw[8], vraw[8], qraw[8];
    auto chunk_base = [&](int step) -> size_t {
        const int chain = blockIdx.x + ((step >> 4) % nchain) * gridDim.x, item = chain * 4 + ((step >> 2) & 3), c = step & 3;
        const int bh = item >> 5, sc = item & 31, b = bh >> 3, h = bh & 7;
        return ((size_t)b * SEQ + (size_t)sc * 256 + 64 * c + 8 * w) * 1024 + h * 128 + 2 * kp;
    };
    auto load_raw = [&](int step) {
        const size_t gbase = chunk_base(step);
#pragma unroll
        for (int tt = 0; tt < 8; ++tt) kraw[tt] = *(const unsigned*)(king + gbase + (size_t)tt * 1024);
#pragma unroll
        for (int tt = 0; tt < 8; ++tt) vraw[tt] = *(const unsigned*)(vg + gbase + (size_t)tt * 1024);
        if (OUT) {
#pragma unroll
            for (int tt = 0; tt < 8; ++tt) qraw[tt] = *(const unsigned*)(qg + gbase + (size_t)tt * 1024);
        }
    };
    float lf0[8], lf1[8], k0[8], k1[8];
    auto part1 = [&](int step) {
        float run0 = 0.f, run1 = 0.f;
#pragma unroll
        for (int tt = 0; tt < 8; ++tt) {
            const unsigned short lo = (unsigned short)(kraw[tt] & 0xffffu), hi = (unsigned short)(kraw[tt] >> 16);
            _Float16 hl, hh; __builtin_memcpy(&hl, &lo, 2); __builtin_memcpy(&hh, &hi, 2);
            k0[tt] = (float)hl; k1[tt] = (float)hh;
            run0 += __logf(fmaxf(1.0f - k0[tt], 1e-30f)); lf0[tt] = run0; run1 += __logf(fmaxf(1.0f - k1[tt], 1e-30f)); lf1[tt] = run1; }
        *(f32x2*)(segsum + (step & 1) * 1024 + w * 128 + 2 * kp) = (f32x2){run0, run1};
    };
    if (nstep > 0) { load_raw(0); part1(0); }

    f32x4 S[8];
    f32x4 gn = (f32x4){0.f, 0.f, 0.f, 0.f};
    float btot0 = 0.f, btot1 = 0.f;
    for (int step = 0; step < nstep; ++step) {
        const int chain = blockIdx.x + ((step >> 4) % nchain) * gridDim.x, jj = (step >> 2) & 3, item = chain * 4 + jj, c = step & 3;
        const int bh = item >> 5, sc = item & 31, b = bh >> 3, h = bh & 7;
        const size_t tc = (size_t)b * SEQ + (size_t)sc * 256 + 64 * c; const int ch0 = h * 128;
        unsigned short* Lg = (unsigned short*)(p.ws + OFF_L) + (size_t)chain * 16384;
        if (c == 0 && jj == 0) {
#pragma unroll
            for (int kt = 0; kt < 8; ++kt) {
                S[kt] = (f32x4){0.f, 0.f, 0.f, 0.f};
            }
            if (OUT) {
                const int nprev = chain & 7;
                for (int j = 0; j < nprev; ++j) {
                    const unsigned short* Lj = (const unsigned short*)(p.ws + OFF_L) + (size_t)((chain & ~7) + j) * 16384;
                    const float* Dj = (const float*)(p.ws + OFF_D) + (size_t)((chain & ~7) + j) * 128;
#pragma unroll
                    for (int kt = 0; kt < 8; ++kt) {
                        const u32x2 lv = *(const u32x2*)(Lj + (16 * w + c16) * 128 + 16 * kt + 4 * g);
                        const f32x4 dv = *(const f32x4*)(Dj + 16 * kt + 4 * g);
                        S[kt] = S[kt] * dv + (f32x4){bflo(lv[0]), bfhi(lv[0]), bflo(lv[1]), bfhi(lv[1])}; }
                }
            }
            if (OUT) gn = *(const f32x4*)(p.hgrn_norm_g + ch0 + 16 * w + 4 * g);
            btot0 = 0.f; btot1 = 0.f;
        }
        {
            __syncthreads();
            float off0 = 0.f, off1 = 0.f, r0 = 0.f, r1 = 0.f, bl0 = 0.f, bl1 = 0.f;
#pragma unroll
            for (int sg = 0; sg < 8; ++sg) { const f32x2 sv = *(const f32x2*)(segsum + (step & 1) * 1024 + sg * 128 + 2 * kp);
                if (sg < w) { off0 += sv[0]; off1 += sv[1]; }
                if (sg < 4) { r0 += sv[0]; r1 += sv[1]; }
                bl0 += sv[0]; bl1 += sv[1]; }
            unsigned short kb0[8], kb1[8];
#pragma unroll
            for (int tt = 0; tt < 8; ++tt) {
                const float b0 = off0 + lf0[tt], b1 = off1 + lf1[tt];
                const float kt0 = k0[tt] * __expf(fminf(r0 - b0, 80.f)), kt1 = k1[tt] * __expf(fminf(r1 - b1, 80.f));
                const unsigned kpk = cvt_pk_bf16(kt0, kt1);
                kb0[tt] = (unsigned short)(kpk & 0xffffu); kb1[tt] = (unsigned short)(kpk >> 16);
                if (OUT) {
                    *(unsigned*)(lds + H_KN + (8 * w + tt) * 272 + kp * 4) = kpk;
                    const float q0 = bflo(qraw[tt]) * __expf(fminf(b0 - r0, 80.f)), q1 = bfhi(qraw[tt]) * __expf(fminf(b1 - r1, 80.f));
                    *(unsigned*)(lds + H_QT + (8 * w + tt) * 272 + kp * 4) = cvt_pk_bf16(q0, q1);
                }
            }
            u32x4 ka, kbv, va, vb;
#pragma unroll
            for (int j = 0; j < 4; ++j) {
                ka[j] = (unsigned)kb0[2 * j] | ((unsigned)kb0[2 * j + 1] << 16);
                kbv[j] = (unsigned)kb1[2 * j] | ((unsigned)kb1[2 * j + 1] << 16);
                va[j] = (vraw[2 * j] & 0xffffu) | (vraw[2 * j + 1] << 16);
                vb[j] = (vraw[2 * j] >> 16) | (vraw[2 * j + 1] & 0xffff0000u); }
            *(u32x4*)(lds + H_KT + (2 * kp) * 144 + w * 16) = ka;
            *(u32x4*)(lds + H_KT + (2 * kp + 1) * 144 + w * 16) = kbv;
            *(u32x4*)(lds + H_VT + (2 * kp) * 144 + w * 16) = va;
            *(u32x4*)(lds + H_VT + (2 * kp + 1) * 144 + w * 16) = vb;
            if (w == 0) { *(f32x2*)(er + 2 * kp) = (f32x2){__expf(r0), __expf(r1)}; *(f32x2*)(ebl + 2 * kp) = (f32x2){__expf(bl0 - r0), __expf(bl1 - r1)}; btot0 += bl0; btot1 += bl1; }
        }
        __syncthreads();
        if (step + 1 < nstep) load_raw(step + 1);
#pragma unroll
        for (int kt = 0; kt < 8; ++kt) {
            const f32x4 e = *(const f32x4*)(er + 16 * kt + 4 * g);
            S[kt] = S[kt] * e;
            if (OUT) *(u32x2*)(lds + H_SB + (16 * w + c16) * 272 + (16 * kt + 4 * g) * 2) = (u32x2){cvt_pk_bf16(S[kt][0], S[kt][1]), cvt_pk_bf16(S[kt][2], S[kt][3])};
        }
        if (OUT) {
#pragma unroll
            for (int i = 0; i < 2; ++i) {
                const int id = 2 * w + i, st = id >> 2, tt = id & 3;
                f32x4 a4 = (f32x4){0.f, 0.f, 0.f, 0.f};
                if (st <= tt) {
#pragma unroll
                    for (int ks = 0; ks < 4; ++ks) {
                        const bf16x8 af = *(const bf16x8*)(lds + H_KN + (16 * st + c16) * 272 + (32 * ks + 8 * g) * 2);
                        const bf16x8 bf = *(const bf16x8*)(lds + H_QT + (16 * tt + c16) * 272 + (32 * ks + 8 * g) * 2);
                        a4 = __builtin_amdgcn_mfma_f32_16x16x32_bf16(af, bf, a4, 0, 0, 0);
                    }
                    const int tcol = 16 * tt + c16;
#pragma unroll
                    for (int r = 0; r < 4; ++r) { const int srow = 16 * st + 4 * g + r; if (srow > tcol) a4[r] = 0.f; }
                }
                *(u32x2*)(lds + H_PP + (16 * tt + c16) * 144 + (16 * st + 4 * g) * 2) = (u32x2){cvt_pk_bf16(a4[0], a4[1]), cvt_pk_bf16(a4[2], a4[3])};
            }
        }
        __syncthreads();
        f32x4 O[4];
        u32x2 gzv[4];
        if (OUT) {
#pragma unroll
            for (int tt = 0; tt < 4; ++tt) gzv[tt] = *(const u32x2*)(gg + (tc + 16 * tt + c16) * 1024 + ch0 + 16 * w + 4 * g);
        }
        if (OUT) {
#pragma unroll
            for (int tt = 0; tt < 4; ++tt) {
                f32x4 a4 = (f32x4){0.f, 0.f, 0.f, 0.f};
#pragma unroll
                for (int ks = 0; ks < 2; ++ks) {
                    const bf16x8 af = *(const bf16x8*)(lds + H_VT + (16 * w + c16) * 144 + (32 * ks + 8 * g) * 2);
                    const bf16x8 bf = *(const bf16x8*)(lds + H_PP + (16 * tt + c16) * 144 + (32 * ks + 8 * g) * 2);
                    a4 = __builtin_amdgcn_mfma_f32_16x16x32_bf16(af, bf, a4, 0, 0, 0);
                }
#pragma unroll
                for (int ks = 0; ks < 4; ++ks) {
                    const bf16x8 af = *(const bf16x8*)(lds + H_SB + (16 * w + c16) * 272 + (32 * ks + 8 * g) * 2);
                    const bf16x8 bf = *(const bf16x8*)(lds + H_QT + (16 * tt + c16) * 272 + (32 * ks + 8 * g) * 2);
                    a4 = __builtin_amdgcn_mfma_f32_16x16x32_bf16(af, bf, a4, 0, 0, 0);
                }
                O[tt] = a4;
            }
        }
#pragma unroll
        for (int kt = 0; kt < 8; ++kt) {
#pragma unroll
            for (int ks = 0; ks < 2; ++ks) {
                const bf16x8 af = *(const bf16x8*)(lds + H_KT + (16 * kt + c16) * 144 + (32 * ks + 8 * g) * 2);
                const bf16x8 bf = *(const bf16x8*)(lds + H_VT + (16 * w + c16) * 144 + (32 * ks + 8 * g) * 2);
                S[kt] = __builtin_amdgcn_mfma_f32_16x16x32_bf16(af, bf, S[kt], 0, 0, 0);
            }
            const f32x4 e = *(const f32x4*)(ebl + 16 * kt + 4 * g);
            S[kt] = S[kt] * e;
        }
        if (OUT) {
#pragma unroll
            for (int tt = 0; tt < 4; ++tt) {
                float s = O[tt][0] * O[tt][0] + O[tt][1] * O[tt][1] + O[tt][2] * O[tt][2] + O[tt][3] * O[tt][3];
                s += __shfl_xor(s, 16); s += __shfl_xor(s, 32);
                if (g == 0) ssb[w * 64 + 16 * tt + c16] = s;
            }
            __syncthreads();
#pragma unroll
            for (int tt = 0; tt < 4; ++tt) {
                const int t = 16 * tt + c16; float tot = 0.f;
#pragma unroll
                for (int ww = 0; ww < 8; ++ww) tot += ssb[ww * 64 + t];
                const float rs = rsqrtf(tot * (1.0f / 128.0f) + RMS_EPS);
                const size_t gi = (tc + t) * 1024 + ch0 + 16 * w + 4 * g;
                const u32x2 gz = gzv[tt];
                const float o0 = bf2f(f2bf(O[tt][0] * rs * gn[0])) * bflo(gz[0]), o1 = bf2f(f2bf(O[tt][1] * rs * gn[1])) * bfhi(gz[0]);
                const float o2 = bf2f(f2bf(O[tt][2] * rs * gn[2])) * bflo(gz[1]), o3 = bf2f(f2bf(O[tt][3] * rs * gn[3])) * bfhi(gz[1]);
                *(u32x2*)(og + gi) = (u32x2){cvt_pk_bf16(o0, o1), cvt_pk_bf16(o2, o3)};
            }
        }
        if (!OUT && c == 3 && jj == 3) {
            float* Dg = (float*)(p.ws + OFF_D) + (size_t)chain * 128;
#pragma unroll
            for (int kt = 0; kt < 8; ++kt)
                *(u32x2*)(Lg + (16 * w + c16) * 128 + 16 * kt + 4 * g) = (u32x2){cvt_pk_bf16(S[kt][0], S[kt][1]), cvt_pk_bf16(S[kt][2], S[kt][3])};
            if (w == 0) *(f32x2*)(Dg + 2 * kp) = (f32x2){__expf(btot0), __expf(btot1)};
        }
        if (step + 1 < nstep) part1(step + 1);
    }
    __syncthreads();
}

__device__ void phase_scan(const Params& p) {
    unsigned short* L = (unsigned short*)(p.ws + OFF_L); const float* D = (const float*)(p.ws + OFF_D);
    for (int i = blockIdx.x * NTHREADS + threadIdx.x; i < 32 * 4096; i += gridDim.x * NTHREADS) {
        const int bh = i >> 12, e4 = i & 4095, k0 = (e4 & 31) * 4;
        f32x4 carry = (f32x4){0.f, 0.f, 0.f, 0.f};
        u32x2 v[8]; f32x4 d[8];
#pragma unroll
        for (int s = 0; s < 8; ++s) { const int chain = bh * 8 + s; v[s] = *(const u32x2*)(L + (size_t)chain * 16384 + e4 * 4); d[s] = *(const f32x4*)(D + chain * 128 + k0); }
#pragma unroll
        for (int s = 0; s < 8; ++s) { const int chain = bh * 8 + s;
            *(u32x2*)(L + (size_t)chain * 16384 + e4 * 4) = (u32x2){cvt_pk_bf16(carry[0], carry[1]), cvt_pk_bf16(carry[2], carry[3])};
            const f32x4 lv = (f32x4){bflo(v[s][0]), bfhi(v[s][0]), bflo(v[s][1]), bfhi(v[s][1])};
            carry = carry * d[s] + lv; }
    }
}

__device__ void phase_ln(float* buf, const float* gam, const float* bet, unsigned short* copyb) {
    const int lane = threadIdx.x & 63, wv = blockIdx.x * 8 + (threadIdx.x >> 6), nw = gridDim.x * 8;
    f32x4 gv[4], bv[4];
#pragma unroll
    for (int i = 0; i < 4; ++i) { gv[i] = *(const f32x4*)(gam + i * 256 + lane * 4); bv[i] = *(const f32x4*)(bet + i * 256 + lane * 4); }
    for (int r = wv; r < T_TOK; r += nw) {
        float* rp = buf + (size_t)r * 1024;
        f32x4 v[4]; float s = 0.f;
#pragma unroll
        for (int i = 0; i < 4; ++i) { v[i] = *(const f32x4*)(rp + i * 256 + lane * 4); s += v[i][0] + v[i][1] + v[i][2] + v[i][3]; }
        const float mean = wave_sum(s) * (1.0f / 1024.0f);
        float ss = 0.f;
#pragma unroll
        for (int i = 0; i < 4; ++i) { v[i] = v[i] - mean; ss += v[i][0] * v[i][0] + v[i][1] * v[i][1] + v[i][2] * v[i][2] + v[i][3] * v[i][3]; }
        const float rstd = rsqrtf(wave_sum(ss) * (1.0f / 1024.0f) + LN_EPS);
#pragma unroll
        for (int i = 0; i < 4; ++i) { const f32x4 y = v[i] * rstd * gv[i] + bv[i];
            if (copyb) *(u32x2*)(copyb + (size_t)r * 1024 + i * 256 + lane * 4) = (u32x2){cvt_pk_bf16(y[0], y[1]), cvt_pk_bf16(y[2], y[3])};
            else *(f32x4*)(rp + i * 256 + lane * 4) = y; }
    }
}

__device__ __forceinline__ float gelu_tanh(float x) {
    const float y = 0.7978845608028654f * (x + 0.044715f * x * x * x);
    const float t = 1.0f - 2.0f * __builtin_amdgcn_rcpf(1.0f + __expf(2.0f * y));
    return 0.5f * x * (1.0f + t);
}
__device__ void phase_act(const Params& p) {
    unsigned short* z = (unsigned short*)(p.ws + OFF_Z);
    constexpr int NCG = DFF / 8, RUN = 16, NRUN = T_TOK / RUN;
    for (int i = blockIdx.x * NTHREADS + threadIdx.x; i < NCG * NRUN; i += gridDim.x * NTHREADS) {
        const int cgi = i % NCG, run = i / NCG; const int c = cgi * 8; const size_t t0 = (size_t)run * RUN;
        float w0[8], w1[8], w2[8], bb[8];
#pragma unroll
        for (int j = 0; j < 8; ++j) { w0[j] = p.w_ffn_dw[c + j]; w1[j] = p.w_ffn_dw[DFF + c + j]; w2[j] = p.w_ffn_dw[2 * DFF + c + j]; bb[j] = p.b_ffn_dw[c + j]; }
        float um2[8], um1[8];
        if ((t0 % SEQ) == 0) {
#pragma unroll
            for (int j = 0; j < 8; ++j) { um2[j] = 0.f; um1[j] = 0.f; }
        } else {
            const u32x4 a = *(const u32x4*)(z + (t0 - 2) * (2 * DFF) + c), b = *(const u32x4*)(z + (t0 - 1) * (2 * DFF) + c);
#pragma unroll
            for (int j = 0; j < 4; ++j) { um2[2 * j] = bflo(a[j]); um2[2 * j + 1] = bfhi(a[j]); um1[2 * j] = bflo(b[j]); um1[2 * j + 1] = bfhi(b[j]); }
        }
#pragma unroll 4
        for (int tt = 0; tt < RUN; ++tt) {
            unsigned short* rowp = z + (t0 + tt) * (2 * DFF);
            const u32x4 a = *(const u32x4*)(rowp + c), gq = *(const u32x4*)(rowp + DFF + c);
            float u[8], gvv[8], o[8];
#pragma unroll
            for (int j = 0; j < 4; ++j) { u[2 * j] = bflo(a[j]); u[2 * j + 1] = bfhi(a[j]); gvv[2 * j] = bflo(gq[j]); gvv[2 * j + 1] = bfhi(gq[j]); }
#pragma unroll
            for (int j = 0; j < 8; ++j) { const float cv = w0[j] * um2[j] + w1[j] * um1[j] + w2[j] * u[j] + bb[j]; o[j] = gelu_tanh(cv) * gvv[j]; um2[j] = um1[j]; um1[j] = u[j]; }
            *(u32x4*)(rowp + DFF + c) = (u32x4){cvt_pk_bf16(o[0], o[1]), cvt_pk_bf16(o[2], o[3]), cvt_pk_bf16(o[4], o[5]), cvt_pk_bf16(o[6], o[7])};
        }
    }
}


#define XB_TMO      128
#define XB_XCNT(j)  (256  + 64 * (j))
#define XB_XSUB(j)  (1280 + 64 * (j))
#define XB_XGEN(j)  (2304 + 64 * (j))
#define XB_TOP      3328
#define XB_TOPGEN   3392
#define XCD_BAR_WORDS 3456
#define XB_SPIN_CAP (1u << 22)
__device__ __forceinline__ unsigned xb_ld(unsigned* p)              { return __hip_atomic_load(p, __ATOMIC_RELAXED, __HIP_MEMORY_SCOPE_AGENT); }
__device__ __forceinline__ unsigned xb_add(unsigned* p, unsigned v) { return __hip_atomic_fetch_add(p, v, __ATOMIC_RELAXED, __HIP_MEMORY_SCOPE_AGENT); }
__device__ __forceinline__ unsigned xb_xcc_id() { return (unsigned)__builtin_amdgcn_s_getreg((3 << 11) | 20) & 0xFu; }
#define XB_SPIN(cond, bar) do { unsigned _sp = 0; while (cond) { __builtin_amdgcn_s_sleep(1); \
    if ((++_sp & 255u) == 0u) { if (xb_ld(&(bar)[XB_TMO])) break; if (_sp > XB_SPIN_CAP) { atomicAdd(&(bar)[XB_TMO], 1u); break; } } } } while (0)
struct XcdBarrier { unsigned* bar; unsigned x; volatile LAS unsigned* st; };
__device__ __forceinline__ XcdBarrier xcd_barrier_post(unsigned* bar, volatile LAS unsigned* st) {
    XcdBarrier b; b.bar = bar; b.x = xb_xcc_id(); b.st = st;
    if (threadIdx.x == 0) (void)xb_add(&bar[XB_XCNT(b.x)], 1u);
    return b;
}
__device__ __forceinline__ void xcd_barrier_complete(unsigned* bar, unsigned x, unsigned& nloc, unsigned& nx) {
    const unsigned G = gridDim.x * gridDim.y * gridDim.z;
    unsigned sum, cnt, mine, sp = 0u;
    for (;;) {
        sum = 0u; cnt = 0u; mine = 0u;
#pragma unroll
        for (unsigned j = 0; j < 16; ++j) { const unsigned c = xb_ld(&bar[XB_XCNT(j)]); sum += c; cnt += (c > 0u) ? 1u : 0u; mine = (j == x) ? c : mine; }
        if (sum == G) break;
        __builtin_amdgcn_s_sleep(1);
        if ((++sp & 255u) == 0u) { if (xb_ld(&bar[XB_TMO])) break; if (sp > XB_SPIN_CAP) { atomicAdd(&bar[XB_TMO], 1u); break; } }
    }
    nloc = mine > 0u ? mine : 1u; nx = cnt > 0u ? cnt : 1u;
}
__device__ __forceinline__ void xcd_barrier(const XcdBarrier& b) {
    asm volatile("s_waitcnt vmcnt(0)" ::: "memory");
    __syncthreads();
    if (threadIdx.x == 0) {
        unsigned* bar = b.bar;
        __builtin_amdgcn_s_waitcnt(0);
        unsigned nloc = b.st[0], nx = b.st[1];
        if (nloc == 0u) { xcd_barrier_complete(bar, b.x, nloc, nx); b.st[0] = nloc; b.st[1] = nx; }
        const unsigned old = xb_add(&bar[XB_XSUB(b.x)], 1u);
        const unsigned gen = old / nloc;
        if (old + 1u == (gen + 1u) * nloc) {
            __builtin_amdgcn_fence(__ATOMIC_RELEASE, "agent");
            asm volatile("s_waitcnt vmcnt(0)" ::: "memory");
            const unsigned og = xb_add(&bar[XB_TOP], 1u);
            const unsigned tg = og / nx;
            if (og + 1u == (tg + 1u) * nx) xb_add(&bar[XB_TOPGEN], 1u);
            else XB_SPIN(xb_ld(&bar[XB_TOPGEN]) == tg, bar);
            __builtin_amdgcn_fence(__ATOMIC_ACQUIRE, "agent");
            xb_add(&bar[XB_XGEN(b.x)], 1u);
            asm volatile("s_waitcnt vmcnt(0)" ::: "memory");
        } else {
            XB_SPIN(xb_ld(&bar[XB_XGEN(b.x)]) == gen, bar);
            __builtin_amdgcn_fence(__ATOMIC_ACQUIRE, "agent");
            asm volatile("s_waitcnt vmcnt(0)" ::: "memory");
        }
    }
    __syncthreads();
}

#ifndef PHASE_MASK
#define PHASE_MASK 0x1fff
#endif
#ifndef DUP_MASK
#define DUP_MASK 0
#endif
#define PHASE(n) if ((PHASE_MASK & (1 << (n))) && (ph_only < 0 || ph_only == (n))) for (int rep_ = 0; rep_ < 1 + ((DUP_MASK >> (n)) & 1); ++rep_)
#define SYNC() do { if (ph_only < 0) xcd_barrier(xb); } while (0)
__global__ void __launch_bounds__(NTHREADS, 2) fwd_megakernel(Params p, int ph_only) {
    extern __shared__ __attribute__((aligned(16))) unsigned char shm[];
    cg::grid_group grid = cg::this_grid();
    LAS unsigned char* lds3 = (LAS unsigned char*)shm;
    volatile LAS unsigned* xst = (volatile LAS unsigned*)(lds3 + LDS_BYTES - 16);
    if (threadIdx.x == 0) { xst[0] = 0u; xst[1] = 0u; }
    __syncthreads();
    const XcdBarrier xb = xcd_barrier_post((unsigned*)(p.ws + OFF_BAR), xst);
    PHASE(0) { phase_prep(p, shm); }
    if (ph_only == -12345) grid.sync();
    SYNC();
    PHASE(1) { pg8::StaticOrder S; S.init(T_TOK, IN_COLS, gridDim.x, blockIdx.x);
               pg8::Gemm g{(const bf16_t*)(p.ws + OFF_XB), (const bf16_t*)(p.ws + OFF_WIN), T_TOK, IN_COLS, DM, DM, nullptr, 0, 0};
               EpiProj e{p.ws, (unsigned short*)p.out, (const float*)(p.ws + OFF_MISC)}; pg8::gemm_phase(lds3, g, S, e); }
    SYNC();
    PHASE(2) { phase_conv(p, shm);
               hgrn_phase<false>(p, shm); }
    SYNC();
    PHASE(4) { hgrn_phase<true>(p, shm); }
    SYNC();
    PHASE(5) { pg8::StaticOrder S; S.init(T_TOK, DM, gridDim.x, blockIdx.x);
               pg8::Gemm g{(const bf16_t*)(p.ws + OFF_XB), (const bf16_t*)(p.ws + OFF_WCO), T_TOK, DM, CONV_DIM + HG, CONV_DIM, (const bf16_t*)(p.ws + OFF_CVG), HG, CONV_DIM / 64};
               EpiMix e{(const unsigned short*)p.out, (unsigned short*)(p.ws + OFF_V)}; pg8::gemm_phase<EpiMix, true>(lds3, g, S, e); }
    SYNC();
    PHASE(7) { pg8::StaticOrder S; S.init(T_TOK, DM, gridDim.x, blockIdx.x);
               pg8::Gemm g{(const bf16_t*)(p.ws + OFF_V), (const bf16_t*)(p.ws + OFF_WOUT), T_TOK, DM, DM, DM, nullptr, 0, 0};
               EpiLn<0> e{p.x, p.ws + OFF_G, p.ln1_g, p.ln1_b, (float*)(p.ws + OFF_PART7), (unsigned*)(p.ws + OFF_CNT), lds3 + 131072}; pg8::gemm_phase(lds3, g, S, e); }
    SYNC();
    PHASE(9) { pg8::StaticOrder S; S.init(T_TOK, 2 * DFF, gridDim.x, blockIdx.x);
               pg8::Gemm g{(const bf16_t*)(p.ws + OFF_G), (const bf16_t*)(p.ws + OFF_WFI), T_TOK, 2 * DFF, DM, DM, nullptr, 0, 0};
               EpiZ e{(unsigned short*)(p.ws + OFF_Z), 2 * DFF}; pg8::gemm_phase(lds3, g, S, e); }
    SYNC();
    PHASE(10) { phase_act(p); }
    SYNC();
    PHASE(11) { pg8::StaticOrder S; S.init(T_TOK, DM, gridDim.x, blockIdx.x);
                pg8::Gemm g{(const bf16_t*)(p.ws + OFF_Z) + DFF, (const bf16_t*)(p.ws + OFF_WFO), T_TOK, DM, DFF, 2 * DFF, nullptr, 0, 0};
                EpiLn<1> e{p.ws + OFF_G, p.out, p.ln2_g, p.ln2_b, (float*)(p.ws + OFF_PART11), (unsigned*)(p.ws + OFF_CNT) + 128 * 2 * 64, lds3 + 131072}; pg8::gemm_phase(lds3, g, S, e); }
}

extern "C" void kernel_launch(void* const* d_in, const int* in_sizes, int n_in, void* d_out, int out_size, void* d_ws, size_t ws_size, hipStream_t stream) {
    static int grid_blocks = 0;
    if (!grid_blocks) {
        int dev = 0, cus = 0, per_cu = 0;
        hipGetDevice(&dev);
        hipDeviceGetAttribute(&cus, hipDeviceAttributeMultiprocessorCount, dev);
        hipFuncSetAttribute((const void*)fwd_megakernel, hipFuncAttributeMaxDynamicSharedMemorySize, LDS_BYTES);
        hipOccupancyMaxActiveBlocksPerMultiprocessor(&per_cu, (const void*)fwd_megakernel, NTHREADS, LDS_BYTES);
        if (per_cu < 1) per_cu = 1;
        if (per_cu > 1) per_cu = 1;
        grid_blocks = cus * per_cu;
        if (ws_size < WS_NEED) fprintf(stderr, "kernel_launch: workspace too small: %zu < %zu\n", ws_size, (size_t)WS_NEED);
    }
    hipMemsetAsync((unsigned char*)d_ws + OFF_BAR, 0, ZERO_BYTES, stream);
    Params p{};
    p.x = (const float*)d_in[0]; p.w_in = (const float*)d_in[1]; p.w_conv_dw = (const float*)d_in[2]; p.b_conv_dw = (const float*)d_in[3];
    p.conv_ln_g = (const float*)d_in[4]; p.conv_ln_b = (const float*)d_in[5]; p.w_conv_out = (const float*)d_in[6]; p.lb_logits = (const float*)d_in[7];
    p.hgrn_norm_g = (const float*)d_in[8]; p.w_hgrn_out = (const float*)d_in[9]; p.w_out = (const float*)d_in[10]; p.ln1_g = (const float*)d_in[11];
    p.ln1_b = (const float*)d_in[12]; p.w_ffn_in = (const float*)d_in[13]; p.w_ffn_dw = (const float*)d_in[14]; p.b_ffn_dw = (const float*)d_in[15];
    p.w_ffn_out = (const float*)d_in[16]; p.ln2_g = (const float*)d_in[17]; p.ln2_b = (const float*)d_in[18];
    p.out = (float*)d_out; p.ws = (unsigned char*)d_ws;
#if defined(MULTI_LAUNCH)
    for (int ph = 0; ph < 13; ++ph) hipLaunchKernelGGL(fwd_megakernel, dim3(grid_blocks), dim3(NTHREADS), LDS_BYTES, stream, p, ph);
#else
    int ph_only = -1;
    void* args[] = {&p, &ph_only};
    hipError_t e = hipLaunchCooperativeKernel((const void*)fwd_megakernel, dim3(grid_blocks), dim3(NTHREADS), args, LDS_BYTES, stream);
    if (e != hipSuccess) fprintf(stderr, "cooperative launch failed: %s (grid %d)\n", hipGetErrorString(e), grid_blocks);
#endif
}
```

```cpp
#include <hip/hip_runtime.h>
#include <hip/hip_cooperative_groups.h>
#include <cstdio>
namespace cg = cooperative_groups;

#define LAS __attribute__((address_space(3)))
typedef unsigned short bf16_t;
typedef short bf16x8 __attribute__((ext_vector_type(8)));
typedef float f32x4 __attribute__((ext_vector_type(4)));
typedef float f32x2 __attribute__((ext_vector_type(2)));
typedef unsigned u32x4 __attribute__((ext_vector_type(4)));
typedef unsigned u32x2 __attribute__((ext_vector_type(2)));

constexpr int T_TOK = 32768, SEQ = 8192, DM = 1024, IN_COLS = 7168, CONV_DIM = 512, CONV_K = 31, HG = 1024, DFF = 2816;
constexpr float ALPHA = 1.189207115002721f;
constexpr float LN_EPS = 1e-5f, RMS_EPS = 1e-6f;
constexpr int NTHREADS = 512;
constexpr int LDS_BYTES = 140 * 1024;

constexpr size_t MiB = 1024ull * 1024ull;
constexpr size_t OFF_W    = 0;
constexpr size_t OFF_WIN  = OFF_W;
constexpr size_t OFF_WCO  = OFF_WIN + (size_t)IN_COLS * DM * 2;
constexpr size_t OFF_WHO  = OFF_WCO + (size_t)DM * CONV_DIM * 2;
constexpr size_t OFF_WOUT = OFF_WHO + (size_t)DM * HG * 2;
constexpr size_t OFF_WFI  = OFF_WOUT + (size_t)DM * DM * 2;
constexpr size_t OFF_WFO  = OFF_WFI + (size_t)2 * DFF * DM * 2;
constexpr size_t OFF_G    = 36 * MiB;
constexpr size_t OFF_Q    = 100 * MiB;
constexpr size_t OFF_KIN  = 164 * MiB;
constexpr size_t OFF_V    = 228 * MiB;
constexpr size_t OFF_XB   = 292 * MiB;
constexpr size_t OFF_CVG  = 356 * MiB;
constexpr size_t OFF_L    = 420 * MiB;
constexpr size_t OFF_D    = 484 * MiB;
constexpr size_t OFF_MISC = 485 * MiB;
constexpr size_t OFF_Z    = OFF_Q;
constexpr size_t OFF_PART7  = 486 * MiB;
constexpr size_t OFF_PART11 = 487 * MiB;
constexpr size_t OFF_BAR  = 489 * MiB;
constexpr size_t OFF_CNT  = OFF_BAR + 64 * 1024;
constexpr size_t ZERO_BYTES = 64 * 1024 + 2 * 128 * 2 * 256;
constexpr size_t WS_NEED  = 490 * MiB;

struct Params {
    const float* x; const float* w_in; const float* w_conv_dw; const float* b_conv_dw; const float* conv_ln_g; const float* conv_ln_b;
    const float* w_conv_out; const float* lb_logits; const float* hgrn_norm_g; const float* w_hgrn_out; const float* w_out;
    const float* ln1_g; const float* ln1_b; const float* w_ffn_in; const float* w_ffn_dw; const float* b_ffn_dw; const float* w_ffn_out;
    const float* ln2_g; const float* ln2_b;
    float* out; unsigned char* ws;
};

__device__ __forceinline__ unsigned cvt_pk_bf16(float lo, float hi) { unsigned r; asm("v_cvt_pk_bf16_f32 %0, %1, %2" : "=v"(r) : "v"(lo), "v"(hi)); return r; }
__device__ __forceinline__ float bf2f(unsigned short b) { return __uint_as_float(((unsigned)b) << 16); }
__device__ __forceinline__ float bflo(unsigned u) { return __uint_as_float(u << 16); }
__device__ __forceinline__ float bfhi(unsigned u) { return __uint_as_float(u & 0xffff0000u); }
__device__ __forceinline__ unsigned short f2bf(float f) { return (unsigned short)(cvt_pk_bf16(f, 0.f) & 0xffffu); }
__device__ __forceinline__ float sigmoidf_(float x) { return __builtin_amdgcn_rcpf(1.0f + __expf(-x)); }
__device__ __forceinline__ unsigned pk_f16(float lo, float hi) {
    _Float16 a = (_Float16)lo, b = (_Float16)hi; unsigned short ua, ub; __builtin_memcpy(&ua, &a, 2); __builtin_memcpy(&ub, &b, 2); return (unsigned)ua | ((unsigned)ub << 16); }
__device__ __forceinline__ float wave_sum(float v) {
#pragma unroll
    for (int o = 32; o >= 1; o >>= 1) v += __shfl_xor(v, o);
    return v; }

namespace pg8 {
constexpr int BM = 256, BK = 64, HALF = 128, HTB = HALF * BK * 2, STAGE_BYTES = 8 * HTB, NXCD = 8, WGM = 4;
__host__ __device__ __forceinline__ int lds_byte(int r, int c) { const int st = (r >> 4) * 2 + (c >> 5), rr = r & 15, cc = c & 31, ob = rr * 64 + cc * 2; return st * 1024 + (ob ^ (((ob >> 9) & 1) << 5)); }
__host__ __device__ __forceinline__ void stage_rc(int b, int& R, int& C) { const int st = b / 1024, sb = b % 1024, swz = sb ^ (((sb >> 9) & 1) << 5); R = (st >> 1) * 16 + swz / 64; C = (st & 1) * 32 + (swz % 64) / 2; }
__host__ __device__ __forceinline__ int perm32(int rho) { const int n = rho >> 4, i = rho & 15; return 8 * (i >> 2) + 4 * n + (i & 3); }
struct Unit { int pm, pn; };
struct Gemm { const bf16_t* A; const bf16_t* Bt; int M, N, K, lda; const bf16_t* A2; int lda2; int ksplit; };
template <int NN  > struct StaticOrder {
    static constexpr int nM = T_TOK / BM, nN = NN, nwg = nM * nN, nig = WGM * nN, q = nwg / NXCD;
    static_assert(nwg % NXCD == 0 && nM % WGM == 0, "unit order");
    int G, c, reps, rounds;
    __device__ void init(int, int, int G_, int c_, int reps_ = 1) { G = G_; c = c_; reps = reps_; rounds = (nwg + G - 1) / G; }
    __device__ bool next(int i, Unit& u) const {
        if (i >= rounds * reps) return false;
        const int ir = (reps == 1) ? i : (i % rounds);
        const long L = (long)ir * G + c; if (L >= nwg) return false;
        const int l = (int)L, wgid = (l % NXCD) * q + l / NXCD;
        const int gid = wgid / nig, idx = wgid % nig;
        u.pm = gid * WGM + (idx % WGM); u.pn = idx / WGM; return true;
    }
};

template <class Epi, bool DUAL = false, class Sched>
__device__ __forceinline__ void gemm_phase(LAS unsigned char* lds, const Gemm g, const Sched& S, Epi& E) {
    const int tid = threadIdx.x, wid = __builtin_amdgcn_readfirstlane(tid >> 6), lane = tid & 63, wr = wid >> 2, wc = wid & 3, fr = lane & 15, fq = lane >> 4;
    const int K = g.K, nt = K / BK, lda = g.lda, lda2 = g.lda2, ksplit = g.ksplit;
    unsigned voffA[2], voffA2[2], voffB[2];
#pragma unroll
    for (int i = 0; i < 2; ++i) { int R, C; stage_rc(tid * 16 + i * 8192, R, C); const int Rb = Epi::PERM ? ((R & ~31) + perm32(R & 31)) : R;
        voffA[i] = (unsigned)(R * lda + C) * 2u; voffA2[i] = DUAL ? (unsigned)(R * lda2 + C) * 2u : 0u; voffB[i] = (unsigned)(Rb * K + C) * 2u; }
    const size_t kstep = (size_t)(BK * 2);
    const size_t hstepA = (size_t)HALF * lda * 2, hstepA2 = (size_t)HALF * lda2 * 2, hstepB = (size_t)HALF * K * 2;
    const unsigned ldsw = (unsigned)wid * 1024u;
    const int aoff = lds_byte(wr * 64 + fr, fq * 8), boff = lds_byte(wc * 32 + fr, fq * 8);
#define PG8_SA(b, h) (((b) * 2 + (h)) * HTB)
#define PG8_SB(b, h) ((4 + (b) * 2 + (h)) * HTB)
    auto stA = [&](int bufoff, int pm, int kt, int half) {
        const char* base; unsigned v0, v1;
        if (DUAL && kt >= ksplit) { base = (const char*)g.A2 + (size_t)(2 * pm + half) * hstepA2 + (size_t)(kt - ksplit) * kstep; v0 = voffA2[0]; v1 = voffA2[1]; }
        else                      { base = (const char*)g.A  + (size_t)(2 * pm + half) * hstepA  + (size_t)kt * kstep;            v0 = voffA[0];  v1 = voffA[1]; }
        __builtin_amdgcn_global_load_lds((const unsigned*)(base + v0), (LAS unsigned*)(lds + bufoff + ldsw), 16, 0, 0);
        __builtin_amdgcn_global_load_lds((const unsigned*)(base + v1), (LAS unsigned*)(lds + bufoff + ldsw + 8192), 16, 0, 0);
    };
    auto stB = [&](int bufoff, int pn, int kt, int half) {
        const char* base = (const char*)g.Bt + (size_t)(2 * pn + half) * hstepB + (size_t)kt * kstep;
        __builtin_amdgcn_global_load_lds((const unsigned*)(base + voffB[0]), (LAS unsigned*)(lds + bufoff + ldsw), 16, 0, 0);
        __builtin_amdgcn_global_load_lds((const unsigned*)(base + voffB[1]), (LAS unsigned*)(lds + bufoff + ldsw + 8192), 16, 0, 0);
    };
#define PG8_LDA(dst, b, h) do { _Pragma("unroll") for (int m = 0; m < 4; ++m) _Pragma("unroll") for (int k = 0; k < 2; ++k) dst[m][k] = *(const LAS bf16x8*)(lds + PG8_SA(b, h) + aoff + m * 2048 + k * 1024); } while (0)
#define PG8_LDB(dst, b, h) do { _Pragma("unroll") for (int n = 0; n < 2; ++n) _Pragma("unroll") for (int k = 0; k < 2; ++k) dst[n][k] = *(const LAS bf16x8*)(lds + PG8_SB(b, h) + boff + n * 2048 + k * 1024); } while (0)
#define PG8_MMA(ai, bj, At, Bt) do { __builtin_amdgcn_s_setprio(1); _Pragma("unroll") for (int m = 0; m < 4; ++m) _Pragma("unroll") for (int n = 0; n < 2; ++n) _Pragma("unroll") for (int k = 0; k < 2; ++k) \
        acc[ai][bj][m][n] = __builtin_amdgcn_mfma_f32_16x16x32_bf16(Bt[n][k], At[m][k], acc[ai][bj][m][n], 0, 0, 0); __builtin_amdgcn_s_setprio(0); } while (0)
#define PG8_WAIT_V(n) asm volatile("s_waitcnt vmcnt(" #n ")" ::: "memory")
#define PG8_WAIT_L(n) asm volatile("s_waitcnt lgkmcnt(" #n ")" ::: "memory")
#define PG8_BAR __builtin_amdgcn_s_barrier()
#define PG8_SCHED __builtin_amdgcn_sched_barrier(0)
    Unit cur, nxt; int ui = 0;
    if (!S.next(0, cur)) return;
    f32x4 acc[2][2][4][2];
#pragma unroll
    for (int a = 0; a < 2; ++a)
#pragma unroll
        for (int b = 0; b < 2; ++b)
#pragma unroll
            for (int m = 0; m < 4; ++m)
#pragma unroll
                for (int n = 0; n < 2; ++n) acc[a][b][m][n] = (f32x4){0.f, 0.f, 0.f, 0.f};
    bf16x8 At[4][2], B0[2][2], B1[2][2];
    stB(PG8_SB(0, 0), cur.pn, 0, 0); stA(PG8_SA(0, 0), cur.pm, 0, 0); stB(PG8_SB(0, 1), cur.pn, 0, 1); stA(PG8_SA(0, 1), cur.pm, 0, 1);
    if (wr == 1) PG8_BAR;
    PG8_WAIT_V(4); PG8_BAR;
    stB(PG8_SB(1, 0), cur.pn, 1, 0); stA(PG8_SA(1, 0), cur.pm, 1, 0); stB(PG8_SB(1, 1), cur.pn, 1, 1);
    PG8_WAIT_V(6); PG8_BAR;
    for (;;) {
        const bool has_next = S.next(ui + 1, nxt);
        const int npm = has_next ? nxt.pm : cur.pm, npn = has_next ? nxt.pn : cur.pn;
        for (int t = 0; t < nt; t += 2) {
            const bool last = (t == nt - 2);
            const int pm2 = last ? npm : cur.pm, pn2 = last ? npn : cur.pn, k2 = last ? 0 : t + 2, k3 = k2 + 1;
            if constexpr (DUAL) { if (t == ksplit) E.mid(acc, cur, wr, wc, fr, fq); }
            PG8_LDB(B0, 0, 0); PG8_SCHED; PG8_LDA(At, 0, 0); stA(PG8_SA(1, 1), cur.pm, t + 1, 1);
            PG8_WAIT_L(8); PG8_BAR; PG8_WAIT_L(0); PG8_MMA(0, 0, At, B0); PG8_BAR; PG8_SCHED;
            PG8_LDB(B1, 0, 1); stB(PG8_SB(0, 0), pn2, k2, 0);
            PG8_BAR; PG8_WAIT_L(0); PG8_MMA(0, 1, At, B1); PG8_BAR;
            PG8_LDA(At, 0, 1); stA(PG8_SA(0, 0), pm2, k2, 0);
            PG8_BAR; PG8_WAIT_L(0); PG8_MMA(1, 0, At, B0); PG8_BAR; PG8_SCHED;
            stB(PG8_SB(0, 1), pn2, k2, 1);
            PG8_WAIT_V(6); PG8_BAR; PG8_MMA(1, 1, At, B1); PG8_BAR;
            PG8_LDB(B0, 1, 0); PG8_SCHED; PG8_LDA(At, 1, 0); stA(PG8_SA(0, 1), pm2, k2, 1);
            PG8_WAIT_L(8); PG8_BAR; PG8_WAIT_L(0); PG8_MMA(0, 0, At, B0); PG8_BAR; PG8_SCHED;
            PG8_LDB(B1, 1, 1); stB(PG8_SB(1, 0), pn2, k3, 0);
            PG8_BAR; PG8_WAIT_L(0); PG8_MMA(0, 1, At, B1); PG8_BAR;
            PG8_LDA(At, 1, 1); stA(PG8_SA(1, 0), pm2, k3, 0);
            PG8_BAR; PG8_WAIT_L(0); PG8_MMA(1, 0, At, B0); PG8_BAR; PG8_SCHED;
            stB(PG8_SB(1, 1), pn2, k3, 1);
            PG8_WAIT_V(6); PG8_BAR; PG8_MMA(1, 1, At, B1); PG8_BAR;
        }
        E(acc, cur, wr, wc, fr, fq);
        if (!has_next) break;
#pragma unroll
        for (int a = 0; a < 2; ++a)
#pragma unroll
            for (int b = 0; b < 2; ++b)
#pragma unroll
                for (int m = 0; m < 4; ++m)
#pragma unroll
                    for (int n = 0; n < 2; ++n) acc[a][b][m][n] = (f32x4){0.f, 0.f, 0.f, 0.f};
        cur = nxt; ++ui;
    }
    PG8_WAIT_V(0);
    if (wr == 0) PG8_BAR;
    PG8_BAR;
#undef PG8_SA
#undef PG8_SB
#undef PG8_LDA
#undef PG8_LDB
#undef PG8_MMA
#undef PG8_WAIT_V
#undef PG8_WAIT_L
#undef PG8_BAR
#undef PG8_SCHED
}
}
using pg8::Unit;

struct EpiProj {
    static constexpr bool PERM = true;
    unsigned char* ws; unsigned short* mgate; const float* colscale;
    __device__ __forceinline__ void operator()(const f32x4 (&acc)[2][2][4][2], const Unit& u, int wr, int wc, int fr, int fq) const {
        const int pn = u.pn;
        if (pn >= 20) {
            const int rowg = u.pm * 256 + wr * 64 + fr, chl = (pn - 20) * 128 + wc * 32 + 8 * fq;
#pragma unroll
            for (int ai = 0; ai < 2; ++ai)
#pragma unroll
                for (int m = 0; m < 4; ++m) {
                    float ra[8], g1[8];
#pragma unroll
                    for (int n = 0; n < 2; ++n)
#pragma unroll
                        for (int j = 0; j < 4; ++j) { const float d0 = 1.0f + __expf(-acc[ai][0][m][n][j]), d1 = 1.0f + __expf(-acc[ai][1][m][n][j]);
                            g1[n * 4 + j] = __builtin_amdgcn_rcpf(d1); ra[n * 4 + j] = d1 * __builtin_amdgcn_rcpf(d0); }
                    unsigned short* rowp = mgate + (size_t)(rowg + ai * 128 + m * 16) * 2048 + chl;
                    *(u32x4*)rowp = (u32x4){cvt_pk_bf16(ra[0], ra[1]), cvt_pk_bf16(ra[2], ra[3]), cvt_pk_bf16(ra[4], ra[5]), cvt_pk_bf16(ra[6], ra[7])};
                    *(u32x4*)(rowp + 1024) = (u32x4){cvt_pk_bf16(g1[0], g1[1]), cvt_pk_bf16(g1[2], g1[3]), cvt_pk_bf16(g1[4], g1[5]), cvt_pk_bf16(g1[6], g1[7])};
                }
            return;
        }
        unsigned short* base; int ld, colt; float c0, c1, c2, sgn; bool f16 = false;
        if (pn < 4)       { base = (unsigned short*)(ws + OFF_CVG); ld = 1024; colt = pn * 256; if (pn < 2) { c0 = 1.f; c1 = 0.f; c2 = 0.f; } else { c0 = 0.f; c1 = 1.f; c2 = 0.f; } sgn = 1.f; }
        else if (pn < 8)  { base = (unsigned short*)(ws + OFF_Q);   ld = 1024; colt = (pn - 4) * 256;  c0 = 0.f; c1 = 0.f; c2 = 1.f; sgn = 1.f; }
        else if (pn < 12) { base = (unsigned short*)(ws + OFF_KIN); ld = 1024; colt = (pn - 8) * 256;  c0 = 0.f; c1 = 1.f; c2 = 0.f; sgn = -1.f; f16 = true; }
        else if (pn < 16) { base = (unsigned short*)(ws + OFF_V);   ld = 1024; colt = (pn - 12) * 256; c0 = 1.f; c1 = 0.f; c2 = 0.f; sgn = 1.f; }
        else if (pn < 20) { base = (unsigned short*)(ws + OFF_G);   ld = 1024; colt = (pn - 16) * 256; c0 = 0.f; c1 = 0.f; c2 = 1.f; sgn = 1.f; }
        else              { base = mgate;                           ld = 2048; colt = (pn - 20) * 256; c0 = 0.f; c1 = 1.f; c2 = 0.f; sgn = 1.f; }
        const int row0 = u.pm * 256 + wr * 64 + fr, coll = wc * 32 + 8 * fq;
        f32x4 cs[2][2];
#pragma unroll
        for (int bj = 0; bj < 2; ++bj)
#pragma unroll
            for (int n = 0; n < 2; ++n) cs[bj][n] = f16 ? *(const f32x4*)(colscale + pn * 256 + bj * 128 + coll + 4 * n) : (f32x4){1.f, 1.f, 1.f, 1.f};
#pragma unroll
        for (int ai = 0; ai < 2; ++ai)
#pragma unroll
            for (int m = 0; m < 4; ++m) {
                unsigned short* rowp = base + (size_t)(row0 + ai * 128 + m * 16) * ld + colt + coll;
#pragma unroll
                for (int bj = 0; bj < 2; ++bj) {
                    float o[8];
#pragma unroll
                    for (int n = 0; n < 2; ++n)
#pragma unroll
                        for (int j = 0; j < 4; ++j) { const float z = acc[ai][bj][m][n][j]; const float s = __builtin_amdgcn_rcpf(1.0f + __expf(-sgn * z)); o[n * 4 + j] = (c0 * z + s * (c1 + c2 * z)) * cs[bj][n][j]; }
                    const u32x4 pkh = (u32x4){pk_f16(o[0], o[1]), pk_f16(o[2], o[3]), pk_f16(o[4], o[5]), pk_f16(o[6], o[7])};
                    const u32x4 pkb = (u32x4){cvt_pk_bf16(o[0], o[1]), cvt_pk_bf16(o[2], o[3]), cvt_pk_bf16(o[4], o[5]), cvt_pk_bf16(o[6], o[7])};
                    u32x4 pk;
#pragma unroll
                    for (int q = 0; q < 4; ++q) pk[q] = f16 ? pkh[q] : pkb[q];
                    *(u32x4*)(rowp + bj * 128) = pk;
                }
            }
    }
};
struct EpiMix {
    static constexpr bool PERM = false;
    const unsigned short* mgate; unsigned short* mixed;
    __device__ __forceinline__ void mid(f32x4 (&acc)[2][2][4][2], const Unit& u, int wr, int wc, int fr, int fq) const {
        const int row0 = u.pm * 256 + wr * 64 + fr, col0 = u.pn * 256 + wc * 32 + 4 * fq;
#pragma unroll
        for (int ai = 0; ai < 2; ++ai)
#pragma unroll
            for (int m = 0; m < 4; ++m) { const size_t r = (size_t)(row0 + ai * 128 + m * 16);
#pragma unroll
                for (int bj = 0; bj < 2; ++bj)
#pragma unroll
                    for (int n = 0; n < 2; ++n) { const int c = col0 + bj * 128 + n * 16;
                        const u32x2 ga = *(const u32x2*)(mgate + r * 2048 + c);
                        acc[ai][bj][m][n][0] *= bflo(ga[0]); acc[ai][bj][m][n][1] *= bfhi(ga[0]);
                        acc[ai][bj][m][n][2] *= bflo(ga[1]); acc[ai][bj][m][n][3] *= bfhi(ga[1]); } }
    }
    __device__ __forceinline__ void operator()(const f32x4 (&acc)[2][2][4][2], const Unit& u, int wr, int wc, int fr, int fq) const {
        const int row0 = u.pm * 256 + wr * 64 + fr, col0 = u.pn * 256 + wc * 32 + 4 * fq;
#pragma unroll
        for (int ai = 0; ai < 2; ++ai)
#pragma unroll
            for (int m = 0; m < 4; ++m) { const size_t r = (size_t)(row0 + ai * 128 + m * 16);
#pragma unroll
                for (int bj = 0; bj < 2; ++bj)
#pragma unroll
                    for (int n = 0; n < 2; ++n) { const int c = col0 + bj * 128 + n * 16;
                        const u32x2 gb = *(const u32x2*)(mgate + r * 2048 + 1024 + c);
                        const f32x4 v = acc[ai][bj][m][n];
                        *(u32x2*)(mixed + r * 1024 + c) = (u32x2){cvt_pk_bf16(v[0] * bflo(gb[0]), v[1] * bfhi(gb[0])), cvt_pk_bf16(v[2] * bflo(gb[1]), v[3] * bfhi(gb[1]))}; } }
    }
};
struct EpiRes {
    static constexpr bool PERM = false;
    const float* res; float* dst;
    __device__ __forceinline__ void operator()(const f32x4 (&acc)[2][2][4][2], const Unit& u, int wr, int wc, int fr, int fq) const {
        const int row0 = u.pm * 256 + wr * 64 + fr, col0 = u.pn * 256 + wc * 32 + 4 * fq;
#pragma unroll
        for (int ai = 0; ai < 2; ++ai)
#pragma unroll
            for (int m = 0; m < 4; ++m) { const size_t r = (size_t)(row0 + ai * 128 + m * 16);
#pragma unroll
                for (int bj = 0; bj < 2; ++bj)
#pragma unroll
                    for (int n = 0; n < 2; ++n) { const int c = col0 + bj * 128 + n * 16;
                        const f32x4 t = *(const f32x4*)(res + r * 1024 + c);
                        *(f32x4*)(dst + r * 1024 + c) = t * ALPHA + acc[ai][bj][m][n]; } }
    }
};
struct EpiResB {
    static constexpr bool PERM = false;
    const unsigned short* res; float* dst;
    __device__ __forceinline__ void operator()(const f32x4 (&acc)[2][2][4][2], const Unit& u, int wr, int wc, int fr, int fq) const {
        const int row0 = u.pm * 256 + wr * 64 + fr, col0 = u.pn * 256 + wc * 32 + 4 * fq;
#pragma unroll
        for (int ai = 0; ai < 2; ++ai)
#pragma unroll
            for (int m = 0; m < 4; ++m) { const size_t r = (size_t)(row0 + ai * 128 + m * 16);
#pragma unroll
                for (int bj = 0; bj < 2; ++bj)
#pragma unroll
                    for (int n = 0; n < 2; ++n) { const int c = col0 + bj * 128 + n * 16;
                        const u32x2 t = *(const u32x2*)(res + r * 1024 + c);
                        const f32x4 tv = (f32x4){bflo(t[0]), bfhi(t[0]), bflo(t[1]), bfhi(t[1])};
                        *(f32x4*)(dst + r * 1024 + c) = tv * ALPHA + acc[ai][bj][m][n]; } }
    }
};
template <int MODE  > struct EpiLn {
    static constexpr bool PERM = false;
    const void* res; void* outp; const float* gam; const float* bet; float* part; unsigned* cnt; LAS unsigned char* ldsx;
    __device__ __forceinline__ void operator()(f32x4 (&acc)[2][2][4][2], const Unit& u, int wr, int wc, int fr, int fq) const {
        const int row0 = u.pm * 256 + wr * 64 + fr, col0 = u.pn * 256 + wc * 32 + 4 * fq;
        LAS float* red = (LAS float*)ldsx;
        LAS float* stats = (LAS float*)(ldsx + 8192);
#pragma unroll
        for (int ai = 0; ai < 2; ++ai)
#pragma unroll
            for (int m = 0; m < 4; ++m) { const size_t r = (size_t)(row0 + ai * 128 + m * 16);
                float s1 = 0.f, s2 = 0.f;
#pragma unroll
                for (int bj = 0; bj < 2; ++bj)
#pragma unroll
                    for (int n = 0; n < 2; ++n) { const int c = col0 + bj * 128 + n * 16;
                        f32x4 tv;
                        if (MODE == 0) tv = *(const f32x4*)((const float*)res + r * 1024 + c);
                        else { const u32x2 t = *(const u32x2*)((const unsigned short*)res + r * 1024 + c); tv = (f32x4){bflo(t[0]), bfhi(t[0]), bflo(t[1]), bfhi(t[1])}; }
                        const f32x4 v = tv * ALPHA + acc[ai][bj][m][n];
                        acc[ai][bj][m][n] = v;
                        s1 += v[0] + v[1] + v[2] + v[3]; s2 += v[0] * v[0] + v[1] * v[1] + v[2] * v[2] + v[3] * v[3]; }
                s1 += __shfl_xor(s1, 16); s1 += __shfl_xor(s1, 32); s2 += __shfl_xor(s2, 16); s2 += __shfl_xor(s2, 32);
                if (fq == 0) { const int rl = ai * 128 + wr * 64 + m * 16 + fr; red[(rl * 4 + wc) * 2] = s1; red[(rl * 4 + wc) * 2 + 1] = s2; } }
        __syncthreads();
        if (wc == 0) {
            const int lane = fq * 16 + fr;
            unsigned* cw = cnt + (size_t)(u.pm * 2 + wr) * 64;
            float* mypart = part + ((size_t)(u.pm * 4 + u.pn) * 256) * 2;
#pragma unroll
            for (int q = 0; q < 2; ++q) { const int i = lane + 64 * q, rl = (i >> 6) * 128 + wr * 64 + (i & 63);
                float t1 = 0.f, t2 = 0.f;
#pragma unroll
                for (int w4 = 0; w4 < 4; ++w4) { t1 += red[(rl * 4 + w4) * 2]; t2 += red[(rl * 4 + w4) * 2 + 1]; }
                const unsigned long long pv = (unsigned long long)__float_as_uint(t1) | ((unsigned long long)__float_as_uint(t2) << 32);
                __hip_atomic_store((unsigned long long*)(mypart + rl * 2), pv, __ATOMIC_RELAXED, __HIP_MEMORY_SCOPE_AGENT); }
            asm volatile("s_waitcnt vmcnt(0)" ::: "memory");
            if (lane == 0) (void)__hip_atomic_fetch_add(cw, 1u, __ATOMIC_RELAXED, __HIP_MEMORY_SCOPE_AGENT);
            { unsigned sp = 0;
              while ((unsigned)__builtin_amdgcn_readfirstlane(__hip_atomic_load(cw, __ATOMIC_RELAXED, __HIP_MEMORY_SCOPE_AGENT)) < 4u) { __builtin_amdgcn_s_sleep(1); if (++sp > (1u << 22)) break; } }
            asm volatile("" ::: "memory");
#pragma unroll
            for (int q = 0; q < 2; ++q) { const int i = lane + 64 * q, rl = (i >> 6) * 128 + wr * 64 + (i & 63);
                float t1 = 0.f, t2 = 0.f;
#pragma unroll
                for (int pn = 0; pn < 4; ++pn) { const unsigned long long pv = __hip_atomic_load((unsigned long long*)(part + ((size_t)(u.pm * 4 + pn) * 256 + rl) * 2), __ATOMIC_RELAXED, __HIP_MEMORY_SCOPE_AGENT);
                    t1 += __uint_as_float((unsigned)pv); t2 += __uint_as_float((unsigned)(pv >> 32)); }
                const float mean = t1 * (1.0f / 1024.0f); const float var = fmaxf(t2 * (1.0f / 1024.0f) - mean * mean, 0.f);
                stats[rl * 2] = mean; stats[rl * 2 + 1] = rsqrtf(var + LN_EPS); }
        }
        __syncthreads();
#pragma unroll
        for (int ai = 0; ai < 2; ++ai)
#pragma unroll
            for (int m = 0; m < 4; ++m) { const size_t r = (size_t)(row0 + ai * 128 + m * 16); const int rl = ai * 128 + wr * 64 + m * 16 + fr;
                const float mean = stats[rl * 2], rstd = stats[rl * 2 + 1];
#pragma unroll
                for (int bj = 0; bj < 2; ++bj)
#pragma unroll
                    for (int n = 0; n < 2; ++n) { const int c = col0 + bj * 128 + n * 16;
                        const f32x4 gv = *(const f32x4*)(gam + c), bv = *(const f32x4*)(bet + c);
                        const f32x4 y = (acc[ai][bj][m][n] - mean) * rstd * gv + bv;
                        if (MODE == 0) *(u32x2*)((unsigned short*)outp + r * 1024 + c) = (u32x2){cvt_pk_bf16(y[0], y[1]), cvt_pk_bf16(y[2], y[3])};
                        else *(f32x4*)((float*)outp + r * 1024 + c) = y; } }
    }
};
struct EpiZ {
    static constexpr bool PERM = true;
    unsigned short* z; int ld;
    __device__ __forceinline__ void operator()(const f32x4 (&acc)[2][2][4][2], const Unit& u, int wr, int wc, int fr, int fq) const {
        const int row0 = u.pm * 256 + wr * 64 + fr, col0 = u.pn * 256 + wc * 32 + 8 * fq;
#pragma unroll
        for (int ai = 0; ai < 2; ++ai)
#pragma unroll
            for (int m = 0; m < 4; ++m) { unsigned short* rowp = z + (size_t)(row0 + ai * 128 + m * 16) * ld + col0;
#pragma unroll
                for (int bj = 0; bj < 2; ++bj) { const f32x4 v0 = acc[ai][bj][m][0], v1 = acc[ai][bj][m][1];
                    *(u32x4*)(rowp + bj * 128) = (u32x4){cvt_pk_bf16(v0[0], v0[1]), cvt_pk_bf16(v0[2], v0[3]), cvt_pk_bf16(v1[0], v1[1]), cvt_pk_bf16(v1[2], v1[3])}; } }
    }
};

__device__ void transpose_convert(const float* __restrict__ src, unsigned short* __restrict__ dst, int K, int N, float* tile  , int ldd = 0, const bool pair_m = false) {
    if (ldd == 0) ldd = K;
    auto srcblk = [&](int tn) -> int { if (!pair_m || tn < 80) return tn; const int q = tn - 80, tt = q >> 2, r4 = q & 3; return (r4 < 2) ? (80 + tt * 2 + r4) : (96 + tt * 2 + (r4 - 2)); };
    const int tid = threadIdx.x; const int nk = K / 64, nn = N / 64, ntile = nk * nn;
    const int r = tid >> 3, c = (tid & 7) * 8;
    f32x4 a, b;
    int t = blockIdx.x;
    if (t < ntile) { const int tk = t / nn, tn = t % nn; const float* p = src + (size_t)(tk * 64 + r) * N + srcblk(tn) * 64 + c; a = *(const f32x4*)p; b = *(const f32x4*)(p + 4); }
    for (; t < ntile; t += gridDim.x) {
        const int tk = t / nn, tn = t % nn;
        { float* q = tile + r * 65 + c; q[0] = a[0]; q[1] = a[1]; q[2] = a[2]; q[3] = a[3]; q[4] = b[0]; q[5] = b[1]; q[6] = b[2]; q[7] = b[3]; }
        __syncthreads();
        { const int t2 = t + gridDim.x;
          if (t2 < ntile) { const int tk2 = t2 / nn, tn2 = t2 % nn; const float* p = src + (size_t)(tk2 * 64 + r) * N + srcblk(tn2) * 64 + c; a = *(const f32x4*)p; b = *(const f32x4*)(p + 4); } }
        { const int n = tid >> 3, k0 = (tid & 7) * 8; float v[8];
#pragma unroll
          for (int j = 0; j < 8; ++j) v[j] = tile[(k0 + j) * 65 + n];
          *(u32x4*)(dst + (size_t)(tn * 64 + n) * ldd + tk * 64 + k0) = (u32x4){cvt_pk_bf16(v[0], v[1]), cvt_pk_bf16(v[2], v[3]), cvt_pk_bf16(v[4], v[5]), cvt_pk_bf16(v[6], v[7])}; }
        __syncthreads();
    }
}
__device__ void phase_prep(const Params& p, unsigned char* lds_generic) {
    float* tile = (float*)lds_generic;
    unsigned char* ws = p.ws;
    { const size_t n8 = (size_t)T_TOK * DM / 8; unsigned short* xb = (unsigned short*)(ws + OFF_XB);
      const size_t stride = (size_t)gridDim.x * NTHREADS;
      for (size_t i = (size_t)blockIdx.x * NTHREADS + threadIdx.x; i < n8; i += 4 * stride) {
          f32x4 a[4], b[4];
#pragma unroll
          for (int j = 0; j < 4; ++j) { const size_t ii = i + j * stride; if (ii < n8) { a[j] = *(const f32x4*)(p.x + ii * 8); b[j] = *(const f32x4*)(p.x + ii * 8 + 4); } }
#pragma unroll
          for (int j = 0; j < 4; ++j) { const size_t ii = i + j * stride; if (ii < n8)
              *(u32x4*)(xb + ii * 8) = (u32x4){cvt_pk_bf16(a[j][0], a[j][1]), cvt_pk_bf16(a[j][2], a[j][3]), cvt_pk_bf16(b[j][0], b[j][1]), cvt_pk_bf16(b[j][2], b[j][3])}; } } }
    { float* cs = (float*)(ws + OFF_MISC);
      for (int i = blockIdx.x * NTHREADS + threadIdx.x; i < IN_COLS; i += gridDim.x * NTHREADS) {
          float v = 1.0f;
          if (i >= 2048 && i < 3072) { const int c = i - 2048; const float l0 = p.lb_logits[c], l1 = p.lb_logits[HG + c]; const float lb = 1.0f / (1.0f + expf(l1 - l0)); v = 1.0f - lb; }
          cs[i] = v; } }
    transpose_convert(p.w_in, (unsigned short*)(ws + OFF_WIN), DM, IN_COLS, tile, 0, true);
    transpose_convert(p.w_conv_out, (unsigned short*)(ws + OFF_WCO), CONV_DIM, DM, tile, CONV_DIM + HG);
    transpose_convert(p.w_hgrn_out, (unsigned short*)(ws + OFF_WCO) + CONV_DIM, HG, DM, tile, CONV_DIM + HG);
    transpose_convert(p.w_out, (unsigned short*)(ws + OFF_WOUT), DM, DM, tile);
    transpose_convert(p.w_ffn_in, (unsigned short*)(ws + OFF_WFI), DM, 2 * DFF, tile);
    transpose_convert(p.w_ffn_out, (unsigned short*)(ws + OFF_WFO), DFF, DM, tile);
}

__device__ void phase_conv(const Params& p, unsigned char* lds) {
    unsigned short* gin = (unsigned short*)lds;
    float* obuf = (float*)(lds + 96256);
    const unsigned short* cvg = (const unsigned short*)(p.ws + OFF_CVG);
    unsigned short* cout = (unsigned short*)(p.ws + OFF_XB);
    const int tid = threadIdx.x, wid = tid >> 6, lane = tid & 63;
    float w[CONV_K];
#pragma unroll
    for (int k = 0; k < CONV_K; ++k) w[k] = p.w_conv_dw[k * CONV_DIM + tid];
    const float bias = p.b_conv_dw[tid];
    float lg[8], lb[8];
#pragma unroll
    for (int j = 0; j < 8; ++j) { lg[j] = p.conv_ln_g[lane * 8 + j]; lb[j] = p.conv_ln_b[lane * 8 + j]; }
    for (int tile = blockIdx.x; tile < T_TOK / 64; tile += gridDim.x) {
        const int t0 = tile * 64, pos0 = t0 % SEQ;
        __syncthreads();
#pragma unroll
        for (int it0 = 0; it0 < 12; it0 += 4) {
            u32x4 av[4], bv[4];
#pragma unroll
            for (int q = 0; q < 4; ++q) { const int i = tid + (it0 + q) * NTHREADS; const int row = i >> 6, c8 = (i & 63) * 8; const int pos = pos0 + row - 30;
                const bool valid = (i < 94 * 64) && (pos >= 0);
                const size_t tk = valid ? (size_t)(t0 + row - 30) : (size_t)t0;
                av[q] = *(const u32x4*)(cvg + tk * 1024 + c8); bv[q] = *(const u32x4*)(cvg + tk * 1024 + 512 + c8);
                if (!valid) { av[q] = (u32x4){0u, 0u, 0u, 0u}; bv[q] = av[q]; } }
#pragma unroll
            for (int q = 0; q < 4; ++q) { const int i = tid + (it0 + q) * NTHREADS; const int row = i >> 6, c8 = (i & 63) * 8;
                if (i < 94 * 64) { u32x4 o;
#pragma unroll
                    for (int j = 0; j < 4; ++j) o[j] = cvt_pk_bf16(bflo(av[q][j]) * bflo(bv[q][j]), bfhi(av[q][j]) * bfhi(bv[q][j]));
                    *(u32x4*)(gin + row * 512 + c8) = o; } }
        }
        __syncthreads();
        for (int rr = 0; rr < 4; ++rr) {
            float in[46];
#pragma unroll
            for (int j = 0; j < 46; ++j) in[j] = bf2f(gin[(rr * 16 + j) * 512 + tid]);
#pragma unroll
            for (int i = 0; i < 16; ++i) { float a = bias;
#pragma unroll
                for (int k = 0; k < CONV_K; ++k) a += w[k] * in[i + k];
                obuf[i * 512 + tid] = a; }
            __syncthreads();
#pragma unroll
            for (int q = 0; q < 2; ++q) { const int i = wid * 2 + q; const float* rp = obuf + i * 512 + lane * 8;
                const f32x4 a = *(const f32x4*)rp, b = *(const f32x4*)(rp + 4);
                float v[8] = {a[0], a[1], a[2], a[3], b[0], b[1], b[2], b[3]};
                float s = 0.f;
#pragma unroll
                for (int j = 0; j < 8; ++j) s += v[j];
                const float mean = wave_sum(s) * (1.0f / 512.0f);
                float ss = 0.f;
#pragma unroll
                for (int j = 0; j < 8; ++j) { v[j] -= mean; ss += v[j] * v[j]; }
                const float rstd = rsqrtf(wave_sum(ss) * (1.0f / 512.0f) + LN_EPS);
                float y[8];
#pragma unroll
                for (int j = 0; j < 8; ++j) { const float t = v[j] * rstd * lg[j] + lb[j]; y[j] = t * sigmoidf_(t); }
                *(u32x4*)(cout + (size_t)(t0 + rr * 16 + i) * 512 + lane * 8) = (u32x4){cvt_pk_bf16(y[0], y[1]), cvt_pk_bf16(y[2], y[3]), cvt_pk_bf16(y[4], y[5]), cvt_pk_bf16(y[6], y[7])}; }
            __syncthreads();
        }
    }
}

constexpr int H_QT = 0;
constexpr int H_KN = H_QT + 64 * 272;
constexpr int H_KT = H_KN + 64 * 272;
constexpr int H_VT = H_KT + 128 * 144;
constexpr int H_PP = H_VT + 128 * 144;
constexpr int H_SB = H_PP + 64 * 144;
constexpr int H_SEG = H_SB + 128 * 272;
constexpr int H_ER = H_SEG + 8192;
constexpr int H_EBL = H_ER + 512;
constexpr int H_SS = H_EBL + 512;
constexpr int H_END = H_SS + 2048;
static_assert(H_END <= LDS_BYTES, "hgrn lds");

template <bool OUT>
__device__ void hgrn_phase(const Params& p, unsigned char* lds, const int reps = 1) {
    const int tid = threadIdx.x, w = tid >> 6, lane = tid & 63, g = lane >> 4, c16 = lane & 15;
    const unsigned short* qg = (const unsigned short*)(p.ws + OFF_Q);
    const unsigned short* king = (const unsigned short*)(p.ws + OFF_KIN);
    const unsigned short* vg = (const unsigned short*)(p.ws + OFF_V);
    const unsigned short* gg = (const unsigned short*)(p.ws + OFF_G);
    unsigned short* og = (unsigned short*)(p.ws + OFF_CVG);
    float* segsum = (float*)(lds + H_SEG); float* er = (float*)(lds + H_ER); float* ebl = (float*)(lds + H_EBL); float* ssb = (float*)(lds + H_SS);
    const int kp = tid & 63;
    const int nchain = (256 - (int)blockIdx.x + (int)gridDim.x - 1) / (int)gridDim.x, nstep = nchain * 16 * reps;

    unsigned kraw[8], vraw[8], qraw[8];
    auto chunk_base = [&](int step) -> size_t {
        const int chain = blockIdx.x + ((step >> 4) % nchain) * gridDim.x, item = chain * 4 + ((step >> 2) & 3), c = step & 3;
        const int bh = item >> 5, sc = item & 31, b = bh >> 3, h = bh & 7;
        return ((size_t)b * SEQ + (size_t)sc * 256 + 64 * c + 8 * w) * 1024 + h * 128 + 2 * kp;
    };
    auto load_raw = [&](int step) {
        const size_t gbase = chunk_base(step);
#pragma unroll
        for (int tt = 0; tt < 8; ++tt) kraw[tt] = *(const unsigned*)(king + gbase + (size_t)tt * 1024);
#pragma unroll
        for (int tt = 0; tt < 8; ++tt) vraw[tt] = *(const unsigned*)(vg + gbase + (size_t)tt * 1024);
        if (OUT) {
#pragma unroll
            for (int tt = 0; tt < 8; ++tt) qraw[tt] = *(const unsigned*)(qg + gbase + (size_t)tt * 1024);
        }
    };
    float lf0[8], lf1[8], k0[8], k1[8];
    auto part1 = [&](int step) {
        float run0 = 0.f, run1 = 0.f;
#pragma unroll
        for (int tt = 0; tt < 8; ++tt) {
            const unsigned short lo = (unsigned short)(kraw[tt] & 0xffffu), hi = (unsigned short)(kraw[tt] >> 16);
            _Float16 hl, hh; __builtin_memcpy(&hl, &lo, 2); __builtin_memcpy(&hh, &hi, 2);
            k0[tt] = (float)hl; k1[tt] = (float)hh;
            run0 += __logf(fmaxf(1.0f - k0[tt], 1e-30f)); lf0[tt] = run0; run1 += __logf(fmaxf(1.0f - k1[tt], 1e-30f)); lf1[tt] = run1; }
        *(f32x2*)(segsum + (step & 1) * 1024 + w * 128 + 2 * kp) = (f32x2){run0, run1};
    };
    if (nstep > 0) { load_raw(0); part1(0); }

    f32x4 S[8];
    f32x4 gn = (f32x4){0.f, 0.f, 0.f, 0.f};
    float btot0 = 0.f, btot1 = 0.f;
    for (int step = 0; step < nstep; ++step) {
        const int chain = blockIdx.x + ((step >> 4) % nchain) * gridDim.x, jj = (step >> 2) & 3, item = chain * 4 + jj, c = step & 3;
        const int bh = item >> 5, sc = item & 31, b = bh >> 3, h = bh & 7;
        const size_t tc = (size_t)b * SEQ + (size_t)sc * 256 + 64 * c; const int ch0 = h * 128;
        unsigned short* Lg = (unsigned short*)(p.ws + OFF_L) + (size_t)chain * 16384;
        if (c == 0 && jj == 0) {
#pragma unroll
            for (int kt = 0; kt < 8; ++kt) {
                S[kt] = (f32x4){0.f, 0.f, 0.f, 0.f};
            }
            if (OUT) {
                const int nprev = chain & 7;
                for (int j = 0; j < nprev; ++j) {
                    const unsigned short* Lj = (const unsigned short*)(p.ws + OFF_L) + (size_t)((chain & ~7) + j) * 16384;
                    const float* Dj = (const float*)(p.ws + OFF_D) + (size_t)((chain & ~7) + j) * 128;
#pragma unroll
                    for (int kt = 0; kt < 8; ++kt) {
                        const u32x2 lv = *(const u32x2*)(Lj + (16 * w + c16) * 128 + 16 * kt + 4 * g);
                        const f32x4 dv = *(const f32x4*)(Dj + 16 * kt + 4 * g);
                        S[kt] = S[kt] * dv + (f32x4){bflo(lv[0]), bfhi(lv[0]), bflo(lv[1]), bfhi(lv[1])}; }
                }
            }
            if (OUT) gn = *(const f32x4*)(p.hgrn_norm_g + ch0 + 16 * w + 4 * g);
            btot0 = 0.f; btot1 = 0.f;
        }
        {
            __syncthreads();
            float off0 = 0.f, off1 = 0.f, r0 = 0.f, r1 = 0.f, bl0 = 0.f, bl1 = 0.f;
#pragma unroll
            for (int sg = 0; sg < 8; ++sg) { const f32x2 sv = *(const f32x2*)(segsum + (step & 1) * 1024 + sg * 128 + 2 * kp);
                if (sg < w) { off0 += sv[0]; off1 += sv[1]; }
                if (sg < 4) { r0 += sv[0]; r1 += sv[1]; }
                bl0 += sv[0]; bl1 += sv[1]; }
            unsigned short kb0[8], kb1[8];
#pragma unroll
            for (int tt = 0; tt < 8; ++tt) {
                const float b0 = off0 + lf0[tt], b1 = off1 + lf1[tt];
                const float kt0 = k0[tt] * __expf(fminf(r0 - b0, 80.f)), kt1 = k1[tt] * __expf(fminf(r1 - b1, 80.f));
                const unsigned kpk = cvt_pk_bf16(kt0, kt1);
                kb0[tt] = (unsigned short)(kpk & 0xffffu); kb1[tt] = (unsigned short)(kpk >> 16);
                if (OUT) {
                    *(unsigned*)(lds + H_KN + (8 * w + tt) * 272 + kp * 4) = kpk;
                    const float q0 = bflo(qraw[tt]) * __expf(fminf(b0 - r0, 80.f)), q1 = bfhi(qraw[tt]) * __expf(fminf(b1 - r1, 80.f));
                    *(unsigned*)(lds + H_QT + (8 * w + tt) * 272 + kp * 4) = cvt_pk_bf16(q0, q1);
                }
            }
            u32x4 ka, kbv, va, vb;
#pragma unroll
            for (int j = 0; j < 4; ++j) {
                ka[j] = (unsigned)kb0[2 * j] | ((unsigned)kb0[2 * j + 1] << 16);
                kbv[j] = (unsigned)kb1[2 * j] | ((unsigned)kb1[2 * j + 1] << 16);
                va[j] = (vraw[2 * j] & 0xffffu) | (vraw[2 * j + 1] << 16);
                vb[j] = (vraw[2 * j] >> 16) | (vraw[2 * j + 1] & 0xffff0000u); }
            *(u32x4*)(lds + H_KT + (2 * kp) * 144 + w * 16) = ka;
            *(u32x4*)(lds + H_KT + (2 * kp + 1) * 144 + w * 16) = kbv;
            *(u32x4*)(lds + H_VT + (2 * kp) * 144 + w * 16) = va;
            *(u32x4*)(lds + H_VT + (2 * kp + 1) * 144 + w * 16) = vb;
            if (w == 0) { *(f32x2*)(er + 2 * kp) = (f32x2){__expf(r0), __expf(r1)}; *(f32x2*)(ebl + 2 * kp) = (f32x2){__expf(bl0 - r0), __expf(bl1 - r1)}; btot0 += bl0; btot1 += bl1; }
        }
        __syncthreads();
        if (step + 1 < nstep) load_raw(step + 1);
#pragma unroll
        for (int kt = 0; kt < 8; ++kt) {
            const f32x4 e = *(const f32x4*)(er + 16 * kt + 4 * g);
            S[kt] = S[kt] * e;
            if (OUT) *(u32x2*)(lds + H_SB + (16 * w + c16) * 272 + (16 * kt + 4 * g) * 2) = (u32x2){cvt_pk_bf16(S[kt][0], S[kt][1]), cvt_pk_bf16(S[kt][2], S[kt][3])};
        }
        if (OUT) {
#pragma unroll
            for (int i = 0; i < 2; ++i) {
                const int id = 2 * w + i, st = id >> 2, tt = id & 3;
                f32x4 a4 = (f32x4){0.f, 0.f, 0.f, 0.f};
                if (st <= tt) {
#pragma unroll
                    for (int ks = 0; ks < 4; ++ks) {
                        const bf16x8 af = *(const bf16x8*)(lds + H_KN + (16 * st + c16) * 272 + (32 * ks + 8 * g) * 2);
                        const bf16x8 bf = *(const bf16x8*)(lds + H_QT + (16 * tt + c16) * 272 + (32 * ks + 8 * g) * 2);
                        a4 = __builtin_amdgcn_mfma_f32_16x16x32_bf16(af, bf, a4, 0, 0, 0);
                    }
                    const int tcol = 16 * tt + c16;
#pragma unroll
                    for (int r = 0; r < 4; ++r) { const int srow = 16 * st + 4 * g + r; if (srow > tcol) a4[r] = 0.f; }
                }
                *(u32x2*)(lds + H_PP + (16 * tt + c16) * 144 + (16 * st + 4 * g) * 2) = (u32x2){cvt_pk_bf16(a4[0], a4[1]), cvt_pk_bf16(a4[2], a4[3])};
            }
        }
        __syncthreads();
        f32x4 O[4];
        u32x2 gzv[4];
        if (OUT) {
#pragma unroll
            for (int tt = 0; tt < 4; ++tt) gzv[tt] = *(const u32x2*)(gg + (tc + 16 * tt + c16) * 1024 + ch0 + 16 * w + 4 * g);
        }
        if (OUT) {
#pragma unroll
            for (int tt = 0; tt < 4; ++tt) {
                f32x4 a4 = (f32x4){0.f, 0.f, 0.f, 0.f};
#pragma unroll
                for (int ks = 0; ks < 2; ++ks) {
                    const bf16x8 af = *(const bf16x8*)(lds + H_VT + (16 * w + c16) * 144 + (32 * ks + 8 * g) * 2);
                    const bf16x8 bf = *(const bf16x8*)(lds + H_PP + (16 * tt + c16) * 144 + (32 * ks + 8 * g) * 2);
                    a4 = __builtin_amdgcn_mfma_f32_16x16x32_bf16(af, bf, a4, 0, 0, 0);
                }
#pragma unroll
                for (int ks = 0; ks < 4; ++ks) {
                    const bf16x8 af = *(const bf16x8*)(lds + H_SB + (16 * w + c16) * 272 + (32 * ks + 8 * g) * 2);
                    const bf16x8 bf = *(const bf16x8*)(lds + H_QT + (16 * tt + c16) * 272 + (32 * ks + 8 * g) * 2);
                    a4 = __builtin_amdgcn_mfma_f32_16x16x32_bf16(af, bf, a4, 0, 0, 0);
                }
                O[tt] = a4;
            }
        }
#pragma unroll
        for (int kt = 0; kt < 8; ++kt) {
#pragma unroll
            for (int ks = 0; ks < 2; ++ks) {
                const bf16x8 af = *(const bf16x8*)(lds + H_KT + (16 * kt + c16) * 144 + (32 * ks + 8 * g) * 2);
                const bf16x8 bf = *(const bf16x8*)(lds + H_VT + (16 * w + c16) * 144 + (32 * ks + 8 * g) * 2);
                S[kt] = __builtin_amdgcn_mfma_f32_16x16x32_bf16(af, bf, S[kt], 0, 0, 0);
            }
            const f32x4 e = *(const f32x4*)(ebl + 16 * kt + 4 * g);
            S[kt] = S[kt] * e;
        }
        if (OUT) {
#pragma unroll
            for (int tt = 0; tt < 4; ++tt) {
                float s = O[tt][0] * O[tt][0] + O[tt][1] * O[tt][1] + O[tt][2] * O[tt][2] + O[tt][3] * O[tt][3];
                s += __shfl_xor(s, 16); s += __shfl_xor(s, 32);
                if (g == 0) ssb[w * 64 + 16 * tt + c16] = s;
            }
            __syncthreads();
#pragma unroll
            for (int tt = 0; tt < 4; ++tt) {
                const int t = 16 * tt + c16; float tot = 0.f;
#pragma unroll
                for (int ww = 0; ww < 8; ++ww) tot += ssb[ww * 64 + t];
                const float rs = rsqrtf(tot * (1.0f / 128.0f) + RMS_EPS);
                const size_t gi = (tc + t) * 1024 + ch0 + 16 * w + 4 * g;
                const u32x2 gz = gzv[tt];
                const float o0 = bf2f(f2bf(O[tt][0] * rs * gn[0])) * bflo(gz[0]), o1 = bf2f(f2bf(O[tt][1] * rs * gn[1])) * bfhi(gz[0]);
                const float o2 = bf2f(f2bf(O[tt][2] * rs * gn[2])) * bflo(gz[1]), o3 = bf2f(f2bf(O[tt][3] * rs * gn[3])) * bfhi(gz[1]);
                *(u32x2*)(og + gi) = (u32x2){cvt_pk_bf16(o0, o1), cvt_pk_bf16(o2, o3)};
            }
        }
        if (!OUT && c == 3 && jj == 3) {
            float* Dg = (float*)(p.ws + OFF_D) + (size_t)chain * 128;
#pragma unroll
            for (int kt = 0; kt < 8; ++kt)
                *(u32x2*)(Lg + (16 * w + c16) * 128 + 16 * kt + 4 * g) = (u32x2){cvt_pk_bf16(S[kt][0], S[kt][1]), cvt_pk_bf16(S[kt][2], S[kt][3])};
            if (w == 0) *(f32x2*)(Dg + 2 * kp) = (f32x2){__expf(btot0), __expf(btot1)};
        }
        if (step + 1 < nstep) part1(step + 1);
    }
    __syncthreads();
}

__device__ void phase_scan(const Params& p) {
    unsigned short* L = (unsigned short*)(p.ws + OFF_L); const float* D = (const float*)(p.ws + OFF_D);
    for (int i = blockIdx.x * NTHREADS + threadIdx.x; i < 32 * 4096; i += gridDim.x * NTHREADS) {
        const int bh = i >> 12, e4 = i & 4095, k0 = (e4 & 31) * 4;
        f32x4 carry = (f32x4){0.f, 0.f, 0.f, 0.f};
        u32x2 v[8]; f32x4 d[8];
#pragma unroll
        for (int s = 0; s < 8; ++s) { const int chain = bh * 8 + s; v[s] = *(const u32x2*)(L + (size_t)chain * 16384 + e4 * 4); d[s] = *(const f32x4*)(D + chain * 128 + k0); }
#pragma unroll
        for (int s = 0; s < 8; ++s) { const int chain = bh * 8 + s;
            *(u32x2*)(L + (size_t)chain * 16384 + e4 * 4) = (u32x2){cvt_pk_bf16(carry[0], carry[1]), cvt_pk_bf16(carry[2], carry[3])};
            const f32x4 lv = (f32x4){bflo(v[s][0]), bfhi(v[s][0]), bflo(v[s][1]), bfhi(v[s][1])};
            carry = carry * d[s] + lv; }
    }
}

__device__ void phase_ln(float* buf, const float* gam, const float* bet, unsigned short* copyb) {
    const int lane = threadIdx.x & 63, wv = blockIdx.x * 8 + (threadIdx.x >> 6), nw = gridDim.x * 8;
    f32x4 gv[4], bv[4];
#pragma unroll
    for (int i = 0; i < 4; ++i) { gv[i] = *(const f32x4*)(gam + i * 256 + lane * 4); bv[i] = *(const f32x4*)(bet + i * 256 + lane * 4); }
    for (int r = wv; r < T_TOK; r += nw) {
        float* rp = buf + (size_t)r * 1024;
        f32x4 v[4]; float s = 0.f;
#pragma unroll
        for (int i = 0; i < 4; ++i) { v[i] = *(const f32x4*)(rp + i * 256 + lane * 4); s += v[i][0] + v[i][1] + v[i][2] + v[i][3]; }
        const float mean = wave_sum(s) * (1.0f / 1024.0f);
        float ss = 0.f;
#pragma unroll
        for (int i = 0; i < 4; ++i) { v[i] = v[i] - mean; ss += v[i][0] * v[i][0] + v[i][1] * v[i][1] + v[i][2] * v[i][2] + v[i][3] * v[i][3]; }
        const float rstd = rsqrtf(wave_sum(ss) * (1.0f / 1024.0f) + LN_EPS);
#pragma unroll
        for (int i = 0; i < 4; ++i) { const f32x4 y = v[i] * rstd * gv[i] + bv[i];
            if (copyb) *(u32x2*)(copyb + (size_t)r * 1024 + i * 256 + lane * 4) = (u32x2){cvt_pk_bf16(y[0], y[1]), cvt_pk_bf16(y[2], y[3])};
            else *(f32x4*)(rp + i * 256 + lane * 4) = y; }
    }
}

__device__ __forceinline__ float gelu_tanh(float x) {
    const float y = 0.7978845608028654f * (x + 0.044715f * x * x * x);
    const float t = 1.0f - 2.0f * __builtin_amdgcn_rcpf(1.0f + __expf(2.0f * y));
    return 0.5f * x * (1.0f + t);
}
__device__ void phase_act(const Params& p) {
    unsigned short* z = (unsigned short*)(p.ws + OFF_Z);
    constexpr int NCG = DFF / 8, RUN = 16, NRUN = T_TOK / RUN;
    for (int i = blockIdx.x * NTHREADS + threadIdx.x; i < NCG * NRUN; i += gridDim.x * NTHREADS) {
        const int cgi = i % NCG, run = i / NCG; const int c = cgi * 8; const size_t t0 = (size_t)run * RUN;
        float w0[8], w1[8], w2[8], bb[8];
#pragma unroll
        for (int j = 0; j < 8; ++j) { w0[j] = p.w_ffn_dw[c + j]; w1[j] = p.w_ffn_dw[DFF + c + j]; w2[j] = p.w_ffn_dw[2 * DFF + c + j]; bb[j] = p.b_ffn_dw[c + j]; }
        float um2[8], um1[8];
        if ((t0 % SEQ) == 0) {
#pragma unroll
            for (int j = 0; j < 8; ++j) { um2[j] = 0.f; um1[j] = 0.f; }
        } else {
            const u32x4 a = *(const u32x4*)(z + (t0 - 2) * (2 * DFF) + c), b = *(const u32x4*)(z + (t0 - 1) * (2 * DFF) + c);
#pragma unroll
            for (int j = 0; j < 4; ++j) { um2[2 * j] = bflo(a[j]); um2[2 * j + 1] = bfhi(a[j]); um1[2 * j] = bflo(b[j]); um1[2 * j + 1] = bfhi(b[j]); }
        }
#pragma unroll 4
        for (int tt = 0; tt < RUN; ++tt) {
            unsigned short* rowp = z + (t0 + tt) * (2 * DFF);
            const u32x4 a = *(const u32x4*)(rowp + c), gq = *(const u32x4*)(rowp + DFF + c);
            float u[8], gvv[8], o[8];
#pragma unroll
            for (int j = 0; j < 4; ++j) { u[2 * j] = bflo(a[j]); u[2 * j + 1] = bfhi(a[j]); gvv[2 * j] = bflo(gq[j]); gvv[2 * j + 1] = bfhi(gq[j]); }
#pragma unroll
            for (int j = 0; j < 8; ++j) { const float cv = w0[j] * um2[j] + w1[j] * um1[j] + w2[j] * u[j] + bb[j]; o[j] = gelu_tanh(cv) * gvv[j]; um2[j] = um1[j]; um1[j] = u[j]; }
            *(u32x4*)(rowp + DFF + c) = (u32x4){cvt_pk_bf16(o[0], o[1]), cvt_pk_bf16(o[2], o[3]), cvt_pk_bf16(o[4], o[5]), cvt_pk_bf16(o[6], o[7])};
        }
    }
}


#define XB_TMO      128
#define XB_XCNT(j)  (256  + 64 * (j))
#define XB_XSUB(j)  (1280 + 64 * (j))
#define XB_XGEN(j)  (2304 + 64 * (j))
#define XB_TOP      3328
#define XB_TOPGEN   3392
#define XCD_BAR_WORDS 3456
#define XB_SPIN_CAP (1u << 22)
__device__ __forceinline__ unsigned xb_ld(unsigned* p)              { return __hip_atomic_load(p, __ATOMIC_RELAXED, __HIP_MEMORY_SCOPE_AGENT); }
__device__ __forceinline__ unsigned xb_add(unsigned* p, unsigned v) { return __hip_atomic_fetch_add(p, v, __ATOMIC_RELAXED, __HIP_MEMORY_SCOPE_AGENT); }
__device__ __forceinline__ unsigned xb_xcc_id() { return (unsigned)__builtin_amdgcn_s_getreg((3 << 11) | 20) & 0xFu; }
#define XB_SPIN(cond, bar) do { unsigned _sp = 0; while (cond) { __builtin_amdgcn_s_sleep(1); \
    if ((++_sp & 255u) == 0u) { if (xb_ld(&(bar)[XB_TMO])) break; if (_sp > XB_SPIN_CAP) { atomicAdd(&(bar)[XB_TMO], 1u); break; } } } } while (0)
struct XcdBarrier { unsigned* bar; unsigned x; volatile LAS unsigned* st; };
__device__ __forceinline__ XcdBarrier xcd_barrier_post(unsigned* bar, volatile LAS unsigned* st) {
    XcdBarrier b; b.bar = bar; b.x = xb_xcc_id(); b.st = st;
    if (threadIdx.x == 0) (void)xb_add(&bar[XB_XCNT(b.x)], 1u);
    return b;
}
__device__ __forceinline__ void xcd_barrier_complete(unsigned* bar, unsigned x, unsigned& nloc, unsigned& nx) {
    const unsigned G = gridDim.x * gridDim.y * gridDim.z;
    unsigned sum, cnt, mine, sp = 0u;
    for (;;) {
        sum = 0u; cnt = 0u; mine = 0u;
#pragma unroll
        for (unsigned j = 0; j < 16; ++j) { const unsigned c = xb_ld(&bar[XB_XCNT(j)]); sum += c; cnt += (c > 0u) ? 1u : 0u; mine = (j == x) ? c : mine; }
        if (sum == G) break;
        __builtin_amdgcn_s_sleep(1);
        if ((++sp & 255u) == 0u) { if (xb_ld(&bar[XB_TMO])) break; if (sp > XB_SPIN_CAP) { atomicAdd(&bar[XB_TMO], 1u); break; } }
    }
    nloc = mine > 0u ? mine : 1u; nx = cnt > 0u ? cnt : 1u;
}
__device__ __forceinline__ void xcd_barrier(const XcdBarrier& b) {
    asm volatile("s_waitcnt vmcnt(0)" ::: "memory");
    __syncthreads();
    if (threadIdx.x == 0) {
        unsigned* bar = b.bar;
        __builtin_amdgcn_s_waitcnt(0);
        unsigned nloc = b.st[0], nx = b.st[1];
        if (nloc == 0u) { xcd_barrier_complete(bar, b.x, nloc, nx); b.st[0] = nloc; b.st[1] = nx; }
        const unsigned old = xb_add(&bar[XB_XSUB(b.x)], 1u);
        const unsigned gen = old / nloc;
        if (old + 1u == (gen + 1u) * nloc) {
            __builtin_amdgcn_fence(__ATOMIC_RELEASE, "agent");
            asm volatile("s_waitcnt vmcnt(0)" ::: "memory");
            const unsigned og = xb_add(&bar[XB_TOP], 1u);
            const unsigned tg = og / nx;
            if (og + 1u == (tg + 1u) * nx) xb_add(&bar[XB_TOPGEN], 1u);
            else XB_SPIN(xb_ld(&bar[XB_TOPGEN]) == tg, bar);
            __builtin_amdgcn_fence(__ATOMIC_ACQUIRE, "agent");
            xb_add(&bar[XB_XGEN(b.x)], 1u);
            asm volatile("s_waitcnt vmcnt(0)" ::: "memory");
        } else {
            XB_SPIN(xb_ld(&bar[XB_XGEN(b.x)]) == gen, bar);
            __builtin_amdgcn_fence(__ATOMIC_ACQUIRE, "agent");
            asm volatile("s_waitcnt vmcnt(0)" ::: "memory");
        }
    }
    __syncthreads();
}

#ifndef PHASE_MASK
#define PHASE_MASK 0x1fff
#endif
#ifndef DUP_MASK
#define DUP_MASK 0
#endif
#define PHASE(n) if ((PHASE_MASK & (1 << (n))) && (ph_only < 0 || ph_only == (n))) for (int rep_ = 0; rep_ < 1 + ((DUP_MASK >> (n)) & 1); ++rep_)
#define SYNC() do { if (ph_only < 0) xcd_barrier(xb); } while (0)
__global__ void __launch_bounds__(NTHREADS, 2) fwd_megakernel(Params p, int ph_only) {
    extern __shared__ __attribute__((aligned(16))) unsigned char shm[];
    cg::grid_group grid = cg::this_grid();
    LAS unsigned char* lds3 = (LAS unsigned char*)shm;
    volatile LAS unsigned* xst = (volatile LAS unsigned*)(lds3 + LDS_BYTES - 16);
    if (threadIdx.x == 0) { xst[0] = 0u; xst[1] = 0u; }
    __syncthreads();
    const XcdBarrier xb = xcd_barrier_post((unsigned*)(p.ws + OFF_BAR), xst);
    PHASE(0) { phase_prep(p, shm); }
    if (ph_only == -12345) grid.sync();
    SYNC();
    PHASE(1) { pg8::StaticOrder<IN_COLS / 256> S; S.init(T_TOK, IN_COLS, gridDim.x, blockIdx.x);
               pg8::Gemm g{(const bf16_t*)(p.ws + OFF_XB), (const bf16_t*)(p.ws + OFF_WIN), T_TOK, IN_COLS, DM, DM, nullptr, 0, 0};
               EpiProj e{p.ws, (unsigned short*)p.out, (const float*)(p.ws + OFF_MISC)}; pg8::gemm_phase(lds3, g, S, e); }
    SYNC();
    PHASE(2) { phase_conv(p, shm);
               hgrn_phase<false>(p, shm); }
    SYNC();
    PHASE(4) { hgrn_phase<true>(p, shm); }
    SYNC();
    PHASE(5) { pg8::StaticOrder<DM / 256> S; S.init(T_TOK, DM, gridDim.x, blockIdx.x);
               pg8::Gemm g{(const bf16_t*)(p.ws + OFF_XB), (const bf16_t*)(p.ws + OFF_WCO), T_TOK, DM, CONV_DIM + HG, CONV_DIM, (const bf16_t*)(p.ws + OFF_CVG), HG, CONV_DIM / 64};
               EpiMix e{(const unsigned short*)p.out, (unsigned short*)(p.ws + OFF_V)}; pg8::gemm_phase<EpiMix, true>(lds3, g, S, e); }
    SYNC();
    PHASE(7) { pg8::StaticOrder<DM / 256> S; S.init(T_TOK, DM, gridDim.x, blockIdx.x);
               pg8::Gemm g{(const bf16_t*)(p.ws + OFF_V), (const bf16_t*)(p.ws + OFF_WOUT), T_TOK, DM, DM, DM, nullptr, 0, 0};
               EpiLn<0> e{p.x, p.ws + OFF_G, p.ln1_g, p.ln1_b, (float*)(p.ws + OFF_PART7), (unsigned*)(p.ws + OFF_CNT), lds3 + 131072}; pg8::gemm_phase(lds3, g, S, e); }
    SYNC();
    PHASE(9) { pg8::StaticOrder<2 * DFF / 256> S; S.init(T_TOK, 2 * DFF, gridDim.x, blockIdx.x);
               pg8::Gemm g{(const bf16_t*)(p.ws + OFF_G), (const bf16_t*)(p.ws + OFF_WFI), T_TOK, 2 * DFF, DM, DM, nullptr, 0, 0};
               EpiZ e{(unsigned short*)(p.ws + OFF_Z), 2 * DFF}; pg8::gemm_phase(lds3, g, S, e); }
    SYNC();
    PHASE(10) { phase_act(p); }
    SYNC();
    PHASE(11) { pg8::StaticOrder<DM / 256> S; S.init(T_TOK, DM, gridDim.x, blockIdx.x);
                pg8::Gemm g{(const bf16_t*)(p.ws + OFF_Z) + DFF, (const bf16_t*)(p.ws + OFF_WFO), T_TOK, DM, DFF, 2 * DFF, nullptr, 0, 0};
                EpiLn<1> e{p.ws + OFF_G, p.out, p.ln2_g, p.ln2_b, (float*)(p.ws + OFF_PART11), (unsigned*)(p.ws + OFF_CNT) + 128 * 2 * 64, lds3 + 131072}; pg8::gemm_phase(lds3, g, S, e); }
}

extern "C" void kernel_launch(void* const* d_in, const int* in_sizes, int n_in, void* d_out, int out_size, void* d_ws, size_t ws_size, hipStream_t stream) {
    static int grid_blocks = 0;
    if (!grid_blocks) {
        int dev = 0, cus = 0, per_cu = 0;
        hipGetDevice(&dev);
        hipDeviceGetAttribute(&cus, hipDeviceAttributeMultiprocessorCount, dev);
        hipFuncSetAttribute((const void*)fwd_megakernel, hipFuncAttributeMaxDynamicSharedMemorySize, LDS_BYTES);
        hipOccupancyMaxActiveBlocksPerMultiprocessor(&per_cu, (const void*)fwd_megakernel, NTHREADS, LDS_BYTES);
        if (per_cu < 1) per_cu = 1;
        if (per_cu > 1) per_cu = 1;
        grid_blocks = cus * per_cu;
        if (ws_size < WS_NEED) fprintf(stderr, "kernel_launch: workspace too small: %zu < %zu\n", ws_size, (size_t)WS_NEED);
    }
    hipMemsetAsync((unsigned char*)d_ws + OFF_BAR, 0, ZERO_BYTES, stream);
    Params p{};
    p.x = (const float*)d_in[0]; p.w_in = (const float*)d_in[1]; p.w_conv_dw = (const float*)d_in[2]; p.b_conv_dw = (const float*)d_in[3];
    p.conv_ln_g = (const float*)d_in[4]; p.conv_ln_b = (const float*)d_in[5]; p.w_conv_out = (const float*)d_in[6]; p.lb_logits = (const float*)d_in[7];
    p.hgrn_norm_g = (const float*)d_in[8]; p.w_hgrn_out = (const float*)d_in[9]; p.w_out = (const float*)d_in[10]; p.ln1_g = (const float*)d_in[11];
    p.ln1_b = (const float*)d_in[12]; p.w_ffn_in = (const float*)d_in[13]; p.w_ffn_dw = (const float*)d_in[14]; p.b_ffn_dw = (const float*)d_in[15];
    p.w_ffn_out = (const float*)d_in[16]; p.ln2_g = (const float*)d_in[17]; p.ln2_b = (const float*)d_in[18];
    p.out = (float*)d_out; p.ws = (unsigned char*)d_ws;
#if defined(MULTI_LAUNCH)
    for (int ph = 0; ph < 13; ++ph) hipLaunchKernelGGL(fwd_megakernel, dim3(grid_blocks), dim3(NTHREADS), LDS_BYTES, stream, p, ph);
#else
    int ph_only = -1;
    void* args[] = {&p, &ph_only};
    hipError_t e = hipLaunchCooperativeKernel((const void*)fwd_megakernel, dim3(grid_blocks), dim3(NTHREADS), args, LDS_BYTES, stream);
    if (e != hipSuccess) fprintf(stderr, "cooperative launch failed: %s (grid %d)\n", hipGetErrorString(e), grid_blocks);
#endif
}
```

```cpp
#include <hip/hip_runtime.h>
#include <hip/hip_cooperative_groups.h>
#include <cstdio>
namespace cg = cooperative_groups;

#define LAS __attribute__((address_space(3)))
typedef unsigned short bf16_t;
typedef short bf16x8 __attribute__((ext_vector_type(8)));
typedef float f32x4 __attribute__((ext_vector_type(4)));
typedef float f32x2 __attribute__((ext_vector_type(2)));
typedef unsigned u32x4 __attribute__((ext_vector_type(4)));
typedef unsigned u32x2 __attribute__((ext_vector_type(2)));

constexpr int T_TOK = 32768, SEQ = 8192, DM = 1024, IN_COLS = 7168, CONV_DIM = 512, CONV_K = 31, HG = 1024, DFF = 2816;
constexpr float ALPHA = 1.189207115002721f;
constexpr float LN_EPS = 1e-5f, RMS_EPS = 1e-6f;
constexpr int NTHREADS = 512;
constexpr int LDS_BYTES = 140 * 1024;

constexpr size_t MiB = 1024ull * 1024ull;
constexpr size_t OFF_W    = 0;
constexpr size_t OFF_WIN  = OFF_W;
constexpr size_t OFF_WCO  = OFF_WIN + (size_t)IN_COLS * DM * 2;
constexpr size_t OFF_WHO  = OFF_WCO + (size_t)DM * CONV_DIM * 2;
constexpr size_t OFF_WOUT = OFF_WHO + (size_t)DM * HG * 2;
constexpr size_t OFF_WFI  = OFF_WOUT + (size_t)DM * DM * 2;
constexpr size_t OFF_WFO  = OFF_WFI + (size_t)2 * DFF * DM * 2;
constexpr size_t OFF_G    = 36 * MiB;
constexpr size_t OFF_Q    = 100 * MiB;
constexpr size_t OFF_KIN  = 164 * MiB;
constexpr size_t OFF_V    = 228 * MiB;
constexpr size_t OFF_XB   = 292 * MiB;
constexpr size_t OFF_CVG  = 356 * MiB;
constexpr size_t OFF_L    = 420 * MiB;
constexpr size_t OFF_D    = 484 * MiB;
constexpr size_t OFF_MISC = 485 * MiB;
constexpr size_t OFF_Z    = OFF_Q;
constexpr size_t OFF_PART7  = 486 * MiB;
constexpr size_t OFF_PART11 = 487 * MiB;
constexpr size_t OFF_BAR  = 489 * MiB;
constexpr size_t OFF_CNT  = OFF_BAR + 64 * 1024;
constexpr size_t ZERO_BYTES = 64 * 1024 + 2 * 128 * 2 * 256;
constexpr size_t WS_NEED  = 490 * MiB;

struct Params {
    const float* x; const float* w_in; const float* w_conv_dw; const float* b_conv_dw; const float* conv_ln_g; const float* conv_ln_b;
    const float* w_conv_out; const float* lb_logits; const float* hgrn_norm_g; const float* w_hgrn_out; const float* w_out;
    const float* ln1_g; const float* ln1_b; const float* w_ffn_in; const float* w_ffn_dw; const float* b_ffn_dw; const float* w_ffn_out;
    const float* ln2_g; const float* ln2_b;
    float* out; unsigned char* ws;
};

__device__ __forceinline__ unsigned cvt_pk_bf16(float lo, float hi) { unsigned r; asm("v_cvt_pk_bf16_f32 %0, %1, %2" : "=v"(r) : "v"(lo), "v"(hi)); return r; }
__device__ __forceinline__ float bf2f(unsigned short b) { return __uint_as_float(((unsigned)b) << 16); }
__device__ __forceinline__ float bflo(unsigned u) { return __uint_as_float(u << 16); }
__device__ __forceinline__ float bfhi(unsigned u) { return __uint_as_float(u & 0xffff0000u); }
__device__ __forceinline__ unsigned short f2bf(float f) { return (unsigned short)(cvt_pk_bf16(f, 0.f) & 0xffffu); }
__device__ __forceinline__ float sigmoidf_(float x) { return __builtin_amdgcn_rcpf(1.0f + __expf(-x)); }
__device__ __forceinline__ unsigned pk_f16(float lo, float hi) {
    _Float16 a = (_Float16)lo, b = (_Float16)hi; unsigned short ua, ub; __builtin_memcpy(&ua, &a, 2); __builtin_memcpy(&ub, &b, 2); return (unsigned)ua | ((unsigned)ub << 16); }
__device__ __forceinline__ float wave_sum(float v) {
#pragma unroll
    for (int o = 32; o >= 1; o >>= 1) v += __shfl_xor(v, o);
    return v; }

namespace pg8 {
constexpr int BM = 256, BK = 64, HALF = 128, HTB = HALF * BK * 2, STAGE_BYTES = 8 * HTB, NXCD = 8, WGM = 4;
__host__ __device__ __forceinline__ int lds_byte(int r, int c) { const int st = (r >> 4) * 2 + (c >> 5), rr = r & 15, cc = c & 31, ob = rr * 64 + cc * 2; return st * 1024 + (ob ^ (((ob >> 9) & 1) << 5)); }
__host__ __device__ __forceinline__ void stage_rc(int b, int& R, int& C) { const int st = b / 1024, sb = b % 1024, swz = sb ^ (((sb >> 9) & 1) << 5); R = (st >> 1) * 16 + swz / 64; C = (st & 1) * 32 + (swz % 64) / 2; }
__host__ __device__ __forceinline__ int perm32(int rho) { const int n = rho >> 4, i = rho & 15; return 8 * (i >> 2) + 4 * n + (i & 3); }
struct Unit { int pm, pn; };
struct Gemm { const bf16_t* A; const bf16_t* Bt; int M, N, K, lda; const bf16_t* A2; int lda2; int ksplit; };
template <int NN  > struct StaticOrder {
    static constexpr int nM = T_TOK / BM, nN = NN, nwg = nM * nN, nig = WGM * nN, q = nwg / NXCD;
    static_assert(nwg % NXCD == 0 && nM % WGM == 0, "unit order");
    int G, c, reps, rounds;
    __device__ void init(int, int, int G_, int c_, int reps_ = 1) { G = G_; c = c_; reps = reps_; rounds = (nwg + G - 1) / G; }
    __device__ bool next(int i, Unit& u) const {
        if (i >= rounds * reps) return false;
        const int ir = (reps == 1) ? i : (i % rounds);
        const long L = (long)ir * G + c; if (L >= nwg) return false;
        const int l = (int)L, wgid = (l % NXCD) * q + l / NXCD;
        const int gid = wgid / nig, idx = wgid % nig;
        u.pm = gid * WGM + (idx % WGM); u.pn = idx / WGM; return true;
    }
};

template <class Epi, bool DUAL = false, class Sched>
__device__ __forceinline__ void gemm_phase(LAS unsigned char* lds, const Gemm g, const Sched& S, Epi& E) {
    const int tid = threadIdx.x, wid = __builtin_amdgcn_readfirstlane(tid >> 6), lane = tid & 63, wr = wid >> 2, wc = wid & 3, fr = lane & 15, fq = lane >> 4;
    const int K = g.K, nt = K / BK, lda = g.lda, lda2 = g.lda2, ksplit = g.ksplit;
    unsigned voffA[2], voffA2[2], voffB[2];
#pragma unroll
    for (int i = 0; i < 2; ++i) { int R, C; stage_rc(tid * 16 + i * 8192, R, C); const int Rb = Epi::PERM ? ((R & ~31) + perm32(R & 31)) : R;
        voffA[i] = (unsigned)(R * lda + C) * 2u; voffA2[i] = DUAL ? (unsigned)(R * lda2 + C) * 2u : 0u; voffB[i] = (unsigned)(Rb * K + C) * 2u; }
    const size_t kstep = (size_t)(BK * 2);
    const size_t hstepA = (size_t)HALF * lda * 2, hstepA2 = (size_t)HALF * lda2 * 2, hstepB = (size_t)HALF * K * 2;
    const unsigned ldsw = (unsigned)wid * 1024u;
    const int aoff = lds_byte(wr * 64 + fr, fq * 8), boff = lds_byte(wc * 32 + fr, fq * 8);
#define PG8_SA(b, h) (((b) * 2 + (h)) * HTB)
#define PG8_SB(b, h) ((4 + (b) * 2 + (h)) * HTB)
    auto stA = [&](int bufoff, int pm, int kt, int half) {
        const char* base; unsigned v0, v1;
        if (DUAL && kt >= ksplit) { base = (const char*)g.A2 + (size_t)(2 * pm + half) * hstepA2 + (size_t)(kt - ksplit) * kstep; v0 = voffA2[0]; v1 = voffA2[1]; }
        else                      { base = (const char*)g.A  + (size_t)(2 * pm + half) * hstepA  + (size_t)kt * kstep;            v0 = voffA[0];  v1 = voffA[1]; }
        __builtin_amdgcn_global_load_lds((const unsigned*)(base + v0), (LAS unsigned*)(lds + bufoff + ldsw), 16, 0, 0);
        __builtin_amdgcn_global_load_lds((const unsigned*)(base + v1), (LAS unsigned*)(lds + bufoff + ldsw + 8192), 16, 0, 0);
    };
    auto stB = [&](int bufoff, int pn, int kt, int half) {
        const char* base = (const char*)g.Bt + (size_t)(2 * pn + half) * hstepB + (size_t)kt * kstep;
        __builtin_amdgcn_global_load_lds((const unsigned*)(base + voffB[0]), (LAS unsigned*)(lds + bufoff + ldsw), 16, 0, 0);
        __builtin_amdgcn_global_load_lds((const unsigned*)(base + voffB[1]), (LAS unsigned*)(lds + bufoff + ldsw + 8192), 16, 0, 0);
    };
#define PG8_LDA(dst, b, h) do { _Pragma("unroll") for (int m = 0; m < 4; ++m) _Pragma("unroll") for (int k = 0; k < 2; ++k) dst[m][k] = *(const LAS bf16x8*)(lds + PG8_SA(b, h) + aoff + m * 2048 + k * 1024); } while (0)
#define PG8_LDB(dst, b, h) do { _Pragma("unroll") for (int n = 0; n < 2; ++n) _Pragma("unroll") for (int k = 0; k < 2; ++k) dst[n][k] = *(const LAS bf16x8*)(lds + PG8_SB(b, h) + boff + n * 2048 + k * 1024); } while (0)
#define PG8_MMA(ai, bj, At, Bt) do { __builtin_amdgcn_s_setprio(1); _Pragma("unroll") for (int m = 0; m < 4; ++m) _Pragma("unroll") for (int n = 0; n < 2; ++n) _Pragma("unroll") for (int k = 0; k < 2; ++k) \
        acc[ai][bj][m][n] = __builtin_amdgcn_mfma_f32_16x16x32_bf16(Bt[n][k], At[m][k], acc[ai][bj][m][n], 0, 0, 0); __builtin_amdgcn_s_setprio(0); } while (0)
#define PG8_WAIT_V(n) asm volatile("s_waitcnt vmcnt(" #n ")" ::: "memory")
#define PG8_WAIT_L(n) asm volatile("s_waitcnt lgkmcnt(" #n ")" ::: "memory")
#define PG8_BAR __builtin_amdgcn_s_barrier()
#define PG8_SCHED __builtin_amdgcn_sched_barrier(0)
    Unit cur, nxt; int ui = 0;
    if (!S.next(0, cur)) return;
    f32x4 acc[2][2][4][2];
#pragma unroll
    for (int a = 0; a < 2; ++a)
#pragma unroll
        for (int b = 0; b < 2; ++b)
#pragma unroll
            for (int m = 0; m < 4; ++m)
#pragma unroll
                for (int n = 0; n < 2; ++n) acc[a][b][m][n] = (f32x4){0.f, 0.f, 0.f, 0.f};
    bf16x8 At[4][2], B0[2][2], B1[2][2];
    stB(PG8_SB(0, 0), cur.pn, 0, 0); stA(PG8_SA(0, 0), cur.pm, 0, 0); stB(PG8_SB(0, 1), cur.pn, 0, 1); stA(PG8_SA(0, 1), cur.pm, 0, 1);
    if (wr == 1) PG8_BAR;
    PG8_WAIT_V(4); PG8_BAR;
    stB(PG8_SB(1, 0), cur.pn, 1, 0); stA(PG8_SA(1, 0), cur.pm, 1, 0); stB(PG8_SB(1, 1), cur.pn, 1, 1);
    PG8_WAIT_V(6); PG8_BAR;
    for (;;) {
        const bool has_next = S.next(ui + 1, nxt);
        const int npm = has_next ? nxt.pm : cur.pm, npn = has_next ? nxt.pn : cur.pn;
        for (int t = 0; t < nt; t += 2) {
            const bool last = (t == nt - 2);
            const int pm2 = last ? npm : cur.pm, pn2 = last ? npn : cur.pn, k2 = last ? 0 : t + 2, k3 = k2 + 1;
            if constexpr (DUAL) { if (t == ksplit) E.mid(acc, cur, wr, wc, fr, fq); }
            PG8_LDB(B0, 0, 0); PG8_SCHED; PG8_LDA(At, 0, 0); stA(PG8_SA(1, 1), cur.pm, t + 1, 1);
            PG8_WAIT_L(8); PG8_BAR; PG8_WAIT_L(0); PG8_MMA(0, 0, At, B0); PG8_BAR; PG8_SCHED;
            PG8_LDB(B1, 0, 1); stB(PG8_SB(0, 0), pn2, k2, 0);
            PG8_BAR; PG8_WAIT_L(0); PG8_MMA(0, 1, At, B1); PG8_BAR;
            PG8_LDA(At, 0, 1); stA(PG8_SA(0, 0), pm2, k2, 0);
            PG8_BAR; PG8_WAIT_L(0); PG8_MMA(1, 0, At, B0); PG8_BAR; PG8_SCHED;
            stB(PG8_SB(0, 1), pn2, k2, 1);
            PG8_WAIT_V(6); PG8_BAR; PG8_MMA(1, 1, At, B1); PG8_BAR;
            PG8_LDB(B0, 1, 0); PG8_SCHED; PG8_LDA(At, 1, 0); stA(PG8_SA(0, 1), pm2, k2, 1);
            PG8_WAIT_L(8); PG8_BAR; PG8_WAIT_L(0); PG8_MMA(0, 0, At, B0); PG8_BAR; PG8_SCHED;
            PG8_LDB(B1, 1, 1); stB(PG8_SB(1, 0), pn2, k3, 0);
            PG8_BAR; PG8_WAIT_L(0); PG8_MMA(0, 1, At, B1); PG8_BAR;
            PG8_LDA(At, 1, 1); stA(PG8_SA(1, 0), pm2, k3, 0);
            PG8_BAR; PG8_WAIT_L(0); PG8_MMA(1, 0, At, B0); PG8_BAR; PG8_SCHED;
            stB(PG8_SB(1, 1), pn2, k3, 1);
            PG8_WAIT_V(6); PG8_BAR; PG8_MMA(1, 1, At, B1); PG8_BAR;
        }
        E(acc, cur, wr, wc, fr, fq);
        if (!has_next) break;
#pragma unroll
        for (int a = 0; a < 2; ++a)
#pragma unroll
            for (int b = 0; b < 2; ++b)
#pragma unroll
                for (int m = 0; m < 4; ++m)
#pragma unroll
                    for (int n = 0; n < 2; ++n) acc[a][b][m][n] = (f32x4){0.f, 0.f, 0.f, 0.f};
        cur = nxt; ++ui;
    }
    PG8_WAIT_V(0);
    if (wr == 0) PG8_BAR;
    PG8_BAR;
#undef PG8_SA
#undef PG8_SB
#undef PG8_LDA
#undef PG8_LDB
#undef PG8_MMA
#undef PG8_WAIT_V
#undef PG8_WAIT_L
#undef PG8_BAR
#undef PG8_SCHED
}
}
using pg8::Unit;

struct EpiProj {
    static constexpr bool PERM = true;
    unsigned char* ws; unsigned short* mgate; const float* colscale;
    __device__ __forceinline__ void operator()(const f32x4 (&acc)[2][2][4][2], const Unit& u, int wr, int wc, int fr, int fq) const {
        const int pn = u.pn;
        if (pn >= 20) {
            const int rowg = u.pm * 256 + wr * 64 + fr, chl = (pn - 20) * 128 + wc * 32 + 8 * fq;
#pragma unroll
            for (int ai = 0; ai < 2; ++ai)
#pragma unroll
                for (int m = 0; m < 4; ++m) {
                    float ra[8], g1[8];
#pragma unroll
                    for (int n = 0; n < 2; ++n)
#pragma unroll
                        for (int j = 0; j < 4; ++j) { const float d0 = 1.0f + __expf(-acc[ai][0][m][n][j]), d1 = 1.0f + __expf(-acc[ai][1][m][n][j]);
                            g1[n * 4 + j] = __builtin_amdgcn_rcpf(d1); ra[n * 4 + j] = d1 * __builtin_amdgcn_rcpf(d0); }
                    unsigned short* rowp = mgate + (size_t)(rowg + ai * 128 + m * 16) * 2048 + chl;
                    *(u32x4*)rowp = (u32x4){cvt_pk_bf16(ra[0], ra[1]), cvt_pk_bf16(ra[2], ra[3]), cvt_pk_bf16(ra[4], ra[5]), cvt_pk_bf16(ra[6], ra[7])};
                    *(u32x4*)(rowp + 1024) = (u32x4){cvt_pk_bf16(g1[0], g1[1]), cvt_pk_bf16(g1[2], g1[3]), cvt_pk_bf16(g1[4], g1[5]), cvt_pk_bf16(g1[6], g1[7])};
                }
            return;
        }
        unsigned short* base; int ld, colt; float c0, c1, c2, sgn; bool f16 = false;
        if (pn < 4)       { base = (unsigned short*)(ws + OFF_CVG); ld = 1024; colt = pn * 256; if (pn < 2) { c0 = 1.f; c1 = 0.f; c2 = 0.f; } else { c0 = 0.f; c1 = 1.f; c2 = 0.f; } sgn = 1.f; }
        else if (pn < 8)  { base = (unsigned short*)(ws + OFF_Q);   ld = 1024; colt = (pn - 4) * 256;  c0 = 0.f; c1 = 0.f; c2 = 1.f; sgn = 1.f; }
        else if (pn < 12) { base = (unsigned short*)(ws + OFF_KIN); ld = 1024; colt = (pn - 8) * 256;  c0 = 0.f; c1 = 1.f; c2 = 0.f; sgn = -1.f; f16 = true; }
        else if (pn < 16) { base = (unsigned short*)(ws + OFF_V);   ld = 1024; colt = (pn - 12) * 256; c0 = 1.f; c1 = 0.f; c2 = 0.f; sgn = 1.f; }
        else if (pn < 20) { base = (unsigned short*)(ws + OFF_G);   ld = 1024; colt = (pn - 16) * 256; c0 = 0.f; c1 = 0.f; c2 = 1.f; sgn = 1.f; }
        else              { base = mgate;                           ld = 2048; colt = (pn - 20) * 256; c0 = 0.f; c1 = 1.f; c2 = 0.f; sgn = 1.f; }
        const int row0 = u.pm * 256 + wr * 64 + fr, coll = wc * 32 + 8 * fq;
        f32x4 cs[2][2];
#pragma unroll
        for (int bj = 0; bj < 2; ++bj)
#pragma unroll
            for (int n = 0; n < 2; ++n) cs[bj][n] = f16 ? *(const f32x4*)(colscale + pn * 256 + bj * 128 + coll + 4 * n) : (f32x4){1.f, 1.f, 1.f, 1.f};
#pragma unroll
        for (int ai = 0; ai < 2; ++ai)
#pragma unroll
            for (int m = 0; m < 4; ++m) {
                unsigned short* rowp = base + (size_t)(row0 + ai * 128 + m * 16) * ld + colt + coll;
#pragma unroll
                for (int bj = 0; bj < 2; ++bj) {
                    float o[8];
#pragma unroll
                    for (int n = 0; n < 2; ++n)
#pragma unroll
                        for (int j = 0; j < 4; ++j) { const float z = acc[ai][bj][m][n][j]; const float s = __builtin_amdgcn_rcpf(1.0f + __expf(-sgn * z)); o[n * 4 + j] = (c0 * z + s * (c1 + c2 * z)) * cs[bj][n][j]; }
                    const u32x4 pkh = (u32x4){pk_f16(o[0], o[1]), pk_f16(o[2], o[3]), pk_f16(o[4], o[5]), pk_f16(o[6], o[7])};
                    const u32x4 pkb = (u32x4){cvt_pk_bf16(o[0], o[1]), cvt_pk_bf16(o[2], o[3]), cvt_pk_bf16(o[4], o[5]), cvt_pk_bf16(o[6], o[7])};
                    u32x4 pk;
#pragma unroll
                    for (int q = 0; q < 4; ++q) pk[q] = f16 ? pkh[q] : pkb[q];
                    *(u32x4*)(rowp + bj * 128) = pk;
                }
            }
    }
};
struct EpiMix {
    static constexpr bool PERM = false;
    const unsigned short* mgate; unsigned short* mixed;
    __device__ __forceinline__ void mid(f32x4 (&acc)[2][2][4][2], const Unit& u, int wr, int wc, int fr, int fq) const {
        const int row0 = u.pm * 256 + wr * 64 + fr, col0 = u.pn * 256 + wc * 32 + 4 * fq;
#pragma unroll
        for (int ai = 0; ai < 2; ++ai)
#pragma unroll
            for (int m = 0; m < 4; ++m) { const size_t r = (size_t)(row0 + ai * 128 + m * 16);
#pragma unroll
                for (int bj = 0; bj < 2; ++bj)
#pragma unroll
                    for (int n = 0; n < 2; ++n) { const int c = col0 + bj * 128 + n * 16;
                        const u32x2 ga = *(const u32x2*)(mgate + r * 2048 + c);
                        acc[ai][bj][m][n][0] *= bflo(ga[0]); acc[ai][bj][m][n][1] *= bfhi(ga[0]);
                        acc[ai][bj][m][n][2] *= bflo(ga[1]); acc[ai][bj][m][n][3] *= bfhi(ga[1]); } }
    }
    __device__ __forceinline__ void operator()(const f32x4 (&acc)[2][2][4][2], const Unit& u, int wr, int wc, int fr, int fq) const {
        const int row0 = u.pm * 256 + wr * 64 + fr, col0 = u.pn * 256 + wc * 32 + 4 * fq;
#pragma unroll
        for (int ai = 0; ai < 2; ++ai)
#pragma unroll
            for (int m = 0; m < 4; ++m) { const size_t r = (size_t)(row0 + ai * 128 + m * 16);
#pragma unroll
                for (int bj = 0; bj < 2; ++bj)
#pragma unroll
                    for (int n = 0; n < 2; ++n) { const int c = col0 + bj * 128 + n * 16;
                        const u32x2 gb = *(const u32x2*)(mgate + r * 2048 + 1024 + c);
                        const f32x4 v = acc[ai][bj][m][n];
                        *(u32x2*)(mixed + r * 1024 + c) = (u32x2){cvt_pk_bf16(v[0] * bflo(gb[0]), v[1] * bfhi(gb[0])), cvt_pk_bf16(v[2] * bflo(gb[1]), v[3] * bfhi(gb[1]))}; } }
    }
};
struct EpiRes {
    static constexpr bool PERM = false;
    const float* res; float* dst;
    __device__ __forceinline__ void operator()(const f32x4 (&acc)[2][2][4][2], const Unit& u, int wr, int wc, int fr, int fq) const {
        const int row0 = u.pm * 256 + wr * 64 + fr, col0 = u.pn * 256 + wc * 32 + 4 * fq;
#pragma unroll
        for (int ai = 0; ai < 2; ++ai)
#pragma unroll
            for (int m = 0; m < 4; ++m) { const size_t r = (size_t)(row0 + ai * 128 + m * 16);
#pragma unroll
                for (int bj = 0; bj < 2; ++bj)
#pragma unroll
                    for (int n = 0; n < 2; ++n) { const int c = col0 + bj * 128 + n * 16;
                        const f32x4 t = *(const f32x4*)(res + r * 1024 + c);
                        *(f32x4*)(dst + r * 1024 + c) = t * ALPHA + acc[ai][bj][m][n]; } }
    }
};
struct EpiResB {
    static constexpr bool PERM = false;
    const unsigned short* res; float* dst;
    __device__ __forceinline__ void operator()(const f32x4 (&acc)[2][2][4][2], const Unit& u, int wr, int wc, int fr, int fq) const {
        const int row0 = u.pm * 256 + wr * 64 + fr, col0 = u.pn * 256 + wc * 32 + 4 * fq;
#pragma unroll
        for (int ai = 0; ai < 2; ++ai)
#pragma unroll
            for (int m = 0; m < 4; ++m) { const size_t r = (size_t)(row0 + ai * 128 + m * 16);
#pragma unroll
                for (int bj = 0; bj < 2; ++bj)
#pragma unroll
                    for (int n = 0; n < 2; ++n) { const int c = col0 + bj * 128 + n * 16;
                        const u32x2 t = *(const u32x2*)(res + r * 1024 + c);
                        const f32x4 tv = (f32x4){bflo(t[0]), bfhi(t[0]), bflo(t[1]), bfhi(t[1])};
                        *(f32x4*)(dst + r * 1024 + c) = tv * ALPHA + acc[ai][bj][m][n]; } }
    }
};
template <int MODE  > struct EpiLn {
    static constexpr bool PERM = false;
    const void* res; void* outp; const float* gam; const float* bet; float* part; unsigned* cnt; LAS unsigned char* ldsx;
    __device__ __forceinline__ void operator()(f32x4 (&acc)[2][2][4][2], const Unit& u, int wr, int wc, int fr, int fq) const {
        const int row0 = u.pm * 256 + wr * 64 + fr, col0 = u.pn * 256 + wc * 32 + 4 * fq;
        LAS float* red = (LAS float*)ldsx;
        LAS float* stats = (LAS float*)(ldsx + 8192);
#pragma unroll
        for (int ai = 0; ai < 2; ++ai)
#pragma unroll
            for (int m = 0; m < 4; ++m) { const size_t r = (size_t)(row0 + ai * 128 + m * 16);
                float s1 = 0.f, s2 = 0.f;
#pragma unroll
                for (int bj = 0; bj < 2; ++bj)
#pragma unroll
                    for (int n = 0; n < 2; ++n) { const int c = col0 + bj * 128 + n * 16;
                        f32x4 tv;
                        if (MODE == 0) tv = *(const f32x4*)((const float*)res + r * 1024 + c);
                        else { const u32x2 t = *(const u32x2*)((const unsigned short*)res + r * 1024 + c); tv = (f32x4){bflo(t[0]), bfhi(t[0]), bflo(t[1]), bfhi(t[1])}; }
                        const f32x4 v = tv * ALPHA + acc[ai][bj][m][n];
                        acc[ai][bj][m][n] = v;
                        s1 += v[0] + v[1] + v[2] + v[3]; s2 += v[0] * v[0] + v[1] * v[1] + v[2] * v[2] + v[3] * v[3]; }
                s1 += __shfl_xor(s1, 16); s1 += __shfl_xor(s1, 32); s2 += __shfl_xor(s2, 16); s2 += __shfl_xor(s2, 32);
                if (fq == 0) { const int rl = ai * 128 + wr * 64 + m * 16 + fr; red[(rl * 4 + wc) * 2] = s1; red[(rl * 4 + wc) * 2 + 1] = s2; } }
        __syncthreads();
        if (wc == 0) {
            const int lane = fq * 16 + fr;
            unsigned* cw = cnt + (size_t)(u.pm * 2 + wr) * 64;
            float* mypart = part + ((size_t)(u.pm * 4 + u.pn) * 256) * 2;
#pragma unroll
            for (int q = 0; q < 2; ++q) { const int i = lane + 64 * q, rl = (i >> 6) * 128 + wr * 64 + (i & 63);
                float t1 = 0.f, t2 = 0.f;
#pragma unroll
                for (int w4 = 0; w4 < 4; ++w4) { t1 += red[(rl * 4 + w4) * 2]; t2 += red[(rl * 4 + w4) * 2 + 1]; }
                const unsigned long long pv = (unsigned long long)__float_as_uint(t1) | ((unsigned long long)__float_as_uint(t2) << 32);
                __hip_atomic_store((unsigned long long*)(mypart + rl * 2), pv, __ATOMIC_RELAXED, __HIP_MEMORY_SCOPE_AGENT); }
            asm volatile("s_waitcnt vmcnt(0)" ::: "memory");
            if (lane == 0) (void)__hip_atomic_fetch_add(cw, 1u, __ATOMIC_RELAXED, __HIP_MEMORY_SCOPE_AGENT);
            { unsigned sp = 0;
              while ((unsigned)__builtin_amdgcn_readfirstlane(__hip_atomic_load(cw, __ATOMIC_RELAXED, __HIP_MEMORY_SCOPE_AGENT)) < 4u) { __builtin_amdgcn_s_sleep(1); if (++sp > (1u << 22)) break; } }
            asm volatile("" ::: "memory");
#pragma unroll
            for (int q = 0; q < 2; ++q) { const int i = lane + 64 * q, rl = (i >> 6) * 128 + wr * 64 + (i & 63);
                float t1 = 0.f, t2 = 0.f;
#pragma unroll
                for (int pn = 0; pn < 4; ++pn) { const unsigned long long pv = __hip_atomic_load((unsigned long long*)(part + ((size_t)(u.pm * 4 + pn) * 256 + rl) * 2), __ATOMIC_RELAXED, __HIP_MEMORY_SCOPE_AGENT);
                    t1 += __uint_as_float((unsigned)pv); t2 += __uint_as_float((unsigned)(pv >> 32)); }
                const float mean = t1 * (1.0f / 1024.0f); const float var = fmaxf(t2 * (1.0f / 1024.0f) - mean * mean, 0.f);
                stats[rl * 2] = mean; stats[rl * 2 + 1] = rsqrtf(var + LN_EPS); }
        }
        __syncthreads();
#pragma unroll
        for (int ai = 0; ai < 2; ++ai)
#pragma unroll
            for (int m = 0; m < 4; ++m) { const size_t r = (size_t)(row0 + ai * 128 + m * 16); const int rl = ai * 128 + wr * 64 + m * 16 + fr;
                const float mean = stats[rl * 2], rstd = stats[rl * 2 + 1];
#pragma unroll
                for (int bj = 0; bj < 2; ++bj)
#pragma unroll
                    for (int n = 0; n < 2; ++n) { const int c = col0 + bj * 128 + n * 16;
                        const f32x4 gv = *(const f32x4*)(gam + c), bv = *(const f32x4*)(bet + c);
                        const f32x4 y = (acc[ai][bj][m][n] - mean) * rstd * gv + bv;
                        if (MODE == 0) *(u32x2*)((unsigned short*)outp + r * 1024 + c) = (u32x2){cvt_pk_bf16(y[0], y[1]), cvt_pk_bf16(y[2], y[3])};
                        else *(f32x4*)((float*)outp + r * 1024 + c) = y; } }
    }
};
struct EpiZ {
    static constexpr bool PERM = true;
    unsigned short* z; int ld;
    __device__ __forceinline__ void operator()(const f32x4 (&acc)[2][2][4][2], const Unit& u, int wr, int wc, int fr, int fq) const {
        const int row0 = u.pm * 256 + wr * 64 + fr, col0 = u.pn * 256 + wc * 32 + 8 * fq;
#pragma unroll
        for (int ai = 0; ai < 2; ++ai)
#pragma unroll
            for (int m = 0; m < 4; ++m) { unsigned short* rowp = z + (size_t)(row0 + ai * 128 + m * 16) * ld + col0;
#pragma unroll
                for (int bj = 0; bj < 2; ++bj) { const f32x4 v0 = acc[ai][bj][m][0], v1 = acc[ai][bj][m][1];
                    *(u32x4*)(rowp + bj * 128) = (u32x4){cvt_pk_bf16(v0[0], v0[1]), cvt_pk_bf16(v0[2], v0[3]), cvt_pk_bf16(v1[0], v1[1]), cvt_pk_bf16(v1[2], v1[3])}; } }
    }
};

__device__ void transpose_convert(const float* __restrict__ src, unsigned short* __restrict__ dst, int K, int N, float* tile  , int ldd = 0, const bool pair_m = false) {
    if (ldd == 0) ldd = K;
    auto srcblk = [&](int tn) -> int { if (!pair_m || tn < 80) return tn; const int q = tn - 80, tt = q >> 2, r4 = q & 3; return (r4 < 2) ? (80 + tt * 2 + r4) : (96 + tt * 2 + (r4 - 2)); };
    const int tid = threadIdx.x; const int nk = K / 64, nn = N / 64, ntile = nk * nn;
    const int r = tid >> 3, c = (tid & 7) * 8;
    f32x4 a, b;
    int t = blockIdx.x;
    if (t < ntile) { const int tk = t / nn, tn = t % nn; const float* p = src + (size_t)(tk * 64 + r) * N + srcblk(tn) * 64 + c; a = *(const f32x4*)p; b = *(const f32x4*)(p + 4); }
    for (; t < ntile; t += gridDim.x) {
        const int tk = t / nn, tn = t % nn;
        { float* q = tile + r * 65 + c; q[0] = a[0]; q[1] = a[1]; q[2] = a[2]; q[3] = a[3]; q[4] = b[0]; q[5] = b[1]; q[6] = b[2]; q[7] = b[3]; }
        __syncthreads();
        { const int t2 = t + gridDim.x;
          if (t2 < ntile) { const int tk2 = t2 / nn, tn2 = t2 % nn; const float* p = src + (size_t)(tk2 * 64 + r) * N + srcblk(tn2) * 64 + c; a = *(const f32x4*)p; b = *(const f32x4*)(p + 4); } }
        { const int n = tid >> 3, k0 = (tid & 7) * 8; float v[8];
#pragma unroll
          for (int j = 0; j < 8; ++j) v[j] = tile[(k0 + j) * 65 + n];
          *(u32x4*)(dst + (size_t)(tn * 64 + n) * ldd + tk * 64 + k0) = (u32x4){cvt_pk_bf16(v[0], v[1]), cvt_pk_bf16(v[2], v[3]), cvt_pk_bf16(v[4], v[5]), cvt_pk_bf16(v[6], v[7])}; }
        __syncthreads();
    }
}
__device__ void phase_prep(const Params& p, unsigned char* lds_generic) {
    float* tile = (float*)lds_generic;
    unsigned char* ws = p.ws;
    { const size_t n8 = (size_t)T_TOK * DM / 8; unsigned short* xb = (unsigned short*)(ws + OFF_XB);
      const size_t stride = (size_t)gridDim.x * NTHREADS;
      for (size_t i = (size_t)blockIdx.x * NTHREADS + threadIdx.x; i < n8; i += 4 * stride) {
          f32x4 a[4], b[4];
#pragma unroll
          for (int j = 0; j < 4; ++j) { const size_t ii = i + j * stride; if (ii < n8) { a[j] = *(const f32x4*)(p.x + ii * 8); b[j] = *(const f32x4*)(p.x + ii * 8 + 4); } }
#pragma unroll
          for (int j = 0; j < 4; ++j) { const size_t ii = i + j * stride; if (ii < n8)
              *(u32x4*)(xb + ii * 8) = (u32x4){cvt_pk_bf16(a[j][0], a[j][1]), cvt_pk_bf16(a[j][2], a[j][3]), cvt_pk_bf16(b[j][0], b[j][1]), cvt_pk_bf16(b[j][2], b[j][3])}; } } }
    { float* cs = (float*)(ws + OFF_MISC);
      for (int i = blockIdx.x * NTHREADS + threadIdx.x; i < IN_COLS; i += gridDim.x * NTHREADS) {
          float v = 1.0f;
          if (i >= 2048 && i < 3072) { const int c = i - 2048; const float l0 = p.lb_logits[c], l1 = p.lb_logits[HG + c]; const float lb = 1.0f / (1.0f + expf(l1 - l0)); v = 1.0f - lb; }
          cs[i] = v; } }
    transpose_convert(p.w_in, (unsigned short*)(ws + OFF_WIN), DM, IN_COLS, tile, 0, true);
    transpose_convert(p.w_conv_out, (unsigned short*)(ws + OFF_WCO), CONV_DIM, DM, tile, CONV_DIM + HG);
    transpose_convert(p.w_hgrn_out, (unsigned short*)(ws + OFF_WCO) + CONV_DIM, HG, DM, tile, CONV_DIM + HG);
    transpose_convert(p.w_out, (unsigned short*)(ws + OFF_WOUT), DM, DM, tile);
    transpose_convert(p.w_ffn_in, (unsigned short*)(ws + OFF_WFI), DM, 2 * DFF, tile);
    transpose_convert(p.w_ffn_out, (unsigned short*)(ws + OFF_WFO), DFF, DM, tile);
}

__device__ void phase_conv(const Params& p, unsigned char* lds) {
    unsigned short* gin = (unsigned short*)lds;
    float* obuf = (float*)(lds + 96256);
    const unsigned short* cvg = (const unsigned short*)(p.ws + OFF_CVG);
    unsigned short* cout = (unsigned short*)(p.ws + OFF_XB);
    const int tid = threadIdx.x, wid = tid >> 6, lane = tid & 63;
    float w[CONV_K];
#pragma unroll
    for (int k = 0; k < CONV_K; ++k) w[k] = p.w_conv_dw[k * CONV_DIM + tid];
    const float bias = p.b_conv_dw[tid];
    float lg[8], lb[8];
#pragma unroll
    for (int j = 0; j < 8; ++j) { lg[j] = p.conv_ln_g[lane * 8 + j]; lb[j] = p.conv_ln_b[lane * 8 + j]; }
    for (int tile = blockIdx.x; tile < T_TOK / 64; tile += gridDim.x) {
        const int t0 = tile * 64, pos0 = t0 % SEQ;
        __syncthreads();
#pragma unroll
        for (int it0 = 0; it0 < 12; it0 += 4) {
            u32x4 av[4], bv[4];
#pragma unroll
            for (int q = 0; q < 4; ++q) { const int i = tid + (it0 + q) * NTHREADS; const int row = i >> 6, c8 = (i & 63) * 8; const int pos = pos0 + row - 30;
                const bool valid = (i < 94 * 64) && (pos >= 0);
                const size_t tk = valid ? (size_t)(t0 + row - 30) : (size_t)t0;
                av[q] = *(const u32x4*)(cvg + tk * 1024 + c8); bv[q] = *(const u32x4*)(cvg + tk * 1024 + 512 + c8);
                if (!valid) { av[q] = (u32x4){0u, 0u, 0u, 0u}; bv[q] = av[q]; } }
#pragma unroll
            for (int q = 0; q < 4; ++q) { const int i = tid + (it0 + q) * NTHREADS; const int row = i >> 6, c8 = (i & 63) * 8;
                if (i < 94 * 64) { u32x4 o;
#pragma unroll
                    for (int j = 0; j < 4; ++j) o[j] = cvt_pk_bf16(bflo(av[q][j]) * bflo(bv[q][j]), bfhi(av[q][j]) * bfhi(bv[q][j]));
                    *(u32x4*)(gin + row * 512 + c8) = o; } }
        }
        __syncthreads();
        for (int rr = 0; rr < 4; ++rr) {
            float in[46];
#pragma unroll
            for (int j = 0; j < 46; ++j) in[j] = bf2f(gin[(rr * 16 + j) * 512 + tid]);
#pragma unroll
            for (int i = 0; i < 16; ++i) { float a = bias;
#pragma unroll
                for (int k = 0; k < CONV_K; ++k) a += w[k] * in[i + k];
                obuf[i * 512 + tid] = a; }
            __syncthreads();
#pragma unroll
            for (int q = 0; q < 2; ++q) { const int i = wid * 2 + q; const float* rp = obuf + i * 512 + lane * 8;
                const f32x4 a = *(const f32x4*)rp, b = *(const f32x4*)(rp + 4);
                float v[8] = {a[0], a[1], a[2], a[3], b[0], b[1], b[2], b[3]};
                float s = 0.f;
#pragma unroll
                for (int j = 0; j < 8; ++j) s += v[j];
                const float mean = wave_sum(s) * (1.0f / 512.0f);
                float ss = 0.f;
#pragma unroll
                for (int j = 0; j < 8; ++j) { v[j] -= mean; ss += v[j] * v[j]; }
                const float rstd = rsqrtf(wave_sum(ss) * (1.0f / 512.0f) + LN_EPS);
                float y[8];
#pragma unroll
                for (int j = 0; j < 8; ++j) { const float t = v[j] * rstd * lg[j] + lb[j]; y[j] = t * sigmoidf_(t); }
                *(u32x4*)(cout + (size_t)(t0 + rr * 16 + i) * 512 + lane * 8) = (u32x4){cvt_pk_bf16(y[0], y[1]), cvt_pk_bf16(y[2], y[3]), cvt_pk_bf16(y[4], y[5]), cvt_pk_bf16(y[6], y[7])}; }
            __syncthreads();
        }
    }
}

constexpr int H_QT = 0;
constexpr int H_KN = H_QT + 64 * 272;
constexpr int H_KT = H_KN + 64 * 272;
constexpr int H_VT = H_KT + 128 * 144;
constexpr int H_PP = H_VT + 128 * 144;
constexpr int H_SB = H_PP + 64 * 144;
constexpr int H_SEG = H_SB + 128 * 272;
constexpr int H_ER = H_SEG + 8192;
constexpr int H_EBL = H_ER + 512;
constexpr int H_SS = H_EBL + 512;
constexpr int H_END = H_SS + 2048;
static_assert(H_END <= LDS_BYTES, "hgrn lds");

template <bool OUT>
__device__ void hgrn_phase(const Params& p, unsigned char* lds, const int reps = 1) {
    const int tid = threadIdx.x, w = tid >> 6, lane = tid & 63, g = lane >> 4, c16 = lane & 15;
    const unsigned short* qg = (const unsigned short*)(p.ws + OFF_Q);
    const unsigned short* king = (const unsigned short*)(p.ws + OFF_KIN);
    const unsigned short* vg = (const unsigned short*)(p.ws + OFF_V);
    const unsigned short* gg = (const unsigned short*)(p.ws + OFF_G);
    unsigned short* og = (unsigned short*)(p.ws + OFF_CVG);
    float* segsum = (float*)(lds + H_SEG); float* er = (float*)(lds + H_ER); float* ebl = (float*)(lds + H_EBL); float* ssb = (float*)(lds + H_SS);
    const int kp = tid & 63;
    const int nchain = (256 - (int)blockIdx.x + (int)gridDim.x - 1) / (int)gridDim.x, nstep = nchain * 16 * reps;

    unsigned kraw[8], vraw[8], qraw[8];
    auto chunk_base = [&](int step) -> size_t {
        const int chain = blockIdx.x + ((step >> 4) % nchain) * gridDim.x, item = chain * 4 + ((step >> 2) & 3), c = step & 3;
        const int bh = item >> 5, sc = item & 31, b = bh >> 3, h = bh & 7;
        return ((size_t)b * SEQ + (size_t)sc * 256 + 64 * c + 8 * w) * 1024 + h * 128 + 2 * kp;
    };
    auto load_k = [&](int step) {
        const size_t gbase = chunk_base(step);
#pragma unroll
        for (int tt = 0; tt < 8; ++tt) kraw[tt] = *(const unsigned*)(king + gbase + (size_t)tt * 1024);
    };
    auto load_vq = [&](int step) {
        const size_t gbase = chunk_base(step);
#pragma unroll
        for (int tt = 0; tt < 8; ++tt) vraw[tt] = *(const unsigned*)(vg + gbase + (size_t)tt * 1024);
        if (OUT) {
#pragma unroll
            for (int tt = 0; tt < 8; ++tt) qraw[tt] = *(const unsigned*)(qg + gbase + (size_t)tt * 1024);
        }
    };
    float lf0[8], lf1[8], k0[8], k1[8];
    auto part1 = [&](int step) {
        float run0 = 0.f, run1 = 0.f;
#pragma unroll
        for (int tt = 0; tt < 8; ++tt) {
            const unsigned short lo = (unsigned short)(kraw[tt] & 0xffffu), hi = (unsigned short)(kraw[tt] >> 16);
            _Float16 hl, hh; __builtin_memcpy(&hl, &lo, 2); __builtin_memcpy(&hh, &hi, 2);
            k0[tt] = (float)hl; k1[tt] = (float)hh;
            run0 += __logf(fmaxf(1.0f - k0[tt], 1e-30f)); lf0[tt] = run0; run1 += __logf(fmaxf(1.0f - k1[tt], 1e-30f)); lf1[tt] = run1; }
        *(f32x2*)(segsum + (step & 1) * 1024 + w * 128 + 2 * kp) = (f32x2){run0, run1};
    };
    if (nstep > 0) { load_k(0); load_vq(0); part1(0); }

    f32x4 S[8];
    f32x4 gn = (f32x4){0.f, 0.f, 0.f, 0.f};
    float btot0 = 0.f, btot1 = 0.f;
    for (int step = 0; step < nstep; ++step) {
        const int chain = blockIdx.x + ((step >> 4) % nchain) * gridDim.x, jj = (step >> 2) & 3, item = chain * 4 + jj, c = step & 3;
        const int bh = item >> 5, sc = item & 31, b = bh >> 3, h = bh & 7;
        const size_t tc = (size_t)b * SEQ + (size_t)sc * 256 + 64 * c; const int ch0 = h * 128;
        unsigned short* Lg = (unsigned short*)(p.ws + OFF_L) + (size_t)chain * 16384;
        if (c == 0 && jj == 0) {
#pragma unroll
            for (int kt = 0; kt < 8; ++kt) {
                S[kt] = (f32x4){0.f, 0.f, 0.f, 0.f};
            }
            if (OUT) {
                const int nprev = chain & 7;
                for (int j = 0; j < nprev; ++j) {
                    const unsigned short* Lj = (const unsigned short*)(p.ws + OFF_L) + (size_t)((chain & ~7) + j) * 16384;
                    const float* Dj = (const float*)(p.ws + OFF_D) + (size_t)((chain & ~7) + j) * 128;
#pragma unroll
                    for (int kt = 0; kt < 8; ++kt) {
                        const u32x2 lv = *(const u32x2*)(Lj + (16 * w + c16) * 128 + 16 * kt + 4 * g);
                        const f32x4 dv = *(const f32x4*)(Dj + 16 * kt + 4 * g);
                        S[kt] = S[kt] * dv + (f32x4){bflo(lv[0]), bfhi(lv[0]), bflo(lv[1]), bfhi(lv[1])}; }
                }
            }
            if (OUT) gn = *(const f32x4*)(p.hgrn_norm_g + ch0 + 16 * w + 4 * g);
            btot0 = 0.f; btot1 = 0.f;
        }
        {
            __syncthreads();
            if (step + 1 < nstep) load_k(step + 1);
            float off0 = 0.f, off1 = 0.f, r0 = 0.f, r1 = 0.f, bl0 = 0.f, bl1 = 0.f;
#pragma unroll
            for (int sg = 0; sg < 8; ++sg) { const f32x2 sv = *(const f32x2*)(segsum + (step & 1) * 1024 + sg * 128 + 2 * kp);
                if (sg < w) { off0 += sv[0]; off1 += sv[1]; }
                if (sg < 4) { r0 += sv[0]; r1 += sv[1]; }
                bl0 += sv[0]; bl1 += sv[1]; }
            unsigned short kb0[8], kb1[8];
#pragma unroll
            for (int tt = 0; tt < 8; ++tt) {
                const float b0 = off0 + lf0[tt], b1 = off1 + lf1[tt];
                const float kt0 = k0[tt] * __expf(fminf(r0 - b0, 80.f)), kt1 = k1[tt] * __expf(fminf(r1 - b1, 80.f));
                const unsigned kpk = cvt_pk_bf16(kt0, kt1);
                kb0[tt] = (unsigned short)(kpk & 0xffffu); kb1[tt] = (unsigned short)(kpk >> 16);
                if (OUT) {
                    *(unsigned*)(lds + H_KN + (8 * w + tt) * 272 + kp * 4) = kpk;
                    const float q0 = bflo(qraw[tt]) * __expf(fminf(b0 - r0, 80.f)), q1 = bfhi(qraw[tt]) * __expf(fminf(b1 - r1, 80.f));
                    *(unsigned*)(lds + H_QT + (8 * w + tt) * 272 + kp * 4) = cvt_pk_bf16(q0, q1);
                }
            }
            u32x4 ka, kbv, va, vb;
#pragma unroll
            for (int j = 0; j < 4; ++j) {
                ka[j] = (unsigned)kb0[2 * j] | ((unsigned)kb0[2 * j + 1] << 16);
                kbv[j] = (unsigned)kb1[2 * j] | ((unsigned)kb1[2 * j + 1] << 16);
                va[j] = (vraw[2 * j] & 0xffffu) | (vraw[2 * j + 1] << 16);
                vb[j] = (vraw[2 * j] >> 16) | (vraw[2 * j + 1] & 0xffff0000u); }
            *(u32x4*)(lds + H_KT + (2 * kp) * 144 + w * 16) = ka;
            *(u32x4*)(lds + H_KT + (2 * kp + 1) * 144 + w * 16) = kbv;
            *(u32x4*)(lds + H_VT + (2 * kp) * 144 + w * 16) = va;
            *(u32x4*)(lds + H_VT + (2 * kp + 1) * 144 + w * 16) = vb;
            if (w == 0) { *(f32x2*)(er + 2 * kp) = (f32x2){__expf(r0), __expf(r1)}; *(f32x2*)(ebl + 2 * kp) = (f32x2){__expf(bl0 - r0), __expf(bl1 - r1)}; btot0 += bl0; btot1 += bl1; }
        }
        __syncthreads();
        if (step + 1 < nstep) load_vq(step + 1);
#pragma unroll
        for (int kt = 0; kt < 8; ++kt) {
            const f32x4 e = *(const f32x4*)(er + 16 * kt + 4 * g);
            S[kt] = S[kt] * e;
            if (OUT) *(u32x2*)(lds + H_SB + (16 * w + c16) * 272 + (16 * kt + 4 * g) * 2) = (u32x2){cvt_pk_bf16(S[kt][0], S[kt][1]), cvt_pk_bf16(S[kt][2], S[kt][3])};
        }
        if (OUT) {
#pragma unroll
            for (int i = 0; i < 2; ++i) {
                const int id = 2 * w + i, st = id >> 2, tt = id & 3;
                f32x4 a4 = (f32x4){0.f, 0.f, 0.f, 0.f};
                if (st <= tt) {
#pragma unroll
                    for (int ks = 0; ks < 4; ++ks) {
                        const bf16x8 af = *(const bf16x8*)(lds + H_KN + (16 * st + c16) * 272 + (32 * ks + 8 * g) * 2);
                        const bf16x8 bf = *(const bf16x8*)(lds + H_QT + (16 * tt + c16) * 272 + (32 * ks + 8 * g) * 2);
                        a4 = __builtin_amdgcn_mfma_f32_16x16x32_bf16(af, bf, a4, 0, 0, 0);
                    }
                    const int tcol = 16 * tt + c16;
#pragma unroll
                    for (int r = 0; r < 4; ++r) { const int srow = 16 * st + 4 * g + r; if (srow > tcol) a4[r] = 0.f; }
                }
                *(u32x2*)(lds + H_PP + (16 * tt + c16) * 144 + (16 * st + 4 * g) * 2) = (u32x2){cvt_pk_bf16(a4[0], a4[1]), cvt_pk_bf16(a4[2], a4[3])};
            }
        }
        __syncthreads();
        f32x4 O[4];
        u32x2 gzv[4];
        if (OUT) {
#pragma unroll
            for (int tt = 0; tt < 4; ++tt) gzv[tt] = *(const u32x2*)(gg + (tc + 16 * tt + c16) * 1024 + ch0 + 16 * w + 4 * g);
        }
        if (OUT) {
#pragma unroll
            for (int tt = 0; tt < 4; ++tt) {
                f32x4 a4 = (f32x4){0.f, 0.f, 0.f, 0.f};
#pragma unroll
                for (int ks = 0; ks < 2; ++ks) {
                    const bf16x8 af = *(const bf16x8*)(lds + H_VT + (16 * w + c16) * 144 + (32 * ks + 8 * g) * 2);
                    const bf16x8 bf = *(const bf16x8*)(lds + H_PP + (16 * tt + c16) * 144 + (32 * ks + 8 * g) * 2);
                    a4 = __builtin_amdgcn_mfma_f32_16x16x32_bf16(af, bf, a4, 0, 0, 0);
                }
#pragma unroll
                for (int ks = 0; ks < 4; ++ks) {
                    const bf16x8 af = *(const bf16x8*)(lds + H_SB + (16 * w + c16) * 272 + (32 * ks + 8 * g) * 2);
                    const bf16x8 bf = *(const bf16x8*)(lds + H_QT + (16 * tt + c16) * 272 + (32 * ks + 8 * g) * 2);
                    a4 = __builtin_amdgcn_mfma_f32_16x16x32_bf16(af, bf, a4, 0, 0, 0);
                }
                O[tt] = a4;
            }
        }
#pragma unroll
        for (int kt = 0; kt < 8; ++kt) {
#pragma unroll
            for (int ks = 0; ks < 2; ++ks) {
                const bf16x8 af = *(const bf16x8*)(lds + H_KT + (16 * kt + c16) * 144 + (32 * ks + 8 * g) * 2);
                const bf16x8 bf = *(const bf16x8*)(lds + H_VT + (16 * w + c16) * 144 + (32 * ks + 8 * g) * 2);
                S[kt] = __builtin_amdgcn_mfma_f32_16x16x32_bf16(af, bf, S[kt], 0, 0, 0);
            }
            const f32x4 e = *(const f32x4*)(ebl + 16 * kt + 4 * g);
            S[kt] = S[kt] * e;
        }
        if (OUT) {
#pragma unroll
            for (int tt = 0; tt < 4; ++tt) {
                float s = O[tt][0] * O[tt][0] + O[tt][1] * O[tt][1] + O[tt][2] * O[tt][2] + O[tt][3] * O[tt][3];
                s += __shfl_xor(s, 16); s += __shfl_xor(s, 32);
                if (g == 0) ssb[w * 64 + 16 * tt + c16] = s;
            }
            __syncthreads();
#pragma unroll
            for (int tt = 0; tt < 4; ++tt) {
                const int t = 16 * tt + c16; float tot = 0.f;
#pragma unroll
                for (int ww = 0; ww < 8; ++ww) tot += ssb[ww * 64 + t];
                const float rs = rsqrtf(tot * (1.0f / 128.0f) + RMS_EPS);
                const size_t gi = (tc + t) * 1024 + ch0 + 16 * w + 4 * g;
                const u32x2 gz = gzv[tt];
                const float o0 = bf2f(f2bf(O[tt][0] * rs * gn[0])) * bflo(gz[0]), o1 = bf2f(f2bf(O[tt][1] * rs * gn[1])) * bfhi(gz[0]);
                const float o2 = bf2f(f2bf(O[tt][2] * rs * gn[2])) * bflo(gz[1]), o3 = bf2f(f2bf(O[tt][3] * rs * gn[3])) * bfhi(gz[1]);
                *(u32x2*)(og + gi) = (u32x2){cvt_pk_bf16(o0, o1), cvt_pk_bf16(o2, o3)};
            }
        }
        if (!OUT && c == 3 && jj == 3) {
            float* Dg = (float*)(p.ws + OFF_D) + (size_t)chain * 128;
#pragma unroll
            for (int kt = 0; kt < 8; ++kt)
                *(u32x2*)(Lg + (16 * w + c16) * 128 + 16 * kt + 4 * g) = (u32x2){cvt_pk_bf16(S[kt][0], S[kt][1]), cvt_pk_bf16(S[kt][2], S[kt][3])};
            if (w == 0) *(f32x2*)(Dg + 2 * kp) = (f32x2){__expf(btot0), __expf(btot1)};
        }
        if (step + 1 < nstep) part1(step + 1);
    }
    __syncthreads();
}

__device__ void phase_scan(const Params& p) {
    unsigned short* L = (unsigned short*)(p.ws + OFF_L); const float* D = (const float*)(p.ws + OFF_D);
    for (int i = blockIdx.x * NTHREADS + threadIdx.x; i < 32 * 4096; i += gridDim.x * NTHREADS) {
        const int bh = i >> 12, e4 = i & 4095, k0 = (e4 & 31) * 4;
        f32x4 carry = (f32x4){0.f, 0.f, 0.f, 0.f};
        u32x2 v[8]; f32x4 d[8];
#pragma unroll
        for (int s = 0; s < 8; ++s) { const int chain = bh * 8 + s; v[s] = *(const u32x2*)(L + (size_t)chain * 16384 + e4 * 4); d[s] = *(const f32x4*)(D + chain * 128 + k0); }
#pragma unroll
        for (int s = 0; s < 8; ++s) { const int chain = bh * 8 + s;
            *(u32x2*)(L + (size_t)chain * 16384 + e4 * 4) = (u32x2){cvt_pk_bf16(carry[0], carry[1]), cvt_pk_bf16(carry[2], carry[3])};
            const f32x4 lv = (f32x4){bflo(v[s][0]), bfhi(v[s][0]), bflo(v[s][1]), bfhi(v[s][1])};
            carry = carry * d[s] + lv; }
    }
}

__device__ void phase_ln(float* buf, const float* gam, const float* bet, unsigned short* copyb) {
    const int lane = threadIdx.x & 63, wv = blockIdx.x * 8 + (threadIdx.x >> 6), nw = gridDim.x * 8;
    f32x4 gv[4], bv[4];
#pragma unroll
    for (int i = 0; i < 4; ++i) { gv[i] = *(const f32x4*)(gam + i * 256 + lane * 4); bv[i] = *(const f32x4*)(bet + i * 256 + lane * 4); }
    for (int r = wv; r < T_TOK; r += nw) {
        float* rp = buf + (size_t)r * 1024;
        f32x4 v[4]; float s = 0.f;
#pragma unroll
        for (int i = 0; i < 4; ++i) { v[i] = *(const f32x4*)(rp + i * 256 + lane * 4); s += v[i][0] + v[i][1] + v[i][2] + v[i][3]; }
        const float mean = wave_sum(s) * (1.0f / 1024.0f);
        float ss = 0.f;
#pragma unroll
        for (int i = 0; i < 4; ++i) { v[i] = v[i] - mean; ss += v[i][0] * v[i][0] + v[i][1] * v[i][1] + v[i][2] * v[i][2] + v[i][3] * v[i][3]; }
        const float rstd = rsqrtf(wave_sum(ss) * (1.0f / 1024.0f) + LN_EPS);
#pragma unroll
        for (int i = 0; i < 4; ++i) { const f32x4 y = v[i] * rstd * gv[i] + bv[i];
            if (copyb) *(u32x2*)(copyb + (size_t)r * 1024 + i * 256 + lane * 4) = (u32x2){cvt_pk_bf16(y[0], y[1]), cvt_pk_bf16(y[2], y[3])};
            else *(f32x4*)(rp + i * 256 + lane * 4) = y; }
    }
}

__device__ __forceinline__ float gelu_tanh(float x) {
    const float y = 0.7978845608028654f * (x + 0.044715f * x * x * x);
    const float t = 1.0f - 2.0f * __builtin_amdgcn_rcpf(1.0f + __expf(2.0f * y));
    return 0.5f * x * (1.0f + t);
}
__device__ void phase_act(const Params& p) {
    unsigned short* z = (unsigned short*)(p.ws + OFF_Z);
    constexpr int NCG = DFF / 8, RUN = 16, NRUN = T_TOK / RUN;
    for (int i = blockIdx.x * NTHREADS + threadIdx.x; i < NCG * NRUN; i += gridDim.x * NTHREADS) {
        const int cgi = i % NCG, run = i / NCG; const int c = cgi * 8; const size_t t0 = (size_t)run * RUN;
        float w0[8], w1[8], w2[8], bb[8];
#pragma unroll
        for (int j = 0; j < 8; ++j) { w0[j] = p.w_ffn_dw[c + j]; w1[j] = p.w_ffn_dw[DFF + c + j]; w2[j] = p.w_ffn_dw[2 * DFF + c + j]; bb[j] = p.b_ffn_dw[c + j]; }
        float um2[8], um1[8];
        if ((t0 % SEQ) == 0) {
#pragma unroll
            for (int j = 0; j < 8; ++j) { um2[j] = 0.f; um1[j] = 0.f; }
        } else {
            const u32x4 a = *(const u32x4*)(z + (t0 - 2) * (2 * DFF) + c), b = *(const u32x4*)(z + (t0 - 1) * (2 * DFF) + c);
#pragma unroll
            for (int j = 0; j < 4; ++j) { um2[2 * j] = bflo(a[j]); um2[2 * j + 1] = bfhi(a[j]); um1[2 * j] = bflo(b[j]); um1[2 * j + 1] = bfhi(b[j]); }
        }
#pragma unroll 4
        for (int tt = 0; tt < RUN; ++tt) {
            unsigned short* rowp = z + (t0 + tt) * (2 * DFF);
            const u32x4 a = *(const u32x4*)(rowp + c), gq = *(const u32x4*)(rowp + DFF + c);
            float u[8], gvv[8], o[8];
#pragma unroll
            for (int j = 0; j < 4; ++j) { u[2 * j] = bflo(a[j]); u[2 * j + 1] = bfhi(a[j]); gvv[2 * j] = bflo(gq[j]); gvv[2 * j + 1] = bfhi(gq[j]); }
#pragma unroll
            for (int j = 0; j < 8; ++j) { const float cv = w0[j] * um2[j] + w1[j] * um1[j] + w2[j] * u[j] + bb[j]; o[j] = gelu_tanh(cv) * gvv[j]; um2[j] = um1[j]; um1[j] = u[j]; }
            *(u32x4*)(rowp + DFF + c) = (u32x4){cvt_pk_bf16(o[0], o[1]), cvt_pk_bf16(o[2], o[3]), cvt_pk_bf16(o[4], o[5]), cvt_pk_bf16(o[6], o[7])};
        }
    }
}


#define XB_TMO      128
#define XB_XCNT(j)  (256  + 64 * (j))
#define XB_XSUB(j)  (1280 + 64 * (j))
#define XB_XGEN(j)  (2304 + 64 * (j))
#define XB_TOP      3328
#define XB_TOPGEN   3392
#define XCD_BAR_WORDS 3456
#define XB_SPIN_CAP (1u << 22)
__device__ __forceinline__ unsigned xb_ld(unsigned* p)              { return __hip_atomic_load(p, __ATOMIC_RELAXED, __HIP_MEMORY_SCOPE_AGENT); }
__device__ __forceinline__ unsigned xb_add(unsigned* p, unsigned v) { return __hip_atomic_fetch_add(p, v, __ATOMIC_RELAXED, __HIP_MEMORY_SCOPE_AGENT); }
__device__ __forceinline__ unsigned xb_xcc_id() { return (unsigned)__builtin_amdgcn_s_getreg((3 << 11) | 20) & 0xFu; }
#define XB_SPIN(cond, bar) do { unsigned _sp = 0; while (cond) { __builtin_amdgcn_s_sleep(1); \
    if ((++_sp & 255u) == 0u) { if (xb_ld(&(bar)[XB_TMO])) break; if (_sp > XB_SPIN_CAP) { atomicAdd(&(bar)[XB_TMO], 1u); break; } } } } while (0)
struct XcdBarrier { unsigned* bar; unsigned x; volatile LAS unsigned* st; };
__device__ __forceinline__ XcdBarrier xcd_barrier_post(unsigned* bar, volatile LAS unsigned* st) {
    XcdBarrier b; b.bar = bar; b.x = xb_xcc_id(); b.st = st;
    if (threadIdx.x == 0) (void)xb_add(&bar[XB_XCNT(b.x)], 1u);
    return b;
}
__device__ __forceinline__ void xcd_barrier_complete(unsigned* bar, unsigned x, unsigned& nloc, unsigned& nx) {
    const unsigned G = gridDim.x * gridDim.y * gridDim.z;
    unsigned sum, cnt, mine, sp = 0u;
    for (;;) {
        sum = 0u; cnt = 0u; mine = 0u;
#pragma unroll
        for (unsigned j = 0; j < 16; ++j) { const unsigned c = xb_ld(&bar[XB_XCNT(j)]); sum += c; cnt += (c > 0u) ? 1u : 0u; mine = (j == x) ? c : mine; }
        if (sum == G) break;
        __builtin_amdgcn_s_sleep(1);
        if ((++sp & 255u) == 0u) { if (xb_ld(&bar[XB_TMO])) break; if (sp > XB_SPIN_CAP) { atomicAdd(&bar[XB_TMO], 1u); break; } }
    }
    nloc = mine > 0u ? mine : 1u; nx = cnt > 0u ? cnt : 1u;
}
__device__ __forceinline__ void xcd_barrier(const XcdBarrier& b) {
    asm volatile("s_waitcnt vmcnt(0)" ::: "memory");
    __syncthreads();
    if (threadIdx.x == 0) {
        unsigned* bar = b.bar;
        __builtin_amdgcn_s_waitcnt(0);
        unsigned nloc = b.st[0], nx = b.st[1];
        if (nloc == 0u) { xcd_barrier_complete(bar, b.x, nloc, nx); b.st[0] = nloc; b.st[1] = nx; }
        const unsigned old = xb_add(&bar[XB_XSUB(b.x)], 1u);
        const unsigned gen = old / nloc;
        if (old + 1u == (gen + 1u) * nloc) {
            __builtin_amdgcn_fence(__ATOMIC_RELEASE, "agent");
            asm volatile("s_waitcnt vmcnt(0)" ::: "memory");
            const unsigned og = xb_add(&bar[XB_TOP], 1u);
            const unsigned tg = og / nx;
            if (og + 1u == (tg + 1u) * nx) xb_add(&bar[XB_TOPGEN], 1u);
            else XB_SPIN(xb_ld(&bar[XB_TOPGEN]) == tg, bar);
            __builtin_amdgcn_fence(__ATOMIC_ACQUIRE, "agent");
            xb_add(&bar[XB_XGEN(b.x)], 1u);
            asm volatile("s_waitcnt vmcnt(0)" ::: "memory");
        } else {
            XB_SPIN(xb_ld(&bar[XB_XGEN(b.x)]) == gen, bar);
            __builtin_amdgcn_fence(__ATOMIC_ACQUIRE, "agent");
            asm volatile("s_waitcnt vmcnt(0)" ::: "memory");
        }
    }
    __syncthreads();
}

#ifndef PHASE_MASK
#define PHASE_MASK 0x1fff
#endif
#ifndef DUP_MASK
#define DUP_MASK 0
#endif
#define PHASE(n) if ((PHASE_MASK & (1 << (n))) && (ph_only < 0 || ph_only == (n))) for (int rep_ = 0; rep_ < 1 + ((DUP_MASK >> (n)) & 1); ++rep_)
#define SYNC() do { if (ph_only < 0) xcd_barrier(xb); } while (0)
__global__ void __launch_bounds__(NTHREADS, 2) fwd_megakernel(Params p, int ph_only) {
    extern __shared__ __attribute__((aligned(16))) unsigned char shm[];
    cg::grid_group grid = cg::this_grid();
    LAS unsigned char* lds3 = (LAS unsigned char*)shm;
    volatile LAS unsigned* xst = (volatile LAS unsigned*)(lds3 + LDS_BYTES - 16);
    if (threadIdx.x == 0) { xst[0] = 0u; xst[1] = 0u; }
    __syncthreads();
    const XcdBarrier xb = xcd_barrier_post((unsigned*)(p.ws + OFF_BAR), xst);
    PHASE(0) { phase_prep(p, shm); }
    if (ph_only == -12345) grid.sync();
    SYNC();
    PHASE(1) { pg8::StaticOrder<IN_COLS / 256> S; S.init(T_TOK, IN_COLS, gridDim.x, blockIdx.x);
               pg8::Gemm g{(const bf16_t*)(p.ws + OFF_XB), (const bf16_t*)(p.ws + OFF_WIN), T_TOK, IN_COLS, DM, DM, nullptr, 0, 0};
               EpiProj e{p.ws, (unsigned short*)p.out, (const float*)(p.ws + OFF_MISC)}; pg8::gemm_phase(lds3, g, S, e); }
    SYNC();
    PHASE(2) { phase_conv(p, shm);
               hgrn_phase<false>(p, shm); }
    SYNC();
    PHASE(4) { hgrn_phase<true>(p, shm); }
    SYNC();
    PHASE(5) { pg8::StaticOrder<DM / 256> S; S.init(T_TOK, DM, gridDim.x, blockIdx.x);
               pg8::Gemm g{(const bf16_t*)(p.ws + OFF_XB), (const bf16_t*)(p.ws + OFF_WCO), T_TOK, DM, CONV_DIM + HG, CONV_DIM, (const bf16_t*)(p.ws + OFF_CVG), HG, CONV_DIM / 64};
               EpiMix e{(const unsigned short*)p.out, (unsigned short*)(p.ws + OFF_V)}; pg8::gemm_phase<EpiMix, true>(lds3, g, S, e); }
    SYNC();
    PHASE(7) { pg8::StaticOrder<DM / 256> S; S.init(T_TOK, DM, gridDim.x, blockIdx.x);
               pg8::Gemm g{(const bf16_t*)(p.ws + OFF_V), (const bf16_t*)(p.ws + OFF_WOUT), T_TOK, DM, DM, DM, nullptr, 0, 0};
               EpiLn<0> e{p.x, p.ws + OFF_G, p.ln1_g, p.ln1_b, (float*)(p.ws + OFF_PART7), (unsigned*)(p.ws + OFF_CNT), lds3 + 131072}; pg8::gemm_phase(lds3, g, S, e); }
    SYNC();
    PHASE(9) { pg8::StaticOrder<2 * DFF / 256> S; S.init(T_TOK, 2 * DFF, gridDim.x, blockIdx.x);
               pg8::Gemm g{(const bf16_t*)(p.ws + OFF_G), (const bf16_t*)(p.ws + OFF_WFI), T_TOK, 2 * DFF, DM, DM, nullptr, 0, 0};
               EpiZ e{(unsigned short*)(p.ws + OFF_Z), 2 * DFF}; pg8::gemm_phase(lds3, g, S, e); }
    SYNC();
    PHASE(10) { phase_act(p); }
    SYNC();
    PHASE(11) { pg8::StaticOrder<DM / 256> S; S.init(T_TOK, DM, gridDim.x, blockIdx.x);
                pg8::Gemm g{(const bf16_t*)(p.ws + OFF_Z) + DFF, (const bf16_t*)(p.ws + OFF_WFO), T_TOK, DM, DFF, 2 * DFF, nullptr, 0, 0};
                EpiLn<1> e{p.ws + OFF_G, p.out, p.ln2_g, p.ln2_b, (float*)(p.ws + OFF_PART11), (unsigned*)(p.ws + OFF_CNT) + 128 * 2 * 64, lds3 + 131072}; pg8::gemm_phase(lds3, g, S, e); }
}

extern "C" void kernel_launch(void* const* d_in, const int* in_sizes, int n_in, void* d_out, int out_size, void* d_ws, size_t ws_size, hipStream_t stream) {
    static int grid_blocks = 0;
    if (!grid_blocks) {
        int dev = 0, cus = 0, per_cu = 0;
        hipGetDevice(&dev);
        hipDeviceGetAttribute(&cus, hipDeviceAttributeMultiprocessorCount, dev);
        hipFuncSetAttribute((const void*)fwd_megakernel, hipFuncAttributeMaxDynamicSharedMemorySize, LDS_BYTES);
        hipOccupancyMaxActiveBlocksPerMultiprocessor(&per_cu, (const void*)fwd_megakernel, NTHREADS, LDS_BYTES);
        if (per_cu < 1) per_cu = 1;
        if (per_cu > 1) per_cu = 1;
        grid_blocks = cus * per_cu;
        if (ws_size < WS_NEED) fprintf(stderr, "kernel_launch: workspace too small: %zu < %zu\n", ws_size, (size_t)WS_NEED);
    }
    hipMemsetAsync((unsigned char*)d_ws + OFF_BAR, 0, ZERO_BYTES, stream);
    Params p{};
    p.x = (const float*)d_in[0]; p.w_in = (const float*)d_in[1]; p.w_conv_dw = (const float*)d_in[2]; p.b_conv_dw = (const float*)d_in[3];
    p.conv_ln_g = (const float*)d_in[4]; p.conv_ln_b = (const float*)d_in[5]; p.w_conv_out = (const float*)d_in[6]; p.lb_logits = (const float*)d_in[7];
    p.hgrn_norm_g = (const float*)d_in[8]; p.w_hgrn_out = (const float*)d_in[9]; p.w_out = (const float*)d_in[10]; p.ln1_g = (const float*)d_in[11];
    p.ln1_b = (const float*)d_in[12]; p.w_ffn_in = (const float*)d_in[13]; p.w_ffn_dw = (const float*)d_in[14]; p.b_ffn_dw = (const float*)d_in[15];
    p.w_ffn_out = (const float*)d_in[16]; p.ln2_g = (const float*)d_in[17]; p.ln2_b = (const float*)d_in[18];
    p.out = (float*)d_out; p.ws = (unsigned char*)d_ws;
#if defined(MULTI_LAUNCH)
    for (int ph = 0; ph < 13; ++ph) hipLaunchKernelGGL(fwd_megakernel, dim3(grid_blocks), dim3(NTHREADS), LDS_BYTES, stream, p, ph);
#else
    int ph_only = -1;
    void* args[] = {&p, &ph_only};
    hipError_t e = hipLaunchCooperativeKernel((const void*)fwd_megakernel, dim3(grid_blocks), dim3(NTHREADS), args, LDS_BYTES, stream);
    if (e != hipSuccess) fprintf(stderr, "cooperative launch failed: %s (grid %d)\n", hipGetErrorString(e), grid_blocks);
#endif
}
```

```cpp
#include <hip/hip_runtime.h>
#include <hip/hip_cooperative_groups.h>
#include <cstdio>
namespace cg = cooperative_groups;

#define LAS __attribute__((address_space(3)))
typedef unsigned short bf16_t;
typedef short bf16x8 __attribute__((ext_vector_type(8)));
typedef float f32x4 __attribute__((ext_vector_type(4)));
typedef float f32x2 __attribute__((ext_vector_type(2)));
typedef unsigned u32x4 __attribute__((ext_vector_type(4)));
typedef unsigned u32x2 __attribute__((ext_vector_type(2)));

constexpr int T_TOK = 32768, SEQ = 8192, DM = 1024, IN_COLS = 7168, CONV_DIM = 512, CONV_K = 31, HG = 1024, DFF = 2816;
constexpr float ALPHA = 1.189207115002721f;
constexpr float LN_EPS = 1e-5f, RMS_EPS = 1e-6f;
constexpr int NTHREADS = 512;
constexpr int LDS_BYTES = 140 * 1024;

constexpr size_t MiB = 1024ull * 1024ull;
constexpr size_t OFF_W    = 0;
constexpr size_t OFF_WIN  = OFF_W;
constexpr size_t OFF_WCO  = OFF_WIN + (size_t)IN_COLS * DM * 2;
constexpr size_t OFF_WHO  = OFF_WCO + (size_t)DM * CONV_DIM * 2;
constexpr size_t OFF_WOUT = OFF_WHO + (size_t)DM * HG * 2;
constexpr size_t OFF_WFI  = OFF_WOUT + (size_t)DM * DM * 2;
constexpr size_t OFF_WFO  = OFF_WFI + (size_t)2 * DFF * DM * 2;
constexpr size_t OFF_G    = 36 * MiB;
constexpr size_t OFF_Q    = 100 * MiB;
constexpr size_t OFF_KIN  = 164 * MiB;
constexpr size_t OFF_V    = 228 * MiB;
constexpr size_t OFF_XB   = 292 * MiB;
constexpr size_t OFF_CVG  = 356 * MiB;
constexpr size_t OFF_L    = 420 * MiB;
constexpr size_t OFF_D    = 484 * MiB;
constexpr size_t OFF_MISC = 485 * MiB;
constexpr size_t OFF_Z    = OFF_Q;
constexpr size_t OFF_PART7  = 486 * MiB;
constexpr size_t OFF_PART11 = 487 * MiB;
constexpr size_t OFF_BAR  = 489 * MiB;
constexpr size_t OFF_CNT  = OFF_BAR + 64 * 1024;
constexpr size_t ZERO_BYTES = 64 * 1024 + 2 * 128 * 2 * 256;
constexpr size_t WS_NEED  = 490 * MiB;

struct Params {
    const float* x; const float* w_in; const float* w_conv_dw; const float* b_conv_dw; const float* conv_ln_g; const float* conv_ln_b;
    const float* w_conv_out; const float* lb_logits; const float* hgrn_norm_g; const float* w_hgrn_out; const float* w_out;
    const float* ln1_g; const float* ln1_b; const float* w_ffn_in; const float* w_ffn_dw; const float* b_ffn_dw; const float* w_ffn_out;
    const float* ln2_g; const float* ln2_b;
    float* out; unsigned char* ws;
};

__device__ __forceinline__ unsigned cvt_pk_bf16(float lo, float hi) { unsigned r; asm("v_cvt_pk_bf16_f32 %0, %1, %2" : "=v"(r) : "v"(lo), "v"(hi)); return r; }
__device__ __forceinline__ float bf2f(unsigned short b) { return __uint_as_float(((unsigned)b) << 16); }
__device__ __forceinline__ float bflo(unsigned u) { return __uint_as_float(u << 16); }
__device__ __forceinline__ float bfhi(unsigned u) { return __uint_as_float(u & 0xffff0000u); }
__device__ __forceinline__ unsigned short f2bf(float f) { return (unsigned short)(cvt_pk_bf16(f, 0.f) & 0xffffu); }
__device__ __forceinline__ float sigmoidf_(float x) { return __builtin_amdgcn_rcpf(1.0f + __expf(-x)); }
__device__ __forceinline__ unsigned pk_f16(float lo, float hi) {
    _Float16 a = (_Float16)lo, b = (_Float16)hi; unsigned short ua, ub; __builtin_memcpy(&ua, &a, 2); __builtin_memcpy(&ub, &b, 2); return (unsigned)ua | ((unsigned)ub << 16); }
__device__ __forceinline__ float wave_sum(float v) {
#pragma unroll
    for (int o = 32; o >= 1; o >>= 1) v += __shfl_xor(v, o);
    return v; }

namespace pg8 {
constexpr int BM = 256, BK = 64, HALF = 128, HTB = HALF * BK * 2, STAGE_BYTES = 8 * HTB, NXCD = 8, WGM = 4;
__host__ __device__ __forceinline__ int lds_byte(int r, int c) { const int st = (r >> 4) * 2 + (c >> 5), rr = r & 15, cc = c & 31, ob = rr * 64 + cc * 2; return st * 1024 + (ob ^ (((ob >> 9) & 1) << 5)); }
__host__ __device__ __forceinline__ void stage_rc(int b, int& R, int& C) { const int st = b / 1024, sb = b % 1024, swz = sb ^ (((sb >> 9) & 1) << 5); R = (st >> 1) * 16 + swz / 64; C = (st & 1) * 32 + (swz % 64) / 2; }
__host__ __device__ __forceinline__ int perm32(int rho) { const int n = rho >> 4, i = rho & 15; return 8 * (i >> 2) + 4 * n + (i & 3); }
struct Unit { int pm, pn; };
struct Gemm { const bf16_t* A; const bf16_t* Bt; int M, N, K, lda; const bf16_t* A2; int lda2; int ksplit; };
template <int NN  > struct StaticOrder {
    static constexpr int nM = T_TOK / BM, nN = NN, nwg = nM * nN, nig = WGM * nN, q = nwg / NXCD;
    static_assert(nwg % NXCD == 0 && nM % WGM == 0, "unit order");
    int G, c, reps, rounds;
    __device__ void init(int, int, int G_, int c_, int reps_ = 1) { G = G_; c = c_; reps = reps_; rounds = (nwg + G - 1) / G; }
    __device__ bool next(int i, Unit& u) const {
        if (i >= rounds * reps) return false;
        const int ir = (reps == 1) ? i : (i % rounds);
        const long L = (long)ir * G + c; if (L >= nwg) return false;
        const int l = (int)L, wgid = (l % NXCD) * q + l / NXCD;
        const int gid = wgid / nig, idx = wgid % nig;
        u.pm = gid * WGM + (idx % WGM); u.pn = idx / WGM; return true;
    }
};

template <class Epi, bool DUAL = false, class Sched>
__device__ __forceinline__ void gemm_phase(LAS unsigned char* lds, const Gemm g, const Sched& S, Epi& E) {
    const int tid = threadIdx.x, wid = __builtin_amdgcn_readfirstlane(tid >> 6), lane = tid & 63, wr = wid >> 2, wc = wid & 3, fr = lane & 15, fq = lane >> 4;
    const int K = g.K, nt = K / BK, lda = g.lda, lda2 = g.lda2, ksplit = g.ksplit;
    unsigned voffA[2], voffA2[2], voffB[2];
#pragma unroll
    for (int i = 0; i < 2; ++i) { int R, C; stage_rc(tid * 16 + i * 8192, R, C); const int Rb = Epi::PERM ? ((R & ~31) + perm32(R & 31)) : R;
        voffA[i] = (unsigned)(R * lda + C) * 2u; voffA2[i] = DUAL ? (unsigned)(R * lda2 + C) * 2u : 0u; voffB[i] = (unsigned)(Rb * K + C) * 2u; }
    const size_t kstep = (size_t)(BK * 2);
    const size_t hstepA = (size_t)HALF * lda * 2, hstepA2 = (size_t)HALF * lda2 * 2, hstepB = (size_t)HALF * K * 2;
    const unsigned ldsw = (unsigned)wid * 1024u;
    const int aoff = lds_byte(wr * 64 + fr, fq * 8), boff = lds_byte(wc * 32 + fr, fq * 8);
#define PG8_SA(b, h) (((b) * 2 + (h)) * HTB)
#define PG8_SB(b, h) ((4 + (b) * 2 + (h)) * HTB)
    auto stA = [&](int bufoff, int pm, int kt, int half) {
        const char* base; unsigned v0, v1;
        if (DUAL && kt >= ksplit) { base = (const char*)g.A2 + (size_t)(2 * pm + half) * hstepA2 + (size_t)(kt - ksplit) * kstep; v0 = voffA2[0]; v1 = voffA2[1]; }
        else                      { base = (const char*)g.A  + (size_t)(2 * pm + half) * hstepA  + (size_t)kt * kstep;            v0 = voffA[0];  v1 = voffA[1]; }
        __builtin_amdgcn_global_load_lds((const unsigned*)(base + v0), (LAS unsigned*)(lds + bufoff + ldsw), 16, 0, 0);
        __builtin_amdgcn_global_load_lds((const unsigned*)(base + v1), (LAS unsigned*)(lds + bufoff + ldsw + 8192), 16, 0, 0);
    };
    auto stB = [&](int bufoff, int pn, int kt, int half) {
        const char* base = (const char*)g.Bt + (size_t)(2 * pn + half) * hstepB + (size_t)kt * kstep;
        __builtin_amdgcn_global_load_lds((const unsigned*)(base + voffB[0]), (LAS unsigned*)(lds + bufoff + ldsw), 16, 0, 0);
        __builtin_amdgcn_global_load_lds((const unsigned*)(base + voffB[1]), (LAS unsigned*)(lds + bufoff + ldsw + 8192), 16, 0, 0);
    };
#define PG8_LDA(dst, b, h) do { _Pragma("unroll") for (int m = 0; m < 4; ++m) _Pragma("unroll") for (int k = 0; k < 2; ++k) dst[m][k] = *(const LAS bf16x8*)(lds + PG8_SA(b, h) + aoff + m * 2048 + k * 1024); } while (0)
#define PG8_LDB(dst, b, h) do { _Pragma("unroll") for (int n = 0; n < 2; ++n) _Pragma("unroll") for (int k = 0; k < 2; ++k) dst[n][k] = *(const LAS bf16x8*)(lds + PG8_SB(b, h) + boff + n * 2048 + k * 1024); } while (0)
#define PG8_MMA(ai, bj, At, Bt) do { __builtin_amdgcn_s_setprio(1); _Pragma("unroll") for (int m = 0; m < 4; ++m) _Pragma("unroll") for (int n = 0; n < 2; ++n) _Pragma("unroll") for (int k = 0; k < 2; ++k) \
        acc[ai][bj][m][n] = __builtin_amdgcn_mfma_f32_16x16x32_bf16(Bt[n][k], At[m][k], acc[ai][bj][m][n], 0, 0, 0); __builtin_amdgcn_s_setprio(0); } while (0)
#define PG8_WAIT_V(n) asm volatile("s_waitcnt vmcnt(" #n ")" ::: "memory")
#define PG8_WAIT_L(n) asm volatile("s_waitcnt lgkmcnt(" #n ")" ::: "memory")
#define PG8_BAR __builtin_amdgcn_s_barrier()
#define PG8_SCHED __builtin_amdgcn_sched_barrier(0)
    Unit cur, nxt; int ui = 0;
    if (!S.next(0, cur)) return;
    f32x4 acc[2][2][4][2];
#pragma unroll
    for (int a = 0; a < 2; ++a)
#pragma unroll
        for (int b = 0; b < 2; ++b)
#pragma unroll
            for (int m = 0; m < 4; ++m)
#pragma unroll
                for (int n = 0; n < 2; ++n) acc[a][b][m][n] = (f32x4){0.f, 0.f, 0.f, 0.f};
    bf16x8 At[4][2], B0[2][2], B1[2][2];
    stB(PG8_SB(0, 0), cur.pn, 0, 0); stA(PG8_SA(0, 0), cur.pm, 0, 0); stB(PG8_SB(0, 1), cur.pn, 0, 1); stA(PG8_SA(0, 1), cur.pm, 0, 1);
    if (wr == 1) PG8_BAR;
    PG8_WAIT_V(4); PG8_BAR;
    stB(PG8_SB(1, 0), cur.pn, 1, 0); stA(PG8_SA(1, 0), cur.pm, 1, 0); stB(PG8_SB(1, 1), cur.pn, 1, 1);
    PG8_WAIT_V(6); PG8_BAR;
    for (;;) {
        const bool has_next = S.next(ui + 1, nxt);
        const int npm = has_next ? nxt.pm : cur.pm, npn = has_next ? nxt.pn : cur.pn;
        for (int t = 0; t < nt; t += 2) {
            const bool last = (t == nt - 2);
            const int pm2 = last ? npm : cur.pm, pn2 = last ? npn : cur.pn, k2 = last ? 0 : t + 2, k3 = k2 + 1;
            if constexpr (DUAL) { if (t == ksplit) E.mid(acc, cur, wr, wc, fr, fq); }
            PG8_LDB(B0, 0, 0); PG8_SCHED; PG8_LDA(At, 0, 0); stA(PG8_SA(1, 1), cur.pm, t + 1, 1);
            PG8_WAIT_L(8); PG8_BAR; PG8_WAIT_L(0); PG8_MMA(0, 0, At, B0); PG8_BAR; PG8_SCHED;
            PG8_LDB(B1, 0, 1); stB(PG8_SB(0, 0), pn2, k2, 0);
            PG8_BAR; PG8_WAIT_L(0); PG8_MMA(0, 1, At, B1); PG8_BAR;
            PG8_LDA(At, 0, 1); stA(PG8_SA(0, 0), pm2, k2, 0);
            PG8_BAR; PG8_WAIT_L(0); PG8_MMA(1, 0, At, B0); PG8_BAR; PG8_SCHED;
            stB(PG8_SB(0, 1), pn2, k2, 1);
            PG8_WAIT_V(6); PG8_BAR; PG8_MMA(1, 1, At, B1); PG8_BAR;
            PG8_LDB(B0, 1, 0); PG8_SCHED; PG8_LDA(At, 1, 0); stA(PG8_SA(0, 1), pm2, k2, 1);
            PG8_WAIT_L(8); PG8_BAR; PG8_WAIT_L(0); PG8_MMA(0, 0, At, B0); PG8_BAR; PG8_SCHED;
            PG8_LDB(B1, 1, 1); stB(PG8_SB(1, 0), pn2, k3, 0);
            PG8_BAR; PG8_WAIT_L(0); PG8_MMA(0, 1, At, B1); PG8_BAR;
            PG8_LDA(At, 1, 1); stA(PG8_SA(1, 0), pm2, k3, 0);
            PG8_BAR; PG8_WAIT_L(0); PG8_MMA(1, 0, At, B0); PG8_BAR; PG8_SCHED;
            stB(PG8_SB(1, 1), pn2, k3, 1);
            PG8_WAIT_V(6); PG8_BAR; PG8_MMA(1, 1, At, B1); PG8_BAR;
        }
        E(acc, cur, wr, wc, fr, fq);
        if (!has_next) break;
#pragma unroll
        for (int a = 0; a < 2; ++a)
#pragma unroll
            for (int b = 0; b < 2; ++b)
#pragma unroll
                for (int m = 0; m < 4; ++m)
#pragma unroll
                    for (int n = 0; n < 2; ++n) acc[a][b][m][n] = (f32x4){0.f, 0.f, 0.f, 0.f};
        cur = nxt; ++ui;
    }
    PG8_WAIT_V(0);
    if (wr == 0) PG8_BAR;
    PG8_BAR;
#undef PG8_SA
#undef PG8_SB
#undef PG8_LDA
#undef PG8_LDB
#undef PG8_MMA
#undef PG8_WAIT_V
#undef PG8_WAIT_L
#undef PG8_BAR
#undef PG8_SCHED
}
}
using pg8::Unit;

struct EpiProj {
    static constexpr bool PERM = true;
    unsigned char* ws; unsigned short* mgate; const float* colscale;
    __device__ __forceinline__ void operator()(const f32x4 (&acc)[2][2][4][2], const Unit& u, int wr, int wc, int fr, int fq) const {
        const int pn = u.pn;
        if (pn < 4) {
            const int rowg = u.pm * 256 + wr * 64 + fr, chl = pn * 128 + wc * 32 + 8 * fq;
            unsigned short* glu = (unsigned short*)(ws + OFF_CVG);
#pragma unroll
            for (int ai = 0; ai < 2; ++ai)
#pragma unroll
                for (int m = 0; m < 4; ++m) {
                    float o[8];
#pragma unroll
                    for (int n = 0; n < 2; ++n)
#pragma unroll
                        for (int j = 0; j < 4; ++j) o[n * 4 + j] = acc[ai][0][m][n][j] * __builtin_amdgcn_rcpf(1.0f + __expf(-acc[ai][1][m][n][j]));
                    *(u32x4*)(glu + (size_t)(rowg + ai * 128 + m * 16) * 512 + chl) = (u32x4){cvt_pk_bf16(o[0], o[1]), cvt_pk_bf16(o[2], o[3]), cvt_pk_bf16(o[4], o[5]), cvt_pk_bf16(o[6], o[7])};
                }
            return;
        }
        if (pn >= 20) {
            const int rowg = u.pm * 256 + wr * 64 + fr, chl = (pn - 20) * 128 + wc * 32 + 8 * fq;
#pragma unroll
            for (int ai = 0; ai < 2; ++ai)
#pragma unroll
                for (int m = 0; m < 4; ++m) {
                    float ra[8], g1[8];
#pragma unroll
                    for (int n = 0; n < 2; ++n)
#pragma unroll
                        for (int j = 0; j < 4; ++j) { const float d0 = 1.0f + __expf(-acc[ai][0][m][n][j]), d1 = 1.0f + __expf(-acc[ai][1][m][n][j]);
                            g1[n * 4 + j] = __builtin_amdgcn_rcpf(d1); ra[n * 4 + j] = d1 * __builtin_amdgcn_rcpf(d0); }
                    unsigned short* rowp = mgate + (size_t)(rowg + ai * 128 + m * 16) * 2048 + chl;
                    *(u32x4*)rowp = (u32x4){cvt_pk_bf16(ra[0], ra[1]), cvt_pk_bf16(ra[2], ra[3]), cvt_pk_bf16(ra[4], ra[5]), cvt_pk_bf16(ra[6], ra[7])};
                    *(u32x4*)(rowp + 1024) = (u32x4){cvt_pk_bf16(g1[0], g1[1]), cvt_pk_bf16(g1[2], g1[3]), cvt_pk_bf16(g1[4], g1[5]), cvt_pk_bf16(g1[6], g1[7])};
                }
            return;
        }
        unsigned short* base; int ld, colt; float c0, c1, c2, sgn; bool f16 = false;
        if (pn < 4)       { base = (unsigned short*)(ws + OFF_CVG); ld = 1024; colt = pn * 256; if (pn < 2) { c0 = 1.f; c1 = 0.f; c2 = 0.f; } else { c0 = 0.f; c1 = 1.f; c2 = 0.f; } sgn = 1.f; }
        else if (pn < 8)  { base = (unsigned short*)(ws + OFF_Q);   ld = 1024; colt = (pn - 4) * 256;  c0 = 0.f; c1 = 0.f; c2 = 1.f; sgn = 1.f; }
        else if (pn < 12) { base = (unsigned short*)(ws + OFF_KIN); ld = 1024; colt = (pn - 8) * 256;  c0 = 0.f; c1 = 1.f; c2 = 0.f; sgn = -1.f; f16 = true; }
        else if (pn < 16) { base = (unsigned short*)(ws + OFF_V);   ld = 1024; colt = (pn - 12) * 256; c0 = 1.f; c1 = 0.f; c2 = 0.f; sgn = 1.f; }
        else if (pn < 20) { base = (unsigned short*)(ws + OFF_G);   ld = 1024; colt = (pn - 16) * 256; c0 = 0.f; c1 = 0.f; c2 = 1.f; sgn = 1.f; }
        else              { base = mgate;                           ld = 2048; colt = (pn - 20) * 256; c0 = 0.f; c1 = 1.f; c2 = 0.f; sgn = 1.f; }
        const int row0 = u.pm * 256 + wr * 64 + fr, coll = wc * 32 + 8 * fq;
        f32x4 cs[2][2];
#pragma unroll
        for (int bj = 0; bj < 2; ++bj)
#pragma unroll
            for (int n = 0; n < 2; ++n) cs[bj][n] = f16 ? *(const f32x4*)(colscale + pn * 256 + bj * 128 + coll + 4 * n) : (f32x4){1.f, 1.f, 1.f, 1.f};
#pragma unroll
        for (int ai = 0; ai < 2; ++ai)
#pragma unroll
            for (int m = 0; m < 4; ++m) {
                unsigned short* rowp = base + (size_t)(row0 + ai * 128 + m * 16) * ld + colt + coll;
#pragma unroll
                for (int bj = 0; bj < 2; ++bj) {
                    float o[8];
#pragma unroll
                    for (int n = 0; n < 2; ++n)
#pragma unroll
                        for (int j = 0; j < 4; ++j) { const float z = acc[ai][bj][m][n][j]; const float s = __builtin_amdgcn_rcpf(1.0f + __expf(-sgn * z)); o[n * 4 + j] = (c0 * z + s * (c1 + c2 * z)) * cs[bj][n][j]; }
                    const u32x4 pkh = (u32x4){pk_f16(o[0], o[1]), pk_f16(o[2], o[3]), pk_f16(o[4], o[5]), pk_f16(o[6], o[7])};
                    const u32x4 pkb = (u32x4){cvt_pk_bf16(o[0], o[1]), cvt_pk_bf16(o[2], o[3]), cvt_pk_bf16(o[4], o[5]), cvt_pk_bf16(o[6], o[7])};
                    u32x4 pk;
#pragma unroll
                    for (int q = 0; q < 4; ++q) pk[q] = f16 ? pkh[q] : pkb[q];
                    *(u32x4*)(rowp + bj * 128) = pk;
                }
            }
    }
};
struct EpiMix {
    static constexpr bool PERM = false;
    const unsigned short* mgate; unsigned short* mixed;
    __device__ __forceinline__ void mid(f32x4 (&acc)[2][2][4][2], const Unit& u, int wr, int wc, int fr, int fq) const {
        const int row0 = u.pm * 256 + wr * 64 + fr, col0 = u.pn * 256 + wc * 32 + 4 * fq;
#pragma unroll
        for (int ai = 0; ai < 2; ++ai)
#pragma unroll
            for (int m = 0; m < 4; ++m) { const size_t r = (size_t)(row0 + ai * 128 + m * 16);
#pragma unroll
                for (int bj = 0; bj < 2; ++bj)
#pragma unroll
                    for (int n = 0; n < 2; ++n) { const int c = col0 + bj * 128 + n * 16;
                        const u32x2 ga = *(const u32x2*)(mgate + r * 2048 + c);
                        acc[ai][bj][m][n][0] *= bflo(ga[0]); acc[ai][bj][m][n][1] *= bfhi(ga[0]);
                        acc[ai][bj][m][n][2] *= bflo(ga[1]); acc[ai][bj][m][n][3] *= bfhi(ga[1]); } }
    }
    __device__ __forceinline__ void operator()(const f32x4 (&acc)[2][2][4][2], const Unit& u, int wr, int wc, int fr, int fq) const {
        const int row0 = u.pm * 256 + wr * 64 + fr, col0 = u.pn * 256 + wc * 32 + 4 * fq;
#pragma unroll
        for (int ai = 0; ai < 2; ++ai)
#pragma unroll
            for (int m = 0; m < 4; ++m) { const size_t r = (size_t)(row0 + ai * 128 + m * 16);
#pragma unroll
                for (int bj = 0; bj < 2; ++bj)
#pragma unroll
                    for (int n = 0; n < 2; ++n) { const int c = col0 + bj * 128 + n * 16;
                        const u32x2 gb = *(const u32x2*)(mgate + r * 2048 + 1024 + c);
                        const f32x4 v = acc[ai][bj][m][n];
                        *(u32x2*)(mixed + r * 1024 + c) = (u32x2){cvt_pk_bf16(v[0] * bflo(gb[0]), v[1] * bfhi(gb[0])), cvt_pk_bf16(v[2] * bflo(gb[1]), v[3] * bfhi(gb[1]))}; } }
    }
};
struct EpiRes {
    static constexpr bool PERM = false;
    const float* res; float* dst;
    __device__ __forceinline__ void operator()(const f32x4 (&acc)[2][2][4][2], const Unit& u, int wr, int wc, int fr, int fq) const {
        const int row0 = u.pm * 256 + wr * 64 + fr, col0 = u.pn * 256 + wc * 32 + 4 * fq;
#pragma unroll
        for (int ai = 0; ai < 2; ++ai)
#pragma unroll
            for (int m = 0; m < 4; ++m) { const size_t r = (size_t)(row0 + ai * 128 + m * 16);
#pragma unroll
                for (int bj = 0; bj < 2; ++bj)
#pragma unroll
                    for (int n = 0; n < 2; ++n) { const int c = col0 + bj * 128 + n * 16;
                        const f32x4 t = *(const f32x4*)(res + r * 1024 + c);
                        *(f32x4*)(dst + r * 1024 + c) = t * ALPHA + acc[ai][bj][m][n]; } }
    }
};
struct EpiResB {
    static constexpr bool PERM = false;
    const unsigned short* res; float* dst;
    __device__ __forceinline__ void operator()(const f32x4 (&acc)[2][2][4][2], const Unit& u, int wr, int wc, int fr, int fq) const {
        const int row0 = u.pm * 256 + wr * 64 + fr, col0 = u.pn * 256 + wc * 32 + 4 * fq;
#pragma unroll
        for (int ai = 0; ai < 2; ++ai)
#pragma unroll
            for (int m = 0; m < 4; ++m) { const size_t r = (size_t)(row0 + ai * 128 + m * 16);
#pragma unroll
                for (int bj = 0; bj < 2; ++bj)
#pragma unroll
                    for (int n = 0; n < 2; ++n) { const int c = col0 + bj * 128 + n * 16;
                        const u32x2 t = *(const u32x2*)(res + r * 1024 + c);
                        const f32x4 tv = (f32x4){bflo(t[0]), bfhi(t[0]), bflo(t[1]), bfhi(t[1])};
                        *(f32x4*)(dst + r * 1024 + c) = tv * ALPHA + acc[ai][bj][m][n]; } }
    }
};
template <int MODE  > struct EpiLn {
    static constexpr bool PERM = false;
    const void* res; void* outp; const float* gam; const float* bet; float* part; unsigned* cnt; LAS unsigned char* ldsx;
    __device__ __forceinline__ void operator()(f32x4 (&acc)[2][2][4][2], const Unit& u, int wr, int wc, int fr, int fq) const {
        const int row0 = u.pm * 256 + wr * 64 + fr, col0 = u.pn * 256 + wc * 32 + 4 * fq;
        LAS float* red = (LAS float*)ldsx;
        LAS float* stats = (LAS float*)(ldsx + 8192);
#pragma unroll
        for (int ai = 0; ai < 2; ++ai)
#pragma unroll
            for (int m = 0; m < 4; ++m) { const size_t r = (size_t)(row0 + ai * 128 + m * 16);
                float s1 = 0.f, s2 = 0.f;
#pragma unroll
                for (int bj = 0; bj < 2; ++bj)
#pragma unroll
                    for (int n = 0; n < 2; ++n) { const int c = col0 + bj * 128 + n * 16;
                        f32x4 tv;
                        if (MODE == 0) tv = *(const f32x4*)((const float*)res + r * 1024 + c);
                        else { const u32x2 t = *(const u32x2*)((const unsigned short*)res + r * 1024 + c); tv = (f32x4){bflo(t[0]), bfhi(t[0]), bflo(t[1]), bfhi(t[1])}; }
                        const f32x4 v = tv * ALPHA + acc[ai][bj][m][n];
                        acc[ai][bj][m][n] = v;
                        s1 += v[0] + v[1] + v[2] + v[3]; s2 += v[0] * v[0] + v[1] * v[1] + v[2] * v[2] + v[3] * v[3]; }
                s1 += __shfl_xor(s1, 16); s1 += __shfl_xor(s1, 32); s2 += __shfl_xor(s2, 16); s2 += __shfl_xor(s2, 32);
                if (fq == 0) { const int rl = ai * 128 + wr * 64 + m * 16 + fr; red[(rl * 4 + wc) * 2] = s1; red[(rl * 4 + wc) * 2 + 1] = s2; } }
        __syncthreads();
        if (wc == 0) {
            const int lane = fq * 16 + fr;
            unsigned* cw = cnt + (size_t)(u.pm * 2 + wr) * 64;
            float* mypart = part + ((size_t)(u.pm * 4 + u.pn) * 256) * 2;
#pragma unroll
            for (int q = 0; q < 2; ++q) { const int i = lane + 64 * q, rl = (i >> 6) * 128 + wr * 64 + (i & 63);
                float t1 = 0.f, t2 = 0.f;
#pragma unroll
                for (int w4 = 0; w4 < 4; ++w4) { t1 += red[(rl * 4 + w4) * 2]; t2 += red[(rl * 4 + w4) * 2 + 1]; }
                const unsigned long long pv = (unsigned long long)__float_as_uint(t1) | ((unsigned long long)__float_as_uint(t2) << 32);
                __hip_atomic_store((unsigned long long*)(mypart + rl * 2), pv, __ATOMIC_RELAXED, __HIP_MEMORY_SCOPE_AGENT); }
            asm volatile("s_waitcnt vmcnt(0)" ::: "memory");
            if (lane == 0) (void)__hip_atomic_fetch_add(cw, 1u, __ATOMIC_RELAXED, __HIP_MEMORY_SCOPE_AGENT);
            { unsigned sp = 0;
              while ((unsigned)__builtin_amdgcn_readfirstlane(__hip_atomic_load(cw, __ATOMIC_RELAXED, __HIP_MEMORY_SCOPE_AGENT)) < 4u) { __builtin_amdgcn_s_sleep(1); if (++sp > (1u << 22)) break; } }
            asm volatile("" ::: "memory");
#pragma unroll
            for (int q = 0; q < 2; ++q) { const int i = lane + 64 * q, rl = (i >> 6) * 128 + wr * 64 + (i & 63);
                float t1 = 0.f, t2 = 0.f;
#pragma unroll
                for (int pn = 0; pn < 4; ++pn) { const unsigned long long pv = __hip_atomic_load((unsigned long long*)(part + ((size_t)(u.pm * 4 + pn) * 256 + rl) * 2), __ATOMIC_RELAXED, __HIP_MEMORY_SCOPE_AGENT);
                    t1 += __uint_as_float((unsigned)pv); t2 += __uint_as_float((unsigned)(pv >> 32)); }
                const float mean = t1 * (1.0f / 1024.0f); const float var = fmaxf(t2 * (1.0f / 1024.0f) - mean * mean, 0.f);
                stats[rl * 2] = mean; stats[rl * 2 + 1] = rsqrtf(var + LN_EPS); }
        }
        __syncthreads();
#pragma unroll
        for (int ai = 0; ai < 2; ++ai)
#pragma unroll
            for (int m = 0; m < 4; ++m) { const size_t r = (size_t)(row0 + ai * 128 + m * 16); const int rl = ai * 128 + wr * 64 + m * 16 + fr;
                const float mean = stats[rl * 2], rstd = stats[rl * 2 + 1];
#pragma unroll
                for (int bj = 0; bj < 2; ++bj)
#pragma unroll
                    for (int n = 0; n < 2; ++n) { const int c = col0 + bj * 128 + n * 16;
                        const f32x4 gv = *(const f32x4*)(gam + c), bv = *(const f32x4*)(bet + c);
                        const f32x4 y = (acc[ai][bj][m][n] - mean) * rstd * gv + bv;
                        if (MODE == 0) *(u32x2*)((unsigned short*)outp + r * 1024 + c) = (u32x2){cvt_pk_bf16(y[0], y[1]), cvt_pk_bf16(y[2], y[3])};
                        else *(f32x4*)((float*)outp + r * 1024 + c) = y; } }
    }
};
struct EpiZ {
    static constexpr bool PERM = true;
    unsigned short* z; int ld;
    __device__ __forceinline__ void operator()(const f32x4 (&acc)[2][2][4][2], const Unit& u, int wr, int wc, int fr, int fq) const {
        const int row0 = u.pm * 256 + wr * 64 + fr, col0 = u.pn * 256 + wc * 32 + 8 * fq;
#pragma unroll
        for (int ai = 0; ai < 2; ++ai)
#pragma unroll
            for (int m = 0; m < 4; ++m) { unsigned short* rowp = z + (size_t)(row0 + ai * 128 + m * 16) * ld + col0;
#pragma unroll
                for (int bj = 0; bj < 2; ++bj) { const f32x4 v0 = acc[ai][bj][m][0], v1 = acc[ai][bj][m][1];
                    *(u32x4*)(rowp + bj * 128) = (u32x4){cvt_pk_bf16(v0[0], v0[1]), cvt_pk_bf16(v0[2], v0[3]), cvt_pk_bf16(v1[0], v1[1]), cvt_pk_bf16(v1[2], v1[3])}; } }
    }
};

__device__ void transpose_convert(const float* __restrict__ src, unsigned short* __restrict__ dst, int K, int N, float* tile  , int ldd = 0, const bool pair_m = false) {
    if (ldd == 0) ldd = K;
    auto srcblk = [&](int tn) -> int {
        if (!pair_m) return tn;
        if (tn < 16) { const int tt = tn >> 2, r4 = tn & 3; return (r4 < 2) ? (tt * 2 + r4) : (8 + tt * 2 + (r4 - 2)); }
        if (tn < 80) return tn;
        const int q = tn - 80, tt = q >> 2, r4 = q & 3; return (r4 < 2) ? (80 + tt * 2 + r4) : (96 + tt * 2 + (r4 - 2)); };
    const int tid = threadIdx.x; const int nk = K / 64, nn = N / 64, ntile = nk * nn;
    const int r = tid >> 3, c = (tid & 7) * 8;
    f32x4 a, b;
    int t = blockIdx.x;
    if (t < ntile) { const int tk = t / nn, tn = t % nn; const float* p = src + (size_t)(tk * 64 + r) * N + srcblk(tn) * 64 + c; a = *(const f32x4*)p; b = *(const f32x4*)(p + 4); }
    for (; t < ntile; t += gridDim.x) {
        const int tk = t / nn, tn = t % nn;
        { float* q = tile + r * 65 + c; q[0] = a[0]; q[1] = a[1]; q[2] = a[2]; q[3] = a[3]; q[4] = b[0]; q[5] = b[1]; q[6] = b[2]; q[7] = b[3]; }
        __syncthreads();
        { const int t2 = t + gridDim.x;
          if (t2 < ntile) { const int tk2 = t2 / nn, tn2 = t2 % nn; const float* p = src + (size_t)(tk2 * 64 + r) * N + srcblk(tn2) * 64 + c; a = *(const f32x4*)p; b = *(const f32x4*)(p + 4); } }
        { const int n = tid >> 3, k0 = (tid & 7) * 8; float v[8];
#pragma unroll
          for (int j = 0; j < 8; ++j) v[j] = tile[(k0 + j) * 65 + n];
          *(u32x4*)(dst + (size_t)(tn * 64 + n) * ldd + tk * 64 + k0) = (u32x4){cvt_pk_bf16(v[0], v[1]), cvt_pk_bf16(v[2], v[3]), cvt_pk_bf16(v[4], v[5]), cvt_pk_bf16(v[6], v[7])}; }
        __syncthreads();
    }
}
__device__ void phase_prep(const Params& p, unsigned char* lds_generic) {
    float* tile = (float*)lds_generic;
    unsigned char* ws = p.ws;
    { const size_t n8 = (size_t)T_TOK * DM / 8; unsigned short* xb = (unsigned short*)(ws + OFF_XB);
      const size_t stride = (size_t)gridDim.x * NTHREADS;
      for (size_t i = (size_t)blockIdx.x * NTHREADS + threadIdx.x; i < n8; i += 4 * stride) {
          f32x4 a[4], b[4];
#pragma unroll
          for (int j = 0; j < 4; ++j) { const size_t ii = i + j * stride; if (ii < n8) { a[j] = *(const f32x4*)(p.x + ii * 8); b[j] = *(const f32x4*)(p.x + ii * 8 + 4); } }
#pragma unroll
          for (int j = 0; j < 4; ++j) { const size_t ii = i + j * stride; if (ii < n8)
              *(u32x4*)(xb + ii * 8) = (u32x4){cvt_pk_bf16(a[j][0], a[j][1]), cvt_pk_bf16(a[j][2], a[j][3]), cvt_pk_bf16(b[j][0], b[j][1]), cvt_pk_bf16(b[j][2], b[j][3])}; } } }
    { float* cs = (float*)(ws + OFF_MISC);
      for (int i = blockIdx.x * NTHREADS + threadIdx.x; i < IN_COLS; i += gridDim.x * NTHREADS) {
          float v = 1.0f;
          if (i >= 2048 && i < 3072) { const int c = i - 2048; const float l0 = p.lb_logits[c], l1 = p.lb_logits[HG + c]; const float lb = 1.0f / (1.0f + expf(l1 - l0)); v = 1.0f - lb; }
          cs[i] = v; } }
    transpose_convert(p.w_in, (unsigned short*)(ws + OFF_WIN), DM, IN_COLS, tile, 0, true);
    transpose_convert(p.w_conv_out, (unsigned short*)(ws + OFF_WCO), CONV_DIM, DM, tile, CONV_DIM + HG);
    transpose_convert(p.w_hgrn_out, (unsigned short*)(ws + OFF_WCO) + CONV_DIM, HG, DM, tile, CONV_DIM + HG);
    transpose_convert(p.w_out, (unsigned short*)(ws + OFF_WOUT), DM, DM, tile);
    transpose_convert(p.w_ffn_in, (unsigned short*)(ws + OFF_WFI), DM, 2 * DFF, tile);
    transpose_convert(p.w_ffn_out, (unsigned short*)(ws + OFF_WFO), DFF, DM, tile);
}

__device__ void phase_conv(const Params& p, unsigned char* lds) {
    unsigned short* gin = (unsigned short*)lds;
    float* obuf = (float*)(lds + 96256);
    const unsigned short* cvg = (const unsigned short*)(p.ws + OFF_CVG);
    unsigned short* cout = (unsigned short*)(p.ws + OFF_XB);
    const int tid = threadIdx.x, wid = tid >> 6, lane = tid & 63;
    float w[CONV_K];
#pragma unroll
    for (int k = 0; k < CONV_K; ++k) w[k] = p.w_conv_dw[k * CONV_DIM + tid];
    const float bias = p.b_conv_dw[tid];
    float lg[8], lb[8];
#pragma unroll
    for (int j = 0; j < 8; ++j) { lg[j] = p.conv_ln_g[lane * 8 + j]; lb[j] = p.conv_ln_b[lane * 8 + j]; }
    for (int tile = blockIdx.x; tile < T_TOK / 64; tile += gridDim.x) {
        const int t0 = tile * 64, pos0 = t0 % SEQ;
        __syncthreads();
#pragma unroll
        for (int it0 = 0; it0 < 12; it0 += 4) {
            u32x4 av[4];
#pragma unroll
            for (int q = 0; q < 4; ++q) { const int i = tid + (it0 + q) * NTHREADS; const int row = i >> 6, c8 = (i & 63) * 8; const int pos = pos0 + row - 30;
                const bool valid = (i < 94 * 64) && (pos >= 0);
                const size_t tk = valid ? (size_t)(t0 + row - 30) : (size_t)t0;
                av[q] = *(const u32x4*)(cvg + tk * 512 + c8);
                if (!valid) av[q] = (u32x4){0u, 0u, 0u, 0u}; }
#pragma unroll
            for (int q = 0; q < 4; ++q) { const int i = tid + (it0 + q) * NTHREADS; const int row = i >> 6, c8 = (i & 63) * 8;
                if (i < 94 * 64) *(u32x4*)(gin + row * 512 + c8) = av[q]; }
        }
        __syncthreads();
        for (int rr = 0; rr < 4; ++rr) {
            float in[46];
#pragma unroll
            for (int j = 0; j < 46; ++j) in[j] = bf2f(gin[(rr * 16 + j) * 512 + tid]);
#pragma unroll
            for (int i = 0; i < 16; ++i) { float a = bias;
#pragma unroll
                for (int k = 0; k < CONV_K; ++k) a += w[k] * in[i + k];
                obuf[i * 512 + tid] = a; }
            __syncthreads();
#pragma unroll
            for (int q = 0; q < 2; ++q) { const int i = wid * 2 + q; const float* rp = obuf + i * 512 + lane * 8;
                const f32x4 a = *(const f32x4*)rp, b = *(const f32x4*)(rp + 4);
                float v[8] = {a[0], a[1], a[2], a[3], b[0], b[1], b[2], b[3]};
                float s = 0.f;
#pragma unroll
                for (int j = 0; j < 8; ++j) s += v[j];
                const float mean = wave_sum(s) * (1.0f / 512.0f);
                float ss = 0.f;
#pragma unroll
                for (int j = 0; j < 8; ++j) { v[j] -= mean; ss += v[j] * v[j]; }
                const float rstd = rsqrtf(wave_sum(ss) * (1.0f / 512.0f) + LN_EPS);
                float y[8];
#pragma unroll
                for (int j = 0; j < 8; ++j) { const float t = v[j] * rstd * lg[j] + lb[j]; y[j] = t * sigmoidf_(t); }
                *(u32x4*)(cout + (size_t)(t0 + rr * 16 + i) * 512 + lane * 8) = (u32x4){cvt_pk_bf16(y[0], y[1]), cvt_pk_bf16(y[2], y[3]), cvt_pk_bf16(y[4], y[5]), cvt_pk_bf16(y[6], y[7])}; }
            __syncthreads();
        }
    }
}

constexpr int H_QT = 0;
constexpr int H_KN = H_QT + 64 * 272;
constexpr int H_KT = H_KN + 64 * 272;
constexpr int H_VT = H_KT + 128 * 144;
constexpr int H_PP = H_VT + 128 * 144;
constexpr int H_SB = H_PP + 64 * 144;
constexpr int H_SEG = H_SB + 128 * 272;
constexpr int H_ER = H_SEG + 8192;
constexpr int H_EBL = H_ER + 512;
constexpr int H_SS = H_EBL + 512;
constexpr int H_END = H_SS + 2048;
static_assert(H_END <= LDS_BYTES, "hgrn lds");

template <bool OUT>
__device__ void hgrn_phase(const Params& p, unsigned char* lds, const int reps = 1) {
    const int tid = threadIdx.x, w = tid >> 6, lane = tid & 63, g = lane >> 4, c16 = lane & 15;
    const unsigned short* qg = (const unsigned short*)(p.ws + OFF_Q);
    const unsigned short* king = (const unsigned short*)(p.ws + OFF_KIN);
    const unsigned short* vg = (const unsigned short*)(p.ws + OFF_V);
    const unsigned short* gg = (const unsigned short*)(p.ws + OFF_G);
    unsigned short* og = (unsigned short*)(p.ws + OFF_CVG);
    float* segsum = (float*)(lds + H_SEG); float* er = (float*)(lds + H_ER); float* ebl = (float*)(lds + H_EBL); float* ssb = (float*)(lds + H_SS);
    const int kp = tid & 63;
    const int nchain = (256 - (int)blockIdx.x + (int)gridDim.x - 1) / (int)gridDim.x, nstep = nchain * 16 * reps;

    unsigned kraw[8], vraw[8], qraw[8];
    auto chunk_base = [&](int step) -> size_t {
        const int chain = blockIdx.x + ((step >> 4) % nchain) * gridDim.x, item = chain * 4 + ((step >> 2) & 3), c = step & 3;
        const int bh = item >> 5, sc = item & 31, b = bh >> 3, h = bh & 7;
        return ((size_t)b * SEQ + (size_t)sc * 256 + 64 * c + 8 * w) * 1024 + h * 128 + 2 * kp;
    };
    auto load_k = [&](int step) {
        const size_t gbase = chunk_base(step);
#pragma unroll
        for (int tt = 0; tt < 8; ++tt) kraw[tt] = *(const unsigned*)(king + gbase + (size_t)tt * 1024);
    };
    auto load_vq = [&](int step) {
        const size_t gbase = chunk_base(step);
#pragma unroll
        for (int tt = 0; tt < 8; ++tt) vraw[tt] = *(const unsigned*)(vg + gbase + (size_t)tt * 1024);
        if (OUT) {
#pragma unroll
            for (int tt = 0; tt < 8; ++tt) qraw[tt] = *(const unsigned*)(qg + gbase + (size_t)tt * 1024);
        }
    };
    float lf0[8], lf1[8], k0[8], k1[8];
    auto part1 = [&](int step) {
        float run0 = 0.f, run1 = 0.f;
#pragma unroll
        for (int tt = 0; tt < 8; ++tt) {
            const unsigned short lo = (unsigned short)(kraw[tt] & 0xffffu), hi = (unsigned short)(kraw[tt] >> 16);
            _Float16 hl, hh; __builtin_memcpy(&hl, &lo, 2); __builtin_memcpy(&hh, &hi, 2);
            k0[tt] = (float)hl; k1[tt] = (float)hh;
            run0 += __logf(fmaxf(1.0f - k0[tt], 1e-30f)); lf0[tt] = run0; run1 += __logf(fmaxf(1.0f - k1[tt], 1e-30f)); lf1[tt] = run1; }
        *(f32x2*)(segsum + (step & 1) * 1024 + w * 128 + 2 * kp) = (f32x2){run0, run1};
    };
    if (nstep > 0) { load_k(0); load_vq(0); part1(0); }

    f32x4 S[8];
    f32x4 gn = (f32x4){0.f, 0.f, 0.f, 0.f};
    float btot0 = 0.f, btot1 = 0.f;
    for (int step = 0; step < nstep; ++step) {
        const int chain = blockIdx.x + ((step >> 4) % nchain) * gridDim.x, jj = (step >> 2) & 3, item = chain * 4 + jj, c = step & 3;
        const int bh = item >> 5, sc = item & 31, b = bh >> 3, h = bh & 7;
        const size_t tc = (size_t)b * SEQ + (size_t)sc * 256 + 64 * c; const int ch0 = h * 128;
        unsigned short* Lg = (unsigned short*)(p.ws + OFF_L) + (size_t)chain * 16384;
        if (c == 0 && jj == 0) {
#pragma unroll
            for (int kt = 0; kt < 8; ++kt) {
                S[kt] = (f32x4){0.f, 0.f, 0.f, 0.f};
            }
            if (OUT) {
                const int nprev = chain & 7;
                for (int j = 0; j < nprev; ++j) {
                    const unsigned short* Lj = (const unsigned short*)(p.ws + OFF_L) + (size_t)((chain & ~7) + j) * 16384;
                    const float* Dj = (const float*)(p.ws + OFF_D) + (size_t)((chain & ~7) + j) * 128;
#pragma unroll
                    for (int kt = 0; kt < 8; ++kt) {
                        const u32x2 lv = *(const u32x2*)(Lj + (16 * w + c16) * 128 + 16 * kt + 4 * g);
                        const f32x4 dv = *(const f32x4*)(Dj + 16 * kt + 4 * g);
                        S[kt] = S[kt] * dv + (f32x4){bflo(lv[0]), bfhi(lv[0]), bflo(lv[1]), bfhi(lv[1])}; }
                }
            }
            if (OUT) gn = *(const f32x4*)(p.hgrn_norm_g + ch0 + 16 * w + 4 * g);
            btot0 = 0.f; btot1 = 0.f;
        }
        {
            __syncthreads();
            if (step + 1 < nstep) load_k(step + 1);
            float off0 = 0.f, off1 = 0.f, r0 = 0.f, r1 = 0.f, bl0 = 0.f, bl1 = 0.f;
#pragma unroll
            for (int sg = 0; sg < 8; ++sg) { const f32x2 sv = *(const f32x2*)(segsum + (step & 1) * 1024 + sg * 128 + 2 * kp);
                if (sg < w) { off0 += sv[0]; off1 += sv[1]; }
                if (sg < 4) { r0 += sv[0]; r1 += sv[1]; }
                bl0 += sv[0]; bl1 += sv[1]; }
            unsigned short kb0[8], kb1[8];
#pragma unroll
            for (int tt = 0; tt < 8; ++tt) {
                const float b0 = off0 + lf0[tt], b1 = off1 + lf1[tt];
                const float kt0 = k0[tt] * __expf(fminf(r0 - b0, 80.f)), kt1 = k1[tt] * __expf(fminf(r1 - b1, 80.f));
                const unsigned kpk = cvt_pk_bf16(kt0, kt1);
                kb0[tt] = (unsigned short)(kpk & 0xffffu); kb1[tt] = (unsigned short)(kpk >> 16);
                if (OUT) {
                    *(unsigned*)(lds + H_KN + (8 * w + tt) * 272 + kp * 4) = kpk;
                    const float q0 = bflo(qraw[tt]) * __expf(fminf(b0 - r0, 80.f)), q1 = bfhi(qraw[tt]) * __expf(fminf(b1 - r1, 80.f));
                    *(unsigned*)(lds + H_QT + (8 * w + tt) * 272 + kp * 4) = cvt_pk_bf16(q0, q1);
                }
            }
            u32x4 ka, kbv, va, vb;
#pragma unroll
            for (int j = 0; j < 4; ++j) {
                ka[j] = (unsigned)kb0[2 * j] | ((unsigned)kb0[2 * j + 1] << 16);
                kbv[j] = (unsigned)kb1[2 * j] | ((unsigned)kb1[2 * j + 1] << 16);
                va[j] = (vraw[2 * j] & 0xffffu) | (vraw[2 * j + 1] << 16);
                vb[j] = (vraw[2 * j] >> 16) | (vraw[2 * j + 1] & 0xffff0000u); }
            *(u32x4*)(lds + H_KT + (2 * kp) * 144 + w * 16) = ka;
            *(u32x4*)(lds + H_KT + (2 * kp + 1) * 144 + w * 16) = kbv;
            *(u32x4*)(lds + H_VT + (2 * kp) * 144 + w * 16) = va;
            *(u32x4*)(lds + H_VT + (2 * kp + 1) * 144 + w * 16) = vb;
            if (w == 0) { *(f32x2*)(er + 2 * kp) = (f32x2){__expf(r0), __expf(r1)}; *(f32x2*)(ebl + 2 * kp) = (f32x2){__expf(bl0 - r0), __expf(bl1 - r1)}; btot0 += bl0; btot1 += bl1; }
        }
        __syncthreads();
        if (step + 1 < nstep) load_vq(step + 1);
#pragma unroll
        for (int kt = 0; kt < 8; ++kt) {
            const f32x4 e = *(const f32x4*)(er + 16 * kt + 4 * g);
            S[kt] = S[kt] * e;
            if (OUT) *(u32x2*)(lds + H_SB + (16 * w + c16) * 272 + (16 * kt + 4 * g) * 2) = (u32x2){cvt_pk_bf16(S[kt][0], S[kt][1]), cvt_pk_bf16(S[kt][2], S[kt][3])};
        }
        if (OUT) {
#pragma unroll
            for (int i = 0; i < 2; ++i) {
                const int id = 2 * w + i, st = id >> 2, tt = id & 3;
                f32x4 a4 = (f32x4){0.f, 0.f, 0.f, 0.f};
                if (st <= tt) {
#pragma unroll
                    for (int ks = 0; ks < 4; ++ks) {
                        const bf16x8 af = *(const bf16x8*)(lds + H_KN + (16 * st + c16) * 272 + (32 * ks + 8 * g) * 2);
                        const bf16x8 bf = *(const bf16x8*)(lds + H_QT + (16 * tt + c16) * 272 + (32 * ks + 8 * g) * 2);
                        a4 = __builtin_amdgcn_mfma_f32_16x16x32_bf16(af, bf, a4, 0, 0, 0);
                    }
                    const int tcol = 16 * tt + c16;
#pragma unroll
                    for (int r = 0; r < 4; ++r) { const int srow = 16 * st + 4 * g + r; if (srow > tcol) a4[r] = 0.f; }
                }
                *(u32x2*)(lds + H_PP + (16 * tt + c16) * 144 + (16 * st + 4 * g) * 2) = (u32x2){cvt_pk_bf16(a4[0], a4[1]), cvt_pk_bf16(a4[2], a4[3])};
            }
        }
        __syncthreads();
        f32x4 O[4];
        u32x2 gzv[4];
        if (OUT) {
#pragma unroll
            for (int tt = 0; tt < 4; ++tt) gzv[tt] = *(const u32x2*)(gg + (tc + 16 * tt + c16) * 1024 + ch0 + 16 * w + 4 * g);
        }
        if (OUT) {
#pragma unroll
            for (int tt = 0; tt < 4; ++tt) {
                f32x4 a4 = (f32x4){0.f, 0.f, 0.f, 0.f};
#pragma unroll
                for (int ks = 0; ks < 2; ++ks) {
                    const bf16x8 af = *(const bf16x8*)(lds + H_VT + (16 * w + c16) * 144 + (32 * ks + 8 * g) * 2);
                    const bf16x8 bf = *(const bf16x8*)(lds + H_PP + (16 * tt + c16) * 144 + (32 * ks + 8 * g) * 2);
                    a4 = __builtin_amdgcn_mfma_f32_16x16x32_bf16(af, bf, a4, 0, 0, 0);
                }
#pragma unroll
                for (int ks = 0; ks < 4; ++ks) {
                    const bf16x8 af = *(const bf16x8*)(lds + H_SB + (16 * w + c16) * 272 + (32 * ks + 8 * g) * 2);
                    const bf16x8 bf = *(const bf16x8*)(lds + H_QT + (16 * tt + c16) * 272 + (32 * ks + 8 * g) * 2);
                    a4 = __builtin_amdgcn_mfma_f32_16x16x32_bf16(af, bf, a4, 0, 0, 0);
                }
                O[tt] = a4;
            }
        }
#pragma unroll
        for (int kt = 0; kt < 8; ++kt) {
#pragma unroll
            for (int ks = 0; ks < 2; ++ks) {
                const bf16x8 af = *(const bf16x8*)(lds + H_KT + (16 * kt + c16) * 144 + (32 * ks + 8 * g) * 2);
                const bf16x8 bf = *(const bf16x8*)(lds + H_VT + (16 * w + c16) * 144 + (32 * ks + 8 * g) * 2);
                S[kt] = __builtin_amdgcn_mfma_f32_16x16x32_bf16(af, bf, S[kt], 0, 0, 0);
            }
            const f32x4 e = *(const f32x4*)(ebl + 16 * kt + 4 * g);
            S[kt] = S[kt] * e;
        }
        if (OUT) {
#pragma unroll
            for (int tt = 0; tt < 4; ++tt) {
                float s = O[tt][0] * O[tt][0] + O[tt][1] * O[tt][1] + O[tt][2] * O[tt][2] + O[tt][3] * O[tt][3];
                s += __shfl_xor(s, 16); s += __shfl_xor(s, 32);
                if (g == 0) ssb[w * 64 + 16 * tt + c16] = s;
            }
            __syncthreads();
#pragma unroll
            for (int tt = 0; tt < 4; ++tt) {
                const int t = 16 * tt + c16; float tot = 0.f;
#pragma unroll
                for (int ww = 0; ww < 8; ++ww) tot += ssb[ww * 64 + t];
                const float rs = rsqrtf(tot * (1.0f / 128.0f) + RMS_EPS);
                const size_t gi = (tc + t) * 1024 + ch0 + 16 * w + 4 * g;
                const u32x2 gz = gzv[tt];
                const float o0 = bf2f(f2bf(O[tt][0] * rs * gn[0])) * bflo(gz[0]), o1 = bf2f(f2bf(O[tt][1] * rs * gn[1])) * bfhi(gz[0]);
                const float o2 = bf2f(f2bf(O[tt][2] * rs * gn[2])) * bflo(gz[1]), o3 = bf2f(f2bf(O[tt][3] * rs * gn[3])) * bfhi(gz[1]);
                *(u32x2*)(og + gi) = (u32x2){cvt_pk_bf16(o0, o1), cvt_pk_bf16(o2, o3)};
            }
        }
        if (!OUT && c == 3 && jj == 3) {
            float* Dg = (float*)(p.ws + OFF_D) + (size_t)chain * 128;
#pragma unroll
            for (int kt = 0; kt < 8; ++kt)
                *(u32x2*)(Lg + (16 * w + c16) * 128 + 16 * kt + 4 * g) = (u32x2){cvt_pk_bf16(S[kt][0], S[kt][1]), cvt_pk_bf16(S[kt][2], S[kt][3])};
            if (w == 0) *(f32x2*)(Dg + 2 * kp) = (f32x2){__expf(btot0), __expf(btot1)};
        }
        if (step + 1 < nstep) part1(step + 1);
    }
    __syncthreads();
}

__device__ void phase_scan(const Params& p) {
    unsigned short* L = (unsigned short*)(p.ws + OFF_L); const float* D = (const float*)(p.ws + OFF_D);
    for (int i = blockIdx.x * NTHREADS + threadIdx.x; i < 32 * 4096; i += gridDim.x * NTHREADS) {
        const int bh = i >> 12, e4 = i & 4095, k0 = (e4 & 31) * 4;
        f32x4 carry = (f32x4){0.f, 0.f, 0.f, 0.f};
        u32x2 v[8]; f32x4 d[8];
#pragma unroll
        for (int s = 0; s < 8; ++s) { const int chain = bh * 8 + s; v[s] = *(const u32x2*)(L + (size_t)chain * 16384 + e4 * 4); d[s] = *(const f32x4*)(D + chain * 128 + k0); }
#pragma unroll
        for (int s = 0; s < 8; ++s) { const int chain = bh * 8 + s;
            *(u32x2*)(L + (size_t)chain * 16384 + e4 * 4) = (u32x2){cvt_pk_bf16(carry[0], carry[1]), cvt_pk_bf16(carry[2], carry[3])};
            const f32x4 lv = (f32x4){bflo(v[s][0]), bfhi(v[s][0]), bflo(v[s][1]), bfhi(v[s][1])};
            carry = carry * d[s] + lv; }
    }
}

__device__ void phase_ln(float* buf, const float* gam, const float* bet, unsigned short* copyb) {
    const int lane = threadIdx.x & 63, wv = blockIdx.x * 8 + (threadIdx.x >> 6), nw = gridDim.x * 8;
    f32x4 gv[4], bv[4];
#pragma unroll
    for (int i = 0; i < 4; ++i) { gv[i] = *(const f32x4*)(gam + i * 256 + lane * 4); bv[i] = *(const f32x4*)(bet + i * 256 + lane * 4); }
    for (int r = wv; r < T_TOK; r += nw) {
        float* rp = buf + (size_t)r * 1024;
        f32x4 v[4]; float s = 0.f;
#pragma unroll
        for (int i = 0; i < 4; ++i) { v[i] = *(const f32x4*)(rp + i * 256 + lane * 4); s += v[i][0] + v[i][1] + v[i][2] + v[i][3]; }
        const float mean = wave_sum(s) * (1.0f / 1024.0f);
        float ss = 0.f;
#pragma unroll
        for (int i = 0; i < 4; ++i) { v[i] = v[i] - mean; ss += v[i][0] * v[i][0] + v[i][1] * v[i][1] + v[i][2] * v[i][2] + v[i][3] * v[i][3]; }
        const float rstd = rsqrtf(wave_sum(ss) * (1.0f / 1024.0f) + LN_EPS);
#pragma unroll
        for (int i = 0; i < 4; ++i) { const f32x4 y = v[i] * rstd * gv[i] + bv[i];
            if (copyb) *(u32x2*)(copyb + (size_t)r * 1024 + i * 256 + lane * 4) = (u32x2){cvt_pk_bf16(y[0], y[1]), cvt_pk_bf16(y[2], y[3])};
            else *(f32x4*)(rp + i * 256 + lane * 4) = y; }
    }
}

__device__ __forceinline__ float gelu_tanh(float x) {
    const float y = 0.7978845608028654f * (x + 0.044715f * x * x * x);
    const float t = 1.0f - 2.0f * __builtin_amdgcn_rcpf(1.0f + __expf(2.0f * y));
    return 0.5f * x * (1.0f + t);
}
__device__ void phase_act(const Params& p) {
    unsigned short* z = (unsigned short*)(p.ws + OFF_Z);
    constexpr int NCG = DFF / 8, RUN = 16, NRUN = T_TOK / RUN;
    for (int i = blockIdx.x * NTHREADS + threadIdx.x; i < NCG * NRUN; i += gridDim.x * NTHREADS) {
        const int cgi = i % NCG, run = i / NCG; const int c = cgi * 8; const size_t t0 = (size_t)run * RUN;
        float w0[8], w1[8], w2[8], bb[8];
#pragma unroll
        for (int j = 0; j < 8; ++j) { w0[j] = p.w_ffn_dw[c + j]; w1[j] = p.w_ffn_dw[DFF + c + j]; w2[j] = p.w_ffn_dw[2 * DFF + c + j]; bb[j] = p.b_ffn_dw[c + j]; }
        float um2[8], um1[8];
        if ((t0 % SEQ) == 0) {
#pragma unroll
            for (int j = 0; j < 8; ++j) { um2[j] = 0.f; um1[j] = 0.f; }
        } else {
            const u32x4 a = *(const u32x4*)(z + (t0 - 2) * (2 * DFF) + c), b = *(const u32x4*)(z + (t0 - 1) * (2 * DFF) + c);
#pragma unroll
            for (int j = 0; j < 4; ++j) { um2[2 * j] = bflo(a[j]); um2[2 * j + 1] = bfhi(a[j]); um1[2 * j] = bflo(b[j]); um1[2 * j + 1] = bfhi(b[j]); }
        }
#pragma unroll 4
        for (int tt = 0; tt < RUN; ++tt) {
            unsigned short* rowp = z + (t0 + tt) * (2 * DFF);
            const u32x4 a = *(const u32x4*)(rowp + c), gq = *(const u32x4*)(rowp + DFF + c);
            float u[8], gvv[8], o[8];
#pragma unroll
            for (int j = 0; j < 4; ++j) { u[2 * j] = bflo(a[j]); u[2 * j + 1] = bfhi(a[j]); gvv[2 * j] = bflo(gq[j]); gvv[2 * j + 1] = bfhi(gq[j]); }
#pragma unroll
            for (int j = 0; j < 8; ++j) { const float cv = w0[j] * um2[j] + w1[j] * um1[j] + w2[j] * u[j] + bb[j]; o[j] = gelu_tanh(cv) * gvv[j]; um2[j] = um1[j]; um1[j] = u[j]; }
            *(u32x4*)(rowp + DFF + c) = (u32x4){cvt_pk_bf16(o[0], o[1]), cvt_pk_bf16(o[2], o[3]), cvt_pk_bf16(o[4], o[5]), cvt_pk_bf16(o[6], o[7])};
        }
    }
}


#define XB_TMO      128
#define XB_XCNT(j)  (256  + 64 * (j))
#define XB_XSUB(j)  (1280 + 64 * (j))
#define XB_XGEN(j)  (2304 + 64 * (j))
#define XB_TOP      3328
#define XB_TOPGEN   3392
#define XCD_BAR_WORDS 3456
#define XB_SPIN_CAP (1u << 22)
__device__ __forceinline__ unsigned xb_ld(unsigned* p)              { return __hip_atomic_load(p, __ATOMIC_RELAXED, __HIP_MEMORY_SCOPE_AGENT); }
__device__ __forceinline__ unsigned xb_add(unsigned* p, unsigned v) { return __hip_atomic_fetch_add(p, v, __ATOMIC_RELAXED, __HIP_MEMORY_SCOPE_AGENT); }
__device__ __forceinline__ unsigned xb_xcc_id() { return (unsigned)__builtin_amdgcn_s_getreg((3 << 11) | 20) & 0xFu; }
#define XB_SPIN(cond, bar) do { unsigned _sp = 0; while (cond) { __builtin_amdgcn_s_sleep(1); \
    if ((++_sp & 255u) == 0u) { if (xb_ld(&(bar)[XB_TMO])) break; if (_sp > XB_SPIN_CAP) { atomicAdd(&(bar)[XB_TMO], 1u); break; } } } } while (0)
struct XcdBarrier { unsigned* bar; unsigned x; volatile LAS unsigned* st; };
__device__ __forceinline__ XcdBarrier xcd_barrier_post(unsigned* bar, volatile LAS unsigned* st) {
    XcdBarrier b; b.bar = bar; b.x = xb_xcc_id(); b.st = st;
    if (threadIdx.x == 0) (void)xb_add(&bar[XB_XCNT(b.x)], 1u);
    return b;
}
__device__ __forceinline__ void xcd_barrier_complete(unsigned* bar, unsigned x, unsigned& nloc, unsigned& nx) {
    const unsigned G = gridDim.x * gridDim.y * gridDim.z;
    unsigned sum, cnt, mine, sp = 0u;
    for (;;) {
        sum = 0u; cnt = 0u; mine = 0u;
#pragma unroll
        for (unsigned j = 0; j < 16; ++j) { const unsigned c = xb_ld(&bar[XB_XCNT(j)]); sum += c; cnt += (c > 0u) ? 1u : 0u; mine = (j == x) ? c : mine; }
        if (sum == G) break;
        __builtin_amdgcn_s_sleep(1);
        if ((++sp & 255u) == 0u) { if (xb_ld(&bar[XB_TMO])) break; if (sp > XB_SPIN_CAP) { atomicAdd(&bar[XB_TMO], 1u); break; } }
    }
    nloc = mine > 0u ? mine : 1u; nx = cnt > 0u ? cnt : 1u;
}
__device__ __forceinline__ void xcd_barrier(const XcdBarrier& b) {
    asm volatile("s_waitcnt vmcnt(0)" ::: "memory");
    __syncthreads();
    if (threadIdx.x == 0) {
        unsigned* bar = b.bar;
        __builtin_amdgcn_s_waitcnt(0);
        unsigned nloc = b.st[0], nx = b.st[1];
        if (nloc == 0u) { xcd_barrier_complete(bar, b.x, nloc, nx); b.st[0] = nloc; b.st[1] = nx; }
        const unsigned old = xb_add(&bar[XB_XSUB(b.x)], 1u);
        const unsigned gen = old / nloc;
        if (old + 1u == (gen + 1u) * nloc) {
            __builtin_amdgcn_fence(__ATOMIC_RELEASE, "agent");
            asm volatile("s_waitcnt vmcnt(0)" ::: "memory");
            const unsigned og = xb_add(&bar[XB_TOP], 1u);
            const unsigned tg = og / nx;
            if (og + 1u == (tg + 1u) * nx) xb_add(&bar[XB_TOPGEN], 1u);
            else XB_SPIN(xb_ld(&bar[XB_TOPGEN]) == tg, bar);
            __builtin_amdgcn_fence(__ATOMIC_ACQUIRE, "agent");
            xb_add(&bar[XB_XGEN(b.x)], 1u);
            asm volatile("s_waitcnt vmcnt(0)" ::: "memory");
        } else {
            XB_SPIN(xb_ld(&bar[XB_XGEN(b.x)]) == gen, bar);
            __builtin_amdgcn_fence(__ATOMIC_ACQUIRE, "agent");
            asm volatile("s_waitcnt vmcnt(0)" ::: "memory");
        }
    }
    __syncthreads();
}

#ifndef PHASE_MASK
#define PHASE_MASK 0x1fff
#endif
#ifndef DUP_MASK
#define DUP_MASK 0
#endif
#define PHASE(n) if ((PHASE_MASK & (1 << (n))) && (ph_only < 0 || ph_only == (n))) for (int rep_ = 0; rep_ < 1 + ((DUP_MASK >> (n)) & 1); ++rep_)
#define SYNC() do { if (ph_only < 0) xcd_barrier(xb); } while (0)
__global__ void __launch_bounds__(NTHREADS, 2) fwd_megakernel(Params p, int ph_only) {
    extern __shared__ __attribute__((aligned(16))) unsigned char shm[];
    cg::grid_group grid = cg::this_grid();
    LAS unsigned char* lds3 = (LAS unsigned char*)shm;
    volatile LAS unsigned* xst = (volatile LAS unsigned*)(lds3 + LDS_BYTES - 16);
    if (threadIdx.x == 0) { xst[0] = 0u; xst[1] = 0u; }
    __syncthreads();
    const XcdBarrier xb = xcd_barrier_post((unsigned*)(p.ws + OFF_BAR), xst);
    PHASE(0) { phase_prep(p, shm); }
    if (ph_only == -12345) grid.sync();
    SYNC();
    PHASE(1) { pg8::StaticOrder<IN_COLS / 256> S; S.init(T_TOK, IN_COLS, gridDim.x, blockIdx.x);
               pg8::Gemm g{(const bf16_t*)(p.ws + OFF_XB), (const bf16_t*)(p.ws + OFF_WIN), T_TOK, IN_COLS, DM, DM, nullptr, 0, 0};
               EpiProj e{p.ws, (unsigned short*)p.out, (const float*)(p.ws + OFF_MISC)}; pg8::gemm_phase(lds3, g, S, e); }
    SYNC();
    PHASE(2) { phase_conv(p, shm);
               hgrn_phase<false>(p, shm); }
    SYNC();
    PHASE(4) { hgrn_phase<true>(p, shm); }
    SYNC();
    PHASE(5) { pg8::StaticOrder<DM / 256> S; S.init(T_TOK, DM, gridDim.x, blockIdx.x);
               pg8::Gemm g{(const bf16_t*)(p.ws + OFF_XB), (const bf16_t*)(p.ws + OFF_WCO), T_TOK, DM, CONV_DIM + HG, CONV_DIM, (const bf16_t*)(p.ws + OFF_CVG), HG, CONV_DIM / 64};
               EpiMix e{(const unsigned short*)p.out, (unsigned short*)(p.ws + OFF_V)}; pg8::gemm_phase<EpiMix, true>(lds3, g, S, e); }
    SYNC();
    PHASE(7) { pg8::StaticOrder<DM / 256> S; S.init(T_TOK, DM, gridDim.x, blockIdx.x);
               pg8::Gemm g{(const bf16_t*)(p.ws + OFF_V), (const bf16_t*)(p.ws + OFF_WOUT), T_TOK, DM, DM, DM, nullptr, 0, 0};
               EpiLn<0> e{p.x, p.ws + OFF_G, p.ln1_g, p.ln1_b, (float*)(p.ws + OFF_PART7), (unsigned*)(p.ws + OFF_CNT), lds3 + 131072}; pg8::gemm_phase(lds3, g, S, e); }
    SYNC();
    PHASE(9) { pg8::StaticOrder<2 * DFF / 256> S; S.init(T_TOK, 2 * DFF, gridDim.x, blockIdx.x);
               pg8::Gemm g{(const bf16_t*)(p.ws + OFF_G), (const bf16_t*)(p.ws + OFF_WFI), T_TOK, 2 * DFF, DM, DM, nullptr, 0, 0};
               EpiZ e{(unsigned short*)(p.ws + OFF_Z), 2 * DFF}; pg8::gemm_phase(lds3, g, S, e); }
    SYNC();
    PHASE(10) { phase_act(p); }
    SYNC();
    PHASE(11) { pg8::StaticOrder<DM / 256> S; S.init(T_TOK, DM, gridDim.x, blockIdx.x);
                pg8::Gemm g{(const bf16_t*)(p.ws + OFF_Z) + DFF, (const bf16_t*)(p.ws + OFF_WFO), T_TOK, DM, DFF, 2 * DFF, nullptr, 0, 0};
                EpiLn<1> e{p.ws + OFF_G, p.out, p.ln2_g, p.ln2_b, (float*)(p.ws + OFF_PART11), (unsigned*)(p.ws + OFF_CNT) + 128 * 2 * 64, lds3 + 131072}; pg8::gemm_phase(lds3, g, S, e); }
}

extern "C" void kernel_launch(void* const* d_in, const int* in_sizes, int n_in, void* d_out, int out_size, void* d_ws, size_t ws_size, hipStream_t stream) {
    static int grid_blocks = 0;
    if (!grid_blocks) {
        int dev = 0, cus = 0, per_cu = 0;
        hipGetDevice(&dev);
        hipDeviceGetAttribute(&cus, hipDeviceAttributeMultiprocessorCount, dev);
        hipFuncSetAttribute((const void*)fwd_megakernel, hipFuncAttributeMaxDynamicSharedMemorySize, LDS_BYTES);
        hipOccupancyMaxActiveBlocksPerMultiprocessor(&per_cu, (const void*)fwd_megakernel, NTHREADS, LDS_BYTES);
        if (per_cu < 1) per_cu = 1;
        if (per_cu > 1) per_cu = 1;
        grid_blocks = cus * per_cu;
        if (ws_size < WS_NEED) fprintf(stderr, "kernel_launch: workspace too small: %zu < %zu\n", ws_size, (size_t)WS_NEED);
    }
    hipMemsetAsync((unsigned char*)d_ws + OFF_BAR, 0, ZERO_BYTES, stream);
    Params p{};
    p.x = (const float*)d_in[0]; p.w_in = (const float*)d_in[1]; p.w_conv_dw = (const float*)d_in[2]; p.b_conv_dw = (const float*)d_in[3];
    p.conv_ln_g = (const float*)d_in[4]; p.conv_ln_b = (const float*)d_in[5]; p.w_conv_out = (const float*)d_in[6]; p.lb_logits = (const float*)d_in[7];
    p.hgrn_norm_g = (const float*)d_in[8]; p.w_hgrn_out = (const float*)d_in[9]; p.w_out = (const float*)d_in[10]; p.ln1_g = (const float*)d_in[11];
    p.ln1_b = (const float*)d_in[12]; p.w_ffn_in = (const float*)d_in[13]; p.w_ffn_dw = (const float*)d_in[14]; p.b_ffn_dw = (const float*)d_in[15];
    p.w_ffn_out = (const float*)d_in[16]; p.ln2_g = (const float*)d_in[17]; p.ln2_b = (const float*)d_in[18];
    p.out = (float*)d_out; p.ws = (unsigned char*)d_ws;
#if defined(MULTI_LAUNCH)
    for (int ph = 0; ph < 13; ++ph) hipLaunchKernelGGL(fwd_megakernel, dim3(grid_blocks), dim3(NTHREADS), LDS_BYTES, stream, p, ph);
#else
    int ph_only = -1;
    void* args[] = {&p, &ph_only};
    hipError_t e = hipLaunchCooperativeKernel((const void*)fwd_megakernel, dim3(grid_blocks), dim3(NTHREADS), args, LDS_BYTES, stream);
    if (e != hipSuccess) fprintf(stderr, "cooperative launch failed: %s (grid %d)\n", hipGetErrorString(e), grid_blocks);
#endif
}
```

```cpp
#include <hip/hip_runtime.h>
#include <hip/hip_cooperative_groups.h>
#include <cstdio>
namespace cg = cooperative_groups;

#define LAS __attribute__((address_space(3)))
typedef unsigned short bf16_t;
typedef short bf16x8 __attribute__((ext_vector_type(8)));
typedef float f32x4 __attribute__((ext_vector_type(4)));
typedef float f32x2 __attribute__((ext_vector_type(2)));
typedef unsigned u32x4 __attribute__((ext_vector_type(4)));
typedef unsigned u32x2 __attribute__((ext_vector_type(2)));

constexpr int T_TOK = 32768, SEQ = 8192, DM = 1024, IN_COLS = 7168, CONV_DIM = 512, CONV_K = 31, HG = 1024, DFF = 2816;
constexpr float ALPHA = 1.189207115002721f;
constexpr float LN_EPS = 1e-5f, RMS_EPS = 1e-6f;
constexpr int NTHREADS = 512;
constexpr int LDS_BYTES = 140 * 1024;

constexpr size_t MiB = 1024ull * 1024ull;
constexpr size_t OFF_W    = 0;
constexpr size_t OFF_WIN  = OFF_W;
constexpr size_t OFF_WCO  = OFF_WIN + (size_t)IN_COLS * DM * 2;
constexpr size_t OFF_WHO  = OFF_WCO + (size_t)DM * CONV_DIM * 2;
constexpr size_t OFF_WOUT = OFF_WHO + (size_t)DM * HG * 2;
constexpr size_t OFF_WFI  = OFF_WOUT + (size_t)DM * DM * 2;
constexpr size_t OFF_WFO  = OFF_WFI + (size_t)2 * DFF * DM * 2;
constexpr size_t OFF_G    = 36 * MiB;
constexpr size_t OFF_Q    = 100 * MiB;
constexpr size_t OFF_KIN  = 164 * MiB;
constexpr size_t OFF_V    = 228 * MiB;
constexpr size_t OFF_XB   = 292 * MiB;
constexpr size_t OFF_CVG  = 356 * MiB;
constexpr size_t OFF_C    = 440 * MiB;
constexpr size_t OFF_L    = 420 * MiB;
constexpr size_t OFF_D    = 484 * MiB;
constexpr size_t OFF_MISC = 485 * MiB;
constexpr size_t OFF_Z    = OFF_Q;
constexpr size_t OFF_PART7  = 486 * MiB;
constexpr size_t OFF_PART11 = 487 * MiB;
constexpr size_t OFF_BAR  = 489 * MiB;
constexpr size_t OFF_CNT  = OFF_BAR + 64 * 1024;
constexpr size_t ZERO_BYTES = 64 * 1024 + 2 * 128 * 2 * 256;
constexpr size_t WS_NEED  = 490 * MiB;

struct Params {
    const float* x; const float* w_in; const float* w_conv_dw; const float* b_conv_dw; const float* conv_ln_g; const float* conv_ln_b;
    const float* w_conv_out; const float* lb_logits; const float* hgrn_norm_g; const float* w_hgrn_out; const float* w_out;
    const float* ln1_g; const float* ln1_b; const float* w_ffn_in; const float* w_ffn_dw; const float* b_ffn_dw; const float* w_ffn_out;
    const float* ln2_g; const float* ln2_b;
    float* out; unsigned char* ws;
};

__device__ __forceinline__ unsigned cvt_pk_bf16(float lo, float hi) { unsigned r; asm("v_cvt_pk_bf16_f32 %0, %1, %2" : "=v"(r) : "v"(lo), "v"(hi)); return r; }
__device__ __forceinline__ float bf2f(unsigned short b) { return __uint_as_float(((unsigned)b) << 16); }
__device__ __forceinline__ float bflo(unsigned u) { return __uint_as_float(u << 16); }
__device__ __forceinline__ float bfhi(unsigned u) { return __uint_as_float(u & 0xffff0000u); }
__device__ __forceinline__ unsigned short f2bf(float f) { return (unsigned short)(cvt_pk_bf16(f, 0.f) & 0xffffu); }
__device__ __forceinline__ float sigmoidf_(float x) { return __builtin_amdgcn_rcpf(1.0f + __expf(-x)); }
__device__ __forceinline__ unsigned pk_f16(float lo, float hi) {
    _Float16 a = (_Float16)lo, b = (_Float16)hi; unsigned short ua, ub; __builtin_memcpy(&ua, &a, 2); __builtin_memcpy(&ub, &b, 2); return (unsigned)ua | ((unsigned)ub << 16); }
__device__ __forceinline__ float wave_sum(float v) {
#pragma unroll
    for (int o = 32; o >= 1; o >>= 1) v += __shfl_xor(v, o);
    return v; }

namespace pg8 {
constexpr int BM = 256, BK = 64, HALF = 128, HTB = HALF * BK * 2, STAGE_BYTES = 8 * HTB, NXCD = 8, WGM = 4;
__host__ __device__ __forceinline__ int lds_byte(int r, int c) { const int st = (r >> 4) * 2 + (c >> 5), rr = r & 15, cc = c & 31, ob = rr * 64 + cc * 2; return st * 1024 + (ob ^ (((ob >> 9) & 1) << 5)); }
__host__ __device__ __forceinline__ void stage_rc(int b, int& R, int& C) { const int st = b / 1024, sb = b % 1024, swz = sb ^ (((sb >> 9) & 1) << 5); R = (st >> 1) * 16 + swz / 64; C = (st & 1) * 32 + (swz % 64) / 2; }
__host__ __device__ __forceinline__ int perm32(int rho) { const int n = rho >> 4, i = rho & 15; return 8 * (i >> 2) + 4 * n + (i & 3); }
struct Unit { int pm, pn; };
struct Gemm { const bf16_t* A; const bf16_t* Bt; int M, N, K, lda; const bf16_t* A2; int lda2; int ksplit; };
template <int NN  > struct StaticOrder {
    static constexpr int nM = T_TOK / BM, nN = NN, nwg = nM * nN, nig = WGM * nN, q = nwg / NXCD;
    static_assert(nwg % NXCD == 0 && nM % WGM == 0, "unit order");
    int G, c, reps, rounds;
    __device__ void init(int, int, int G_, int c_, int reps_ = 1) { G = G_; c = c_; reps = reps_; rounds = (nwg + G - 1) / G; }
    __device__ bool next(int i, Unit& u) const {
        if (i >= rounds * reps) return false;
        const int ir = (reps == 1) ? i : (i % rounds);
        const long L = (long)ir * G + c; if (L >= nwg) return false;
        const int l = (int)L, wgid = (l % NXCD) * q + l / NXCD;
        const int gid = wgid / nig, idx = wgid % nig;
        u.pm = gid * WGM + (idx % WGM); u.pn = idx / WGM; return true;
    }
};

template <class Epi, bool DUAL = false, class Sched>
__device__ __forceinline__ void gemm_phase(LAS unsigned char* lds, const Gemm g, const Sched& S, Epi& E) {
    const int tid = threadIdx.x, wid = __builtin_amdgcn_readfirstlane(tid >> 6), lane = tid & 63, wr = wid >> 2, wc = wid & 3, fr = lane & 15, fq = lane >> 4;
    const int K = g.K, nt = K / BK, lda = g.lda, lda2 = g.lda2, ksplit = g.ksplit;
    unsigned voffA[2], voffA2[2], voffB[2];
#pragma unroll
    for (int i = 0; i < 2; ++i) { int R, C; stage_rc(tid * 16 + i * 8192, R, C); const int Rb = Epi::PERM ? ((R & ~31) + perm32(R & 31)) : R;
        voffA[i] = (unsigned)(R * lda + C) * 2u; voffA2[i] = DUAL ? (unsigned)(R * lda2 + C) * 2u : 0u; voffB[i] = (unsigned)(Rb * K + C) * 2u; }
    const size_t kstep = (size_t)(BK * 2);
    const size_t hstepA = (size_t)HALF * lda * 2, hstepA2 = (size_t)HALF * lda2 * 2, hstepB = (size_t)HALF * K * 2;
    const unsigned ldsw = (unsigned)wid * 1024u;
    const int aoff = lds_byte(wr * 64 + fr, fq * 8), boff = lds_byte(wc * 32 + fr, fq * 8);
#define PG8_SA(b, h) (((b) * 2 + (h)) * HTB)
#define PG8_SB(b, h) ((4 + (b) * 2 + (h)) * HTB)
    auto stA = [&](int bufoff, int pm, int kt, int half) {
        const char* base; unsigned v0, v1;
        if (DUAL && kt >= ksplit) { base = (const char*)g.A2 + (size_t)(2 * pm + half) * hstepA2 + (size_t)(kt - ksplit) * kstep; v0 = voffA2[0]; v1 = voffA2[1]; }
        else                      { base = (const char*)g.A  + (size_t)(2 * pm + half) * hstepA  + (size_t)kt * kstep;            v0 = voffA[0];  v1 = voffA[1]; }
        __builtin_amdgcn_global_load_lds((const unsigned*)(base + v0), (LAS unsigned*)(lds + bufoff + ldsw), 16, 0, 0);
        __builtin_amdgcn_global_load_lds((const unsigned*)(base + v1), (LAS unsigned*)(lds + bufoff + ldsw + 8192), 16, 0, 0);
    };
    auto stB = [&](int bufoff, int pn, int kt, int half) {
        const char* base = (const char*)g.Bt + (size_t)(2 * pn + half) * hstepB + (size_t)kt * kstep;
        __builtin_amdgcn_global_load_lds((const unsigned*)(base + voffB[0]), (LAS unsigned*)(lds + bufoff + ldsw), 16, 0, 0);
        __builtin_amdgcn_global_load_lds((const unsigned*)(base + voffB[1]), (LAS unsigned*)(lds + bufoff + ldsw + 8192), 16, 0, 0);
    };
#define PG8_LDA(dst, b, h) do { _Pragma("unroll") for (int m = 0; m < 4; ++m) _Pragma("unroll") for (int k = 0; k < 2; ++k) dst[m][k] = *(const LAS bf16x8*)(lds + PG8_SA(b, h) + aoff + m * 2048 + k * 1024); } while (0)
#define PG8_LDB(dst, b, h) do { _Pragma("unroll") for (int n = 0; n < 2; ++n) _Pragma("unroll") for (int k = 0; k < 2; ++k) dst[n][k] = *(const LAS bf16x8*)(lds + PG8_SB(b, h) + boff + n * 2048 + k * 1024); } while (0)
#define PG8_MMA(ai, bj, At, Bt) do { __builtin_amdgcn_s_setprio(1); _Pragma("unroll") for (int m = 0; m < 4; ++m) _Pragma("unroll") for (int n = 0; n < 2; ++n) _Pragma("unroll") for (int k = 0; k < 2; ++k) \
        acc[ai][bj][m][n] = __builtin_amdgcn_mfma_f32_16x16x32_bf16(Bt[n][k], At[m][k], acc[ai][bj][m][n], 0, 0, 0); __builtin_amdgcn_s_setprio(0); } while (0)
#define PG8_WAIT_V(n) asm volatile("s_waitcnt vmcnt(" #n ")" ::: "memory")
#define PG8_WAIT_L(n) asm volatile("s_waitcnt lgkmcnt(" #n ")" ::: "memory")
#define PG8_BAR __builtin_amdgcn_s_barrier()
#define PG8_SCHED __builtin_amdgcn_sched_barrier(0)
    Unit cur, nxt; int ui = 0;
    if (!S.next(0, cur)) return;
    f32x4 acc[2][2][4][2];
#pragma unroll
    for (int a = 0; a < 2; ++a)
#pragma unroll
        for (int b = 0; b < 2; ++b)
#pragma unroll
            for (int m = 0; m < 4; ++m)
#pragma unroll
                for (int n = 0; n < 2; ++n) acc[a][b][m][n] = (f32x4){0.f, 0.f, 0.f, 0.f};
    bf16x8 At[4][2], B0[2][2], B1[2][2];
    stB(PG8_SB(0, 0), cur.pn, 0, 0); stA(PG8_SA(0, 0), cur.pm, 0, 0); stB(PG8_SB(0, 1), cur.pn, 0, 1); stA(PG8_SA(0, 1), cur.pm, 0, 1);
    if (wr == 1) PG8_BAR;
    PG8_WAIT_V(4); PG8_BAR;
    stB(PG8_SB(1, 0), cur.pn, 1, 0); stA(PG8_SA(1, 0), cur.pm, 1, 0); stB(PG8_SB(1, 1), cur.pn, 1, 1);
    PG8_WAIT_V(6); PG8_BAR;
    for (;;) {
        const bool has_next = S.next(ui + 1, nxt);
        const int npm = has_next ? nxt.pm : cur.pm, npn = has_next ? nxt.pn : cur.pn;
        for (int t = 0; t < nt; t += 2) {
            const bool last = (t == nt - 2);
            const int pm2 = last ? npm : cur.pm, pn2 = last ? npn : cur.pn, k2 = last ? 0 : t + 2, k3 = k2 + 1;
            if constexpr (DUAL) { if (t == ksplit) E.mid(acc, cur, wr, wc, fr, fq); }
            PG8_LDB(B0, 0, 0); PG8_SCHED; PG8_LDA(At, 0, 0); stA(PG8_SA(1, 1), cur.pm, t + 1, 1);
            PG8_WAIT_L(8); PG8_BAR; PG8_WAIT_L(0); PG8_MMA(0, 0, At, B0); PG8_BAR; PG8_SCHED;
            PG8_LDB(B1, 0, 1); stB(PG8_SB(0, 0), pn2, k2, 0);
            PG8_BAR; PG8_WAIT_L(0); PG8_MMA(0, 1, At, B1); PG8_BAR;
            PG8_LDA(At, 0, 1); stA(PG8_SA(0, 0), pm2, k2, 0);
            PG8_BAR; PG8_WAIT_L(0); PG8_MMA(1, 0, At, B0); PG8_BAR; PG8_SCHED;
            stB(PG8_SB(0, 1), pn2, k2, 1);
            PG8_WAIT_V(6); PG8_BAR; PG8_MMA(1, 1, At, B1); PG8_BAR;
            PG8_LDB(B0, 1, 0); PG8_SCHED; PG8_LDA(At, 1, 0); stA(PG8_SA(0, 1), pm2, k2, 1);
            PG8_WAIT_L(8); PG8_BAR; PG8_WAIT_L(0); PG8_MMA(0, 0, At, B0); PG8_BAR; PG8_SCHED;
            PG8_LDB(B1, 1, 1); stB(PG8_SB(1, 0), pn2, k3, 0);
            PG8_BAR; PG8_WAIT_L(0); PG8_MMA(0, 1, At, B1); PG8_BAR;
            PG8_LDA(At, 1, 1); stA(PG8_SA(1, 0), pm2, k3, 0);
            PG8_BAR; PG8_WAIT_L(0); PG8_MMA(1, 0, At, B0); PG8_BAR; PG8_SCHED;
            stB(PG8_SB(1, 1), pn2, k3, 1);
            PG8_WAIT_V(6); PG8_BAR; PG8_MMA(1, 1, At, B1); PG8_BAR;
        }
        E(acc, cur, wr, wc, fr, fq);
        if (!has_next) break;
#pragma unroll
        for (int a = 0; a < 2; ++a)
#pragma unroll
            for (int b = 0; b < 2; ++b)
#pragma unroll
                for (int m = 0; m < 4; ++m)
#pragma unroll
                    for (int n = 0; n < 2; ++n) acc[a][b][m][n] = (f32x4){0.f, 0.f, 0.f, 0.f};
        cur = nxt; ++ui;
    }
    PG8_WAIT_V(0);
    if (wr == 0) PG8_BAR;
    PG8_BAR;
#undef PG8_SA
#undef PG8_SB
#undef PG8_LDA
#undef PG8_LDB
#undef PG8_MMA
#undef PG8_WAIT_V
#undef PG8_WAIT_L
#undef PG8_BAR
#undef PG8_SCHED
}
}
using pg8::Unit;

struct EpiProj {
    static constexpr bool PERM = true;
    unsigned char* ws; unsigned short* mgate; const float* colscale;
    __device__ __forceinline__ void operator()(const f32x4 (&acc)[2][2][4][2], const Unit& u, int wr, int wc, int fr, int fq) const {
        const int pn = u.pn;
        if (pn < 4) {
            const int rowg = u.pm * 256 + wr * 64 + fr, chl = pn * 128 + wc * 32 + 8 * fq;
            unsigned short* glu = (unsigned short*)(ws + OFF_CVG);
#pragma unroll
            for (int ai = 0; ai < 2; ++ai)
#pragma unroll
                for (int m = 0; m < 4; ++m) {
                    float o[8];
#pragma unroll
                    for (int n = 0; n < 2; ++n)
#pragma unroll
                        for (int j = 0; j < 4; ++j) o[n * 4 + j] = acc[ai][0][m][n][j] * __builtin_amdgcn_rcpf(1.0f + __expf(-acc[ai][1][m][n][j]));
                    *(u32x4*)(glu + (size_t)(rowg + ai * 128 + m * 16) * 512 + chl) = (u32x4){cvt_pk_bf16(o[0], o[1]), cvt_pk_bf16(o[2], o[3]), cvt_pk_bf16(o[4], o[5]), cvt_pk_bf16(o[6], o[7])};
                }
            return;
        }
        if (pn >= 20) {
            const int rowg = u.pm * 256 + wr * 64 + fr, chl = (pn - 20) * 128 + wc * 32 + 8 * fq;
#pragma unroll
            for (int ai = 0; ai < 2; ++ai)
#pragma unroll
                for (int m = 0; m < 4; ++m) {
                    float ra[8], g1[8];
#pragma unroll
                    for (int n = 0; n < 2; ++n)
#pragma unroll
                        for (int j = 0; j < 4; ++j) { const float d0 = 1.0f + __expf(-acc[ai][0][m][n][j]), d1 = 1.0f + __expf(-acc[ai][1][m][n][j]);
                            g1[n * 4 + j] = __builtin_amdgcn_rcpf(d1); ra[n * 4 + j] = d1 * __builtin_amdgcn_rcpf(d0); }
                    unsigned short* rowp = mgate + (size_t)(rowg + ai * 128 + m * 16) * 2048 + chl;
                    *(u32x4*)rowp = (u32x4){cvt_pk_bf16(ra[0], ra[1]), cvt_pk_bf16(ra[2], ra[3]), cvt_pk_bf16(ra[4], ra[5]), cvt_pk_bf16(ra[6], ra[7])};
                    *(u32x4*)(rowp + 1024) = (u32x4){cvt_pk_bf16(g1[0], g1[1]), cvt_pk_bf16(g1[2], g1[3]), cvt_pk_bf16(g1[4], g1[5]), cvt_pk_bf16(g1[6], g1[7])};
                }
            return;
        }
        unsigned short* base; int ld, colt; float c0, c1, c2, sgn; bool f16 = false;
        if (pn < 4)       { base = (unsigned short*)(ws + OFF_CVG); ld = 1024; colt = pn * 256; if (pn < 2) { c0 = 1.f; c1 = 0.f; c2 = 0.f; } else { c0 = 0.f; c1 = 1.f; c2 = 0.f; } sgn = 1.f; }
        else if (pn < 8)  { base = (unsigned short*)(ws + OFF_Q);   ld = 1024; colt = (pn - 4) * 256;  c0 = 0.f; c1 = 0.f; c2 = 1.f; sgn = 1.f; }
        else if (pn < 12) { base = (unsigned short*)(ws + OFF_KIN); ld = 1024; colt = (pn - 8) * 256;  c0 = 0.f; c1 = 1.f; c2 = 0.f; sgn = -1.f; f16 = true; }
        else if (pn < 16) { base = (unsigned short*)(ws + OFF_V);   ld = 1024; colt = (pn - 12) * 256; c0 = 1.f; c1 = 0.f; c2 = 0.f; sgn = 1.f; }
        else if (pn < 20) { base = (unsigned short*)(ws + OFF_G);   ld = 1024; colt = (pn - 16) * 256; c0 = 0.f; c1 = 0.f; c2 = 1.f; sgn = 1.f; }
        else              { base = mgate;                           ld = 2048; colt = (pn - 20) * 256; c0 = 0.f; c1 = 1.f; c2 = 0.f; sgn = 1.f; }
        const int row0 = u.pm * 256 + wr * 64 + fr, coll = wc * 32 + 8 * fq;
        f32x4 cs[2][2];
#pragma unroll
        for (int bj = 0; bj < 2; ++bj)
#pragma unroll
            for (int n = 0; n < 2; ++n) cs[bj][n] = f16 ? *(const f32x4*)(colscale + pn * 256 + bj * 128 + coll + 4 * n) : (f32x4){1.f, 1.f, 1.f, 1.f};
#pragma unroll
        for (int ai = 0; ai < 2; ++ai)
#pragma unroll
            for (int m = 0; m < 4; ++m) {
                unsigned short* rowp = base + (size_t)(row0 + ai * 128 + m * 16) * ld + colt + coll;
#pragma unroll
                for (int bj = 0; bj < 2; ++bj) {
                    float o[8];
#pragma unroll
                    for (int n = 0; n < 2; ++n)
#pragma unroll
                        for (int j = 0; j < 4; ++j) { const float z = acc[ai][bj][m][n][j]; const float s = __builtin_amdgcn_rcpf(1.0f + __expf(-sgn * z)); o[n * 4 + j] = (c0 * z + s * (c1 + c2 * z)) * cs[bj][n][j]; }
                    const u32x4 pkh = (u32x4){pk_f16(o[0], o[1]), pk_f16(o[2], o[3]), pk_f16(o[4], o[5]), pk_f16(o[6], o[7])};
                    const u32x4 pkb = (u32x4){cvt_pk_bf16(o[0], o[1]), cvt_pk_bf16(o[2], o[3]), cvt_pk_bf16(o[4], o[5]), cvt_pk_bf16(o[6], o[7])};
                    u32x4 pk;
#pragma unroll
                    for (int q = 0; q < 4; ++q) pk[q] = f16 ? pkh[q] : pkb[q];
                    *(u32x4*)(rowp + bj * 128) = pk;
                }
            }
    }
};
struct EpiMix {
    static constexpr bool PERM = false;
    const unsigned short* mgate; unsigned short* mixed;
    __device__ __forceinline__ void mid(f32x4 (&acc)[2][2][4][2], const Unit& u, int wr, int wc, int fr, int fq) const {
        const int row0 = u.pm * 256 + wr * 64 + fr, col0 = u.pn * 256 + wc * 32 + 4 * fq;
#pragma unroll
        for (int ai = 0; ai < 2; ++ai)
#pragma unroll
            for (int m = 0; m < 4; ++m) { const size_t r = (size_t)(row0 + ai * 128 + m * 16);
#pragma unroll
                for (int bj = 0; bj < 2; ++bj)
#pragma unroll
                    for (int n = 0; n < 2; ++n) { const int c = col0 + bj * 128 + n * 16;
                        const u32x2 ga = *(const u32x2*)(mgate + r * 2048 + c);
                        acc[ai][bj][m][n][0] *= bflo(ga[0]); acc[ai][bj][m][n][1] *= bfhi(ga[0]);
                        acc[ai][bj][m][n][2] *= bflo(ga[1]); acc[ai][bj][m][n][3] *= bfhi(ga[1]); } }
    }
    __device__ __forceinline__ void operator()(const f32x4 (&acc)[2][2][4][2], const Unit& u, int wr, int wc, int fr, int fq) const {
        const int row0 = u.pm * 256 + wr * 64 + fr, col0 = u.pn * 256 + wc * 32 + 4 * fq;
#pragma unroll
        for (int ai = 0; ai < 2; ++ai)
#pragma unroll
            for (int m = 0; m < 4; ++m) { const size_t r = (size_t)(row0 + ai * 128 + m * 16);
#pragma unroll
                for (int bj = 0; bj < 2; ++bj)
#pragma unroll
                    for (int n = 0; n < 2; ++n) { const int c = col0 + bj * 128 + n * 16;
                        const u32x2 gb = *(const u32x2*)(mgate + r * 2048 + 1024 + c);
                        const f32x4 v = acc[ai][bj][m][n];
                        *(u32x2*)(mixed + r * 1024 + c) = (u32x2){cvt_pk_bf16(v[0] * bflo(gb[0]), v[1] * bfhi(gb[0])), cvt_pk_bf16(v[2] * bflo(gb[1]), v[3] * bfhi(gb[1]))}; } }
    }
};
struct EpiRes {
    static constexpr bool PERM = false;
    const float* res; float* dst;
    __device__ __forceinline__ void operator()(const f32x4 (&acc)[2][2][4][2], const Unit& u, int wr, int wc, int fr, int fq) const {
        const int row0 = u.pm * 256 + wr * 64 + fr, col0 = u.pn * 256 + wc * 32 + 4 * fq;
#pragma unroll
        for (int ai = 0; ai < 2; ++ai)
#pragma unroll
            for (int m = 0; m < 4; ++m) { const size_t r = (size_t)(row0 + ai * 128 + m * 16);
#pragma unroll
                for (int bj = 0; bj < 2; ++bj)
#pragma unroll
                    for (int n = 0; n < 2; ++n) { const int c = col0 + bj * 128 + n * 16;
                        const f32x4 t = *(const f32x4*)(res + r * 1024 + c);
                        *(f32x4*)(dst + r * 1024 + c) = t * ALPHA + acc[ai][bj][m][n]; } }
    }
};
struct EpiResB {
    static constexpr bool PERM = false;
    const unsigned short* res; float* dst;
    __device__ __forceinline__ void operator()(const f32x4 (&acc)[2][2][4][2], const Unit& u, int wr, int wc, int fr, int fq) const {
        const int row0 = u.pm * 256 + wr * 64 + fr, col0 = u.pn * 256 + wc * 32 + 4 * fq;
#pragma unroll
        for (int ai = 0; ai < 2; ++ai)
#pragma unroll
            for (int m = 0; m < 4; ++m) { const size_t r = (size_t)(row0 + ai * 128 + m * 16);
#pragma unroll
                for (int bj = 0; bj < 2; ++bj)
#pragma unroll
                    for (int n = 0; n < 2; ++n) { const int c = col0 + bj * 128 + n * 16;
                        const u32x2 t = *(const u32x2*)(res + r * 1024 + c);
                        const f32x4 tv = (f32x4){bflo(t[0]), bfhi(t[0]), bflo(t[1]), bfhi(t[1])};
                        *(f32x4*)(dst + r * 1024 + c) = tv * ALPHA + acc[ai][bj][m][n]; } }
    }
};
template <int MODE  > struct EpiLn {
    static constexpr bool PERM = false;
    const void* res; void* outp; const float* gam; const float* bet; float* part; unsigned* cnt; LAS unsigned char* ldsx;
    __device__ __forceinline__ void operator()(f32x4 (&acc)[2][2][4][2], const Unit& u, int wr, int wc, int fr, int fq) const {
        const int row0 = u.pm * 256 + wr * 64 + fr, col0 = u.pn * 256 + wc * 32 + 4 * fq;
        LAS float* red = (LAS float*)ldsx;
        LAS float* stats = (LAS float*)(ldsx + 8192);
#pragma unroll
        for (int ai = 0; ai < 2; ++ai)
#pragma unroll
            for (int m = 0; m < 4; ++m) { const size_t r = (size_t)(row0 + ai * 128 + m * 16);
                float s1 = 0.f, s2 = 0.f;
#pragma unroll
                for (int bj = 0; bj < 2; ++bj)
#pragma unroll
                    for (int n = 0; n < 2; ++n) { const int c = col0 + bj * 128 + n * 16;
                        f32x4 tv;
                        if (MODE == 0) tv = *(const f32x4*)((const float*)res + r * 1024 + c);
                        else { const u32x2 t = *(const u32x2*)((const unsigned short*)res + r * 1024 + c); tv = (f32x4){bflo(t[0]), bfhi(t[0]), bflo(t[1]), bfhi(t[1])}; }
                        const f32x4 v = tv * ALPHA + acc[ai][bj][m][n];
                        acc[ai][bj][m][n] = v;
                        s1 += v[0] + v[1] + v[2] + v[3]; s2 += v[0] * v[0] + v[1] * v[1] + v[2] * v[2] + v[3] * v[3]; }
                s1 += __shfl_xor(s1, 16); s1 += __shfl_xor(s1, 32); s2 += __shfl_xor(s2, 16); s2 += __shfl_xor(s2, 32);
                if (fq == 0) { const int rl = ai * 128 + wr * 64 + m * 16 + fr; red[(rl * 4 + wc) * 2] = s1; red[(rl * 4 + wc) * 2 + 1] = s2; } }
        __syncthreads();
        if (wc == 0) {
            const int lane = fq * 16 + fr;
            unsigned* cw = cnt + (size_t)(u.pm * 2 + wr) * 64;
            float* mypart = part + ((size_t)(u.pm * 4 + u.pn) * 256) * 2;
#pragma unroll
            for (int q = 0; q < 2; ++q) { const int i = lane + 64 * q, rl = (i >> 6) * 128 + wr * 64 + (i & 63);
                float t1 = 0.f, t2 = 0.f;
#pragma unroll
                for (int w4 = 0; w4 < 4; ++w4) { t1 += red[(rl * 4 + w4) * 2]; t2 += red[(rl * 4 + w4) * 2 + 1]; }
                const unsigned long long pv = (unsigned long long)__float_as_uint(t1) | ((unsigned long long)__float_as_uint(t2) << 32);
                __hip_atomic_store((unsigned long long*)(mypart + rl * 2), pv, __ATOMIC_RELAXED, __HIP_MEMORY_SCOPE_AGENT); }
            asm volatile("s_waitcnt vmcnt(0)" ::: "memory");
            if (lane == 0) (void)__hip_atomic_fetch_add(cw, 1u, __ATOMIC_RELAXED, __HIP_MEMORY_SCOPE_AGENT);
            { unsigned sp = 0;
              while ((unsigned)__builtin_amdgcn_readfirstlane(__hip_atomic_load(cw, __ATOMIC_RELAXED, __HIP_MEMORY_SCOPE_AGENT)) < 4u) { __builtin_amdgcn_s_sleep(1); if (++sp > (1u << 22)) break; } }
            asm volatile("" ::: "memory");
#pragma unroll
            for (int q = 0; q < 2; ++q) { const int i = lane + 64 * q, rl = (i >> 6) * 128 + wr * 64 + (i & 63);
                float t1 = 0.f, t2 = 0.f;
#pragma unroll
                for (int pn = 0; pn < 4; ++pn) { const unsigned long long pv = __hip_atomic_load((unsigned long long*)(part + ((size_t)(u.pm * 4 + pn) * 256 + rl) * 2), __ATOMIC_RELAXED, __HIP_MEMORY_SCOPE_AGENT);
                    t1 += __uint_as_float((unsigned)pv); t2 += __uint_as_float((unsigned)(pv >> 32)); }
                const float mean = t1 * (1.0f / 1024.0f); const float var = fmaxf(t2 * (1.0f / 1024.0f) - mean * mean, 0.f);
                stats[rl * 2] = mean; stats[rl * 2 + 1] = rsqrtf(var + LN_EPS); }
        }
        __syncthreads();
#pragma unroll
        for (int ai = 0; ai < 2; ++ai)
#pragma unroll
            for (int m = 0; m < 4; ++m) { const size_t r = (size_t)(row0 + ai * 128 + m * 16); const int rl = ai * 128 + wr * 64 + m * 16 + fr;
                const float mean = stats[rl * 2], rstd = stats[rl * 2 + 1];
#pragma unroll
                for (int bj = 0; bj < 2; ++bj)
#pragma unroll
                    for (int n = 0; n < 2; ++n) { const int c = col0 + bj * 128 + n * 16;
                        const f32x4 gv = *(const f32x4*)(gam + c), bv = *(const f32x4*)(bet + c);
                        const f32x4 y = (acc[ai][bj][m][n] - mean) * rstd * gv + bv;
                        if (MODE != 1) *(u32x2*)((unsigned short*)outp + r * 1024 + c) = (u32x2){cvt_pk_bf16(y[0], y[1]), cvt_pk_bf16(y[2], y[3])};
                        else *(f32x4*)((float*)outp + r * 1024 + c) = y; } }
    }
};
struct EpiZ {
    static constexpr bool PERM = true;
    unsigned short* z; int ld;
    __device__ __forceinline__ void operator()(const f32x4 (&acc)[2][2][4][2], const Unit& u, int wr, int wc, int fr, int fq) const {
        const int row0 = u.pm * 256 + wr * 64 + fr, col0 = u.pn * 256 + wc * 32 + 8 * fq;
#pragma unroll
        for (int ai = 0; ai < 2; ++ai)
#pragma unroll
            for (int m = 0; m < 4; ++m) { unsigned short* rowp = z + (size_t)(row0 + ai * 128 + m * 16) * ld + col0;
#pragma unroll
                for (int bj = 0; bj < 2; ++bj) { const f32x4 v0 = acc[ai][bj][m][0], v1 = acc[ai][bj][m][1];
                    *(u32x4*)(rowp + bj * 128) = (u32x4){cvt_pk_bf16(v0[0], v0[1]), cvt_pk_bf16(v0[2], v0[3]), cvt_pk_bf16(v1[0], v1[1]), cvt_pk_bf16(v1[2], v1[3])}; } }
    }
};

__device__ void transpose_convert(const float* __restrict__ src, unsigned short* __restrict__ dst, int K, int N, float* tile  , int ldd = 0, const bool pair_m = false) {
    if (ldd == 0) ldd = K;
    auto srcblk = [&](int tn) -> int {
        if (!pair_m) return tn;
        if (tn < 16) { const int tt = tn >> 2, r4 = tn & 3; return (r4 < 2) ? (tt * 2 + r4) : (8 + tt * 2 + (r4 - 2)); }
        if (tn < 80) return tn;
        const int q = tn - 80, tt = q >> 2, r4 = q & 3; return (r4 < 2) ? (80 + tt * 2 + r4) : (96 + tt * 2 + (r4 - 2)); };
    const int tid = threadIdx.x; const int nk = K / 64, nn = N / 64, ntile = nk * nn;
    const int r = tid >> 3, c = (tid & 7) * 8;
    f32x4 a, b;
    int t = blockIdx.x;
    if (t < ntile) { const int tk = t / nn, tn = t % nn; const float* p = src + (size_t)(tk * 64 + r) * N + srcblk(tn) * 64 + c; a = *(const f32x4*)p; b = *(const f32x4*)(p + 4); }
    for (; t < ntile; t += gridDim.x) {
        const int tk = t / nn, tn = t % nn;
        { float* q = tile + r * 65 + c; q[0] = a[0]; q[1] = a[1]; q[2] = a[2]; q[3] = a[3]; q[4] = b[0]; q[5] = b[1]; q[6] = b[2]; q[7] = b[3]; }
        __syncthreads();
        { const int t2 = t + gridDim.x;
          if (t2 < ntile) { const int tk2 = t2 / nn, tn2 = t2 % nn; const float* p = src + (size_t)(tk2 * 64 + r) * N + srcblk(tn2) * 64 + c; a = *(const f32x4*)p; b = *(const f32x4*)(p + 4); } }
        { const int n = tid >> 3, k0 = (tid & 7) * 8; float v[8];
#pragma unroll
          for (int j = 0; j < 8; ++j) v[j] = tile[(k0 + j) * 65 + n];
          *(u32x4*)(dst + (size_t)(tn * 64 + n) * ldd + tk * 64 + k0) = (u32x4){cvt_pk_bf16(v[0], v[1]), cvt_pk_bf16(v[2], v[3]), cvt_pk_bf16(v[4], v[5]), cvt_pk_bf16(v[6], v[7])}; }
        __syncthreads();
    }
}
__device__ void phase_prep(const Params& p, unsigned char* lds_generic) {
    float* tile = (float*)lds_generic;
    unsigned char* ws = p.ws;
    { const size_t n8 = (size_t)T_TOK * DM / 8; unsigned short* xb = (unsigned short*)(ws + OFF_XB);
      const size_t stride = (size_t)gridDim.x * NTHREADS;
      for (size_t i = (size_t)blockIdx.x * NTHREADS + threadIdx.x; i < n8; i += 4 * stride) {
          f32x4 a[4], b[4];
#pragma unroll
          for (int j = 0; j < 4; ++j) { const size_t ii = i + j * stride; if (ii < n8) { a[j] = *(const f32x4*)(p.x + ii * 8); b[j] = *(const f32x4*)(p.x + ii * 8 + 4); } }
#pragma unroll
          for (int j = 0; j < 4; ++j) { const size_t ii = i + j * stride; if (ii < n8)
              *(u32x4*)(xb + ii * 8) = (u32x4){cvt_pk_bf16(a[j][0], a[j][1]), cvt_pk_bf16(a[j][2], a[j][3]), cvt_pk_bf16(b[j][0], b[j][1]), cvt_pk_bf16(b[j][2], b[j][3])}; } } }
    { float* cs = (float*)(ws + OFF_MISC);
      for (int i = blockIdx.x * NTHREADS + threadIdx.x; i < IN_COLS; i += gridDim.x * NTHREADS) {
          float v = 1.0f;
          if (i >= 2048 && i < 3072) { const int c = i - 2048; const float l0 = p.lb_logits[c], l1 = p.lb_logits[HG + c]; const float lb = 1.0f / (1.0f + expf(l1 - l0)); v = 1.0f - lb; }
          cs[i] = v; } }
    transpose_convert(p.w_in, (unsigned short*)(ws + OFF_WIN), DM, IN_COLS, tile, 0, true);
    transpose_convert(p.w_conv_out, (unsigned short*)(ws + OFF_WCO), CONV_DIM, DM, tile, CONV_DIM + HG);
    transpose_convert(p.w_hgrn_out, (unsigned short*)(ws + OFF_WCO) + CONV_DIM, HG, DM, tile, CONV_DIM + HG);
    transpose_convert(p.w_out, (unsigned short*)(ws + OFF_WOUT), DM, DM, tile);
    transpose_convert(p.w_ffn_in, (unsigned short*)(ws + OFF_WFI), DM, 2 * DFF, tile);
    transpose_convert(p.w_ffn_out, (unsigned short*)(ws + OFF_WFO), DFF, DM, tile);
}

__device__ void phase_conv(const Params& p, unsigned char* lds) {
    unsigned short* gin = (unsigned short*)lds;
    float* obuf = (float*)(lds + 96256);
    const unsigned short* cvg = (const unsigned short*)(p.ws + OFF_CVG);
    unsigned short* cout = (unsigned short*)(p.ws + OFF_C);
    const int tid = threadIdx.x, wid = tid >> 6, lane = tid & 63;
    float w[CONV_K];
#pragma unroll
    for (int k = 0; k < CONV_K; ++k) w[k] = p.w_conv_dw[k * CONV_DIM + tid];
    const float bias = p.b_conv_dw[tid];
    float lg[8], lb[8];
#pragma unroll
    for (int j = 0; j < 8; ++j) { lg[j] = p.conv_ln_g[lane * 8 + j]; lb[j] = p.conv_ln_b[lane * 8 + j]; }
    for (int tile = blockIdx.x; tile < T_TOK / 64; tile += gridDim.x) {
        const int t0 = tile * 64, pos0 = t0 % SEQ;
        __syncthreads();
#pragma unroll
        for (int it0 = 0; it0 < 12; it0 += 4) {
            u32x4 av[4];
#pragma unroll
            for (int q = 0; q < 4; ++q) { const int i = tid + (it0 + q) * NTHREADS; const int row = i >> 6, c8 = (i & 63) * 8; const int pos = pos0 + row - 30;
                const bool valid = (i < 94 * 64) && (pos >= 0);
                const size_t tk = valid ? (size_t)(t0 + row - 30) : (size_t)t0;
                av[q] = *(const u32x4*)(cvg + tk * 512 + c8);
                if (!valid) av[q] = (u32x4){0u, 0u, 0u, 0u}; }
#pragma unroll
            for (int q = 0; q < 4; ++q) { const int i = tid + (it0 + q) * NTHREADS; const int row = i >> 6, c8 = (i & 63) * 8;
                if (i < 94 * 64) *(u32x4*)(gin + row * 512 + c8) = av[q]; }
        }
        __syncthreads();
        for (int rr = 0; rr < 4; ++rr) {
            float in[46];
#pragma unroll
            for (int j = 0; j < 46; ++j) in[j] = bf2f(gin[(rr * 16 + j) * 512 + tid]);
#pragma unroll
            for (int i = 0; i < 16; ++i) { float a = bias;
#pragma unroll
                for (int k = 0; k < CONV_K; ++k) a += w[k] * in[i + k];
                obuf[i * 512 + tid] = a; }
            __syncthreads();
#pragma unroll
            for (int q = 0; q < 2; ++q) { const int i = wid * 2 + q; const float* rp = obuf + i * 512 + lane * 8;
                const f32x4 a = *(const f32x4*)rp, b = *(const f32x4*)(rp + 4);
                float v[8] = {a[0], a[1], a[2], a[3], b[0], b[1], b[2], b[3]};
                float s = 0.f;
#pragma unroll
                for (int j = 0; j < 8; ++j) s += v[j];
                const float mean = wave_sum(s) * (1.0f / 512.0f);
                float ss = 0.f;
#pragma unroll
                for (int j = 0; j < 8; ++j) { v[j] -= mean; ss += v[j] * v[j]; }
                const float rstd = rsqrtf(wave_sum(ss) * (1.0f / 512.0f) + LN_EPS);
                float y[8];
#pragma unroll
                for (int j = 0; j < 8; ++j) { const float t = v[j] * rstd * lg[j] + lb[j]; y[j] = t * sigmoidf_(t); }
                *(u32x4*)(cout + (size_t)(t0 + rr * 16 + i) * 512 + lane * 8) = (u32x4){cvt_pk_bf16(y[0], y[1]), cvt_pk_bf16(y[2], y[3]), cvt_pk_bf16(y[4], y[5]), cvt_pk_bf16(y[6], y[7])}; }
            __syncthreads();
        }
    }
}

constexpr int H_QT = 0;
constexpr int H_KN = H_QT + 64 * 272;
constexpr int H_KT = H_KN + 64 * 272;
constexpr int H_VT = H_KT + 128 * 144;
constexpr int H_PP = H_VT + 128 * 144;
constexpr int H_SB = H_PP + 64 * 144;
constexpr int H_SEG = H_SB + 128 * 272;
constexpr int H_ER = H_SEG + 8192;
constexpr int H_EBL = H_ER + 512;
constexpr int H_SS = H_EBL + 512;
constexpr int H_END = H_SS + 2048;
static_assert(H_END <= LDS_BYTES, "hgrn lds");

template <bool OUT>
__device__ void hgrn_phase(const Params& p, unsigned char* lds, const int reps = 1) {
    const int tid = threadIdx.x, w = tid >> 6, lane = tid & 63, g = lane >> 4, c16 = lane & 15;
    const unsigned short* qg = (const unsigned short*)(p.ws + OFF_Q);
    const unsigned short* king = (const unsigned short*)(p.ws + OFF_KIN);
    const unsigned short* vg = (const unsigned short*)(p.ws + OFF_V);
    const unsigned short* gg = (const unsigned short*)(p.ws + OFF_G);
    unsigned short* og = (unsigned short*)(p.ws + OFF_CVG);
    float* segsum = (float*)(lds + H_SEG); float* er = (float*)(lds + H_ER); float* ebl = (float*)(lds + H_EBL); float* ssb = (float*)(lds + H_SS);
    const int kp = tid & 63;
    const int nchain = (256 - (int)blockIdx.x + (int)gridDim.x - 1) / (int)gridDim.x, nstep = nchain * 16 * reps;

    unsigned kraw[8], vraw[8], qraw[8];
    auto chunk_base = [&](int step) -> size_t {
        const int chain = blockIdx.x + ((step >> 4) % nchain) * gridDim.x, item = chain * 4 + ((step >> 2) & 3), c = step & 3;
        const int bh = item >> 5, sc = item & 31, b = bh >> 3, h = bh & 7;
        return ((size_t)b * SEQ + (size_t)sc * 256 + 64 * c + 8 * w) * 1024 + h * 128 + 2 * kp;
    };
    auto load_k = [&](int step) {
        const size_t gbase = chunk_base(step);
#pragma unroll
        for (int tt = 0; tt < 8; ++tt) kraw[tt] = *(const unsigned*)(king + gbase + (size_t)tt * 1024);
    };
    auto load_vq = [&](int step) {
        const size_t gbase = chunk_base(step);
#pragma unroll
        for (int tt = 0; tt < 8; ++tt) vraw[tt] = *(const unsigned*)(vg + gbase + (size_t)tt * 1024);
        if (OUT) {
#pragma unroll
            for (int tt = 0; tt < 8; ++tt) qraw[tt] = *(const unsigned*)(qg + gbase + (size_t)tt * 1024);
        }
    };
    float lf0[8], lf1[8], k0[8], k1[8];
    auto part1 = [&](int step) {
        float run0 = 0.f, run1 = 0.f;
#pragma unroll
        for (int tt = 0; tt < 8; ++tt) {
            const unsigned short lo = (unsigned short)(kraw[tt] & 0xffffu), hi = (unsigned short)(kraw[tt] >> 16);
            _Float16 hl, hh; __builtin_memcpy(&hl, &lo, 2); __builtin_memcpy(&hh, &hi, 2);
            k0[tt] = (float)hl; k1[tt] = (float)hh;
            run0 += __logf(fmaxf(1.0f - k0[tt], 1e-30f)); lf0[tt] = run0; run1 += __logf(fmaxf(1.0f - k1[tt], 1e-30f)); lf1[tt] = run1; }
        *(f32x2*)(segsum + (step & 1) * 1024 + w * 128 + 2 * kp) = (f32x2){run0, run1};
    };
    if (nstep > 0) { load_k(0); load_vq(0); part1(0); }

    f32x4 S[8];
    f32x4 gn = (f32x4){0.f, 0.f, 0.f, 0.f};
    float btot0 = 0.f, btot1 = 0.f;
    for (int step = 0; step < nstep; ++step) {
        const int chain = blockIdx.x + ((step >> 4) % nchain) * gridDim.x, jj = (step >> 2) & 3, item = chain * 4 + jj, c = step & 3;
        const int bh = item >> 5, sc = item & 31, b = bh >> 3, h = bh & 7;
        const size_t tc = (size_t)b * SEQ + (size_t)sc * 256 + 64 * c; const int ch0 = h * 128;
        unsigned short* Lg = (unsigned short*)(p.ws + OFF_L) + (size_t)chain * 16384;
        if (c == 0 && jj == 0) {
#pragma unroll
            for (int kt = 0; kt < 8; ++kt) {
                S[kt] = (f32x4){0.f, 0.f, 0.f, 0.f};
            }
            if (OUT) {
                const int nprev = chain & 7;
                for (int j = 0; j < nprev; ++j) {
                    const unsigned short* Lj = (const unsigned short*)(p.ws + OFF_L) + (size_t)((chain & ~7) + j) * 16384;
                    const float* Dj = (const float*)(p.ws + OFF_D) + (size_t)((chain & ~7) + j) * 128;
#pragma unroll
                    for (int kt = 0; kt < 8; ++kt) {
                        const u32x2 lv = *(const u32x2*)(Lj + (16 * w + c16) * 128 + 16 * kt + 4 * g);
                        const f32x4 dv = *(const f32x4*)(Dj + 16 * kt + 4 * g);
                        S[kt] = S[kt] * dv + (f32x4){bflo(lv[0]), bfhi(lv[0]), bflo(lv[1]), bfhi(lv[1])}; }
                }
            }
            if (OUT) gn = *(const f32x4*)(p.hgrn_norm_g + ch0 + 16 * w + 4 * g);
            btot0 = 0.f; btot1 = 0.f;
        }
        {
            __syncthreads();
            if (step + 1 < nstep) load_k(step + 1);
            float off0 = 0.f, off1 = 0.f, r0 = 0.f, r1 = 0.f, bl0 = 0.f, bl1 = 0.f;
#pragma unroll
            for (int sg = 0; sg < 8; ++sg) { const f32x2 sv = *(const f32x2*)(segsum + (step & 1) * 1024 + sg * 128 + 2 * kp);
                if (sg < w) { off0 += sv[0]; off1 += sv[1]; }
                if (sg < 4) { r0 += sv[0]; r1 += sv[1]; }
                bl0 += sv[0]; bl1 += sv[1]; }
            unsigned short kb0[8], kb1[8];
#pragma unroll
            for (int tt = 0; tt < 8; ++tt) {
                const float b0 = off0 + lf0[tt], b1 = off1 + lf1[tt];
                const float kt0 = k0[tt] * __expf(fminf(r0 - b0, 80.f)), kt1 = k1[tt] * __expf(fminf(r1 - b1, 80.f));
                const unsigned kpk = cvt_pk_bf16(kt0, kt1);
                kb0[tt] = (unsigned short)(kpk & 0xffffu); kb1[tt] = (unsigned short)(kpk >> 16);
                if (OUT) {
                    *(unsigned*)(lds + H_KN + (8 * w + tt) * 272 + kp * 4) = kpk;
                    const float q0 = bflo(qraw[tt]) * __expf(fminf(b0 - r0, 80.f)), q1 = bfhi(qraw[tt]) * __expf(fminf(b1 - r1, 80.f));
                    *(unsigned*)(lds + H_QT + (8 * w + tt) * 272 + kp * 4) = cvt_pk_bf16(q0, q1);
                }
            }
            u32x4 ka, kbv, va, vb;
#pragma unroll
            for (int j = 0; j < 4; ++j) {
                ka[j] = (unsigned)kb0[2 * j] | ((unsigned)kb0[2 * j + 1] << 16);
                kbv[j] = (unsigned)kb1[2 * j] | ((unsigned)kb1[2 * j + 1] << 16);
                va[j] = (vraw[2 * j] & 0xffffu) | (vraw[2 * j + 1] << 16);
                vb[j] = (vraw[2 * j] >> 16) | (vraw[2 * j + 1] & 0xffff0000u); }
            *(u32x4*)(lds + H_KT + (2 * kp) * 144 + w * 16) = ka;
            *(u32x4*)(lds + H_KT + (2 * kp + 1) * 144 + w * 16) = kbv;
            *(u32x4*)(lds + H_VT + (2 * kp) * 144 + w * 16) = va;
            *(u32x4*)(lds + H_VT + (2 * kp + 1) * 144 + w * 16) = vb;
            if (w == 0) { *(f32x2*)(er + 2 * kp) = (f32x2){__expf(r0), __expf(r1)}; *(f32x2*)(ebl + 2 * kp) = (f32x2){__expf(bl0 - r0), __expf(bl1 - r1)}; btot0 += bl0; btot1 += bl1; }
        }
        __syncthreads();
        if (step + 1 < nstep) load_vq(step + 1);
#pragma unroll
        for (int kt = 0; kt < 8; ++kt) {
            const f32x4 e = *(const f32x4*)(er + 16 * kt + 4 * g);
            S[kt] = S[kt] * e;
            if (OUT) *(u32x2*)(lds + H_SB + (16 * w + c16) * 272 + (16 * kt + 4 * g) * 2) = (u32x2){cvt_pk_bf16(S[kt][0], S[kt][1]), cvt_pk_bf16(S[kt][2], S[kt][3])};
        }
        if (OUT) {
#pragma unroll
            for (int i = 0; i < 2; ++i) {
                const int id = 2 * w + i, st = id >> 2, tt = id & 3;
                f32x4 a4 = (f32x4){0.f, 0.f, 0.f, 0.f};
                if (st <= tt) {
#pragma unroll
                    for (int ks = 0; ks < 4; ++ks) {
                        const bf16x8 af = *(const bf16x8*)(lds + H_KN + (16 * st + c16) * 272 + (32 * ks + 8 * g) * 2);
                        const bf16x8 bf = *(const bf16x8*)(lds + H_QT + (16 * tt + c16) * 272 + (32 * ks + 8 * g) * 2);
                        a4 = __builtin_amdgcn_mfma_f32_16x16x32_bf16(af, bf, a4, 0, 0, 0);
                    }
                    const int tcol = 16 * tt + c16;
#pragma unroll
                    for (int r = 0; r < 4; ++r) { const int srow = 16 * st + 4 * g + r; if (srow > tcol) a4[r] = 0.f; }
                }
                *(u32x2*)(lds + H_PP + (16 * tt + c16) * 144 + (16 * st + 4 * g) * 2) = (u32x2){cvt_pk_bf16(a4[0], a4[1]), cvt_pk_bf16(a4[2], a4[3])};
            }
        }
        __syncthreads();
        f32x4 O[4];
        u32x2 gzv[4];
        if (OUT) {
#pragma unroll
            for (int tt = 0; tt < 4; ++tt) gzv[tt] = *(const u32x2*)(gg + (tc + 16 * tt + c16) * 1024 + ch0 + 16 * w + 4 * g);
        }
        if (OUT) {
#pragma unroll
            for (int tt = 0; tt < 4; ++tt) {
                f32x4 a4 = (f32x4){0.f, 0.f, 0.f, 0.f};
#pragma unroll
                for (int ks = 0; ks < 2; ++ks) {
                    const bf16x8 af = *(const bf16x8*)(lds + H_VT + (16 * w + c16) * 144 + (32 * ks + 8 * g) * 2);
                    const bf16x8 bf = *(const bf16x8*)(lds + H_PP + (16 * tt + c16) * 144 + (32 * ks + 8 * g) * 2);
                    a4 = __builtin_amdgcn_mfma_f32_16x16x32_bf16(af, bf, a4, 0, 0, 0);
                }
#pragma unroll
                for (int ks = 0; ks < 4; ++ks) {
                    const bf16x8 af = *(const bf16x8*)(lds + H_SB + (16 * w + c16) * 272 + (32 * ks + 8 * g) * 2);
                    const bf16x8 bf = *(const bf16x8*)(lds + H_QT + (16 * tt + c16) * 272 + (32 * ks + 8 * g) * 2);
                    a4 = __builtin_amdgcn_mfma_f32_16x16x32_bf16(af, bf, a4, 0, 0, 0);
                }
                O[tt] = a4;
            }
        }
#pragma unroll
        for (int kt = 0; kt < 8; ++kt) {
#pragma unroll
            for (int ks = 0; ks < 2; ++ks) {
                const bf16x8 af = *(const bf16x8*)(lds + H_KT + (16 * kt + c16) * 144 + (32 * ks + 8 * g) * 2);
                const bf16x8 bf = *(const bf16x8*)(lds + H_VT + (16 * w + c16) * 144 + (32 * ks + 8 * g) * 2);
                S[kt] = __builtin_amdgcn_mfma_f32_16x16x32_bf16(af, bf, S[kt], 0, 0, 0);
            }
            const f32x4 e = *(const f32x4*)(ebl + 16 * kt + 4 * g);
            S[kt] = S[kt] * e;
        }
        if (OUT) {
#pragma unroll
            for (int tt = 0; tt < 4; ++tt) {
                float s = O[tt][0] * O[tt][0] + O[tt][1] * O[tt][1] + O[tt][2] * O[tt][2] + O[tt][3] * O[tt][3];
                s += __shfl_xor(s, 16); s += __shfl_xor(s, 32);
                if (g == 0) ssb[w * 64 + 16 * tt + c16] = s;
            }
            __syncthreads();
#pragma unroll
            for (int tt = 0; tt < 4; ++tt) {
                const int t = 16 * tt + c16; float tot = 0.f;
#pragma unroll
                for (int ww = 0; ww < 8; ++ww) tot += ssb[ww * 64 + t];
                const float rs = rsqrtf(tot * (1.0f / 128.0f) + RMS_EPS);
                const size_t gi = (tc + t) * 1024 + ch0 + 16 * w + 4 * g;
                const u32x2 gz = gzv[tt];
                const float o0 = bf2f(f2bf(O[tt][0] * rs * gn[0])) * bflo(gz[0]), o1 = bf2f(f2bf(O[tt][1] * rs * gn[1])) * bfhi(gz[0]);
                const float o2 = bf2f(f2bf(O[tt][2] * rs * gn[2])) * bflo(gz[1]), o3 = bf2f(f2bf(O[tt][3] * rs * gn[3])) * bfhi(gz[1]);
                *(u32x2*)(og + gi) = (u32x2){cvt_pk_bf16(o0, o1), cvt_pk_bf16(o2, o3)};
            }
        }
        if (!OUT && c == 3 && jj == 3) {
            float* Dg = (float*)(p.ws + OFF_D) + (size_t)chain * 128;
#pragma unroll
            for (int kt = 0; kt < 8; ++kt)
                *(u32x2*)(Lg + (16 * w + c16) * 128 + 16 * kt + 4 * g) = (u32x2){cvt_pk_bf16(S[kt][0], S[kt][1]), cvt_pk_bf16(S[kt][2], S[kt][3])};
            if (w == 0) *(f32x2*)(Dg + 2 * kp) = (f32x2){__expf(btot0), __expf(btot1)};
        }
        if (step + 1 < nstep) part1(step + 1);
    }
    __syncthreads();
}

__device__ void phase_scan(const Params& p) {
    unsigned short* L = (unsigned short*)(p.ws + OFF_L); const float* D = (const float*)(p.ws + OFF_D);
    for (int i = blockIdx.x * NTHREADS + threadIdx.x; i < 32 * 4096; i += gridDim.x * NTHREADS) {
        const int bh = i >> 12, e4 = i & 4095, k0 = (e4 & 31) * 4;
        f32x4 carry = (f32x4){0.f, 0.f, 0.f, 0.f};
        u32x2 v[8]; f32x4 d[8];
#pragma unroll
        for (int s = 0; s < 8; ++s) { const int chain = bh * 8 + s; v[s] = *(const u32x2*)(L + (size_t)chain * 16384 + e4 * 4); d[s] = *(const f32x4*)(D + chain * 128 + k0); }
#pragma unroll
        for (int s = 0; s < 8; ++s) { const int chain = bh * 8 + s;
            *(u32x2*)(L + (size_t)chain * 16384 + e4 * 4) = (u32x2){cvt_pk_bf16(carry[0], carry[1]), cvt_pk_bf16(carry[2], carry[3])};
            const f32x4 lv = (f32x4){bflo(v[s][0]), bfhi(v[s][0]), bflo(v[s][1]), bfhi(v[s][1])};
            carry = carry * d[s] + lv; }
    }
}

__device__ void phase_ln(float* buf, const float* gam, const float* bet, unsigned short* copyb) {
    const int lane = threadIdx.x & 63, wv = blockIdx.x * 8 + (threadIdx.x >> 6), nw = gridDim.x * 8;
    f32x4 gv[4], bv[4];
#pragma unroll
    for (int i = 0; i < 4; ++i) { gv[i] = *(const f32x4*)(gam + i * 256 + lane * 4); bv[i] = *(const f32x4*)(bet + i * 256 + lane * 4); }
    for (int r = wv; r < T_TOK; r += nw) {
        float* rp = buf + (size_t)r * 1024;
        f32x4 v[4]; float s = 0.f;
#pragma unroll
        for (int i = 0; i < 4; ++i) { v[i] = *(const f32x4*)(rp + i * 256 + lane * 4); s += v[i][0] + v[i][1] + v[i][2] + v[i][3]; }
        const float mean = wave_sum(s) * (1.0f / 1024.0f);
        float ss = 0.f;
#pragma unroll
        for (int i = 0; i < 4; ++i) { v[i] = v[i] - mean; ss += v[i][0] * v[i][0] + v[i][1] * v[i][1] + v[i][2] * v[i][2] + v[i][3] * v[i][3]; }
        const float rstd = rsqrtf(wave_sum(ss) * (1.0f / 1024.0f) + LN_EPS);
#pragma unroll
        for (int i = 0; i < 4; ++i) { const f32x4 y = v[i] * rstd * gv[i] + bv[i];
            if (copyb) *(u32x2*)(copyb + (size_t)r * 1024 + i * 256 + lane * 4) = (u32x2){cvt_pk_bf16(y[0], y[1]), cvt_pk_bf16(y[2], y[3])};
            else *(f32x4*)(rp + i * 256 + lane * 4) = y; }
    }
}

__device__ __forceinline__ float gelu_tanh(float x) {
    const float y = 0.7978845608028654f * (x + 0.044715f * x * x * x);
    const float t = 1.0f - 2.0f * __builtin_amdgcn_rcpf(1.0f + __expf(2.0f * y));
    return 0.5f * x * (1.0f + t);
}
__device__ void phase_act(const Params& p) {
    unsigned short* z = (unsigned short*)(p.ws + OFF_Z);
    constexpr int NCG = DFF / 8, RUN = 16, NRUN = T_TOK / RUN;
    for (int i = blockIdx.x * NTHREADS + threadIdx.x; i < NCG * NRUN; i += gridDim.x * NTHREADS) {
        const int cgi = i % NCG, run = i / NCG; const int c = cgi * 8; const size_t t0 = (size_t)run * RUN;
        float w0[8], w1[8], w2[8], bb[8];
#pragma unroll
        for (int j = 0; j < 8; ++j) { w0[j] = p.w_ffn_dw[c + j]; w1[j] = p.w_ffn_dw[DFF + c + j]; w2[j] = p.w_ffn_dw[2 * DFF + c + j]; bb[j] = p.b_ffn_dw[c + j]; }
        float um2[8], um1[8];
        if ((t0 % SEQ) == 0) {
#pragma unroll
            for (int j = 0; j < 8; ++j) { um2[j] = 0.f; um1[j] = 0.f; }
        } else {
            const u32x4 a = *(const u32x4*)(z + (t0 - 2) * (2 * DFF) + c), b = *(const u32x4*)(z + (t0 - 1) * (2 * DFF) + c);
#pragma unroll
            for (int j = 0; j < 4; ++j) { um2[2 * j] = bflo(a[j]); um2[2 * j + 1] = bfhi(a[j]); um1[2 * j] = bflo(b[j]); um1[2 * j + 1] = bfhi(b[j]); }
        }
#pragma unroll 4
        for (int tt = 0; tt < RUN; ++tt) {
            unsigned short* rowp = z + (t0 + tt) * (2 * DFF);
            const u32x4 a = *(const u32x4*)(rowp + c), gq = *(const u32x4*)(rowp + DFF + c);
            float u[8], gvv[8], o[8];
#pragma unroll
            for (int j = 0; j < 4; ++j) { u[2 * j] = bflo(a[j]); u[2 * j + 1] = bfhi(a[j]); gvv[2 * j] = bflo(gq[j]); gvv[2 * j + 1] = bfhi(gq[j]); }
#pragma unroll
            for (int j = 0; j < 8; ++j) { const float cv = w0[j] * um2[j] + w1[j] * um1[j] + w2[j] * u[j] + bb[j]; o[j] = gelu_tanh(cv) * gvv[j]; um2[j] = um1[j]; um1[j] = u[j]; }
            *(u32x4*)(rowp + DFF + c) = (u32x4){cvt_pk_bf16(o[0], o[1]), cvt_pk_bf16(o[2], o[3]), cvt_pk_bf16(o[4], o[5]), cvt_pk_bf16(o[6], o[7])};
        }
    }
}


#define XB_TMO      128
#define XB_XCNT(j)  (256  + 64 * (j))
#define XB_XSUB(j)  (1280 + 64 * (j))
#define XB_XGEN(j)  (2304 + 64 * (j))
#define XB_TOP      3328
#define XB_TOPGEN   3392
#define XCD_BAR_WORDS 3456
#define XB_SPIN_CAP (1u << 22)
__device__ __forceinline__ unsigned xb_ld(unsigned* p)              { return __hip_atomic_load(p, __ATOMIC_RELAXED, __HIP_MEMORY_SCOPE_AGENT); }
__device__ __forceinline__ unsigned xb_add(unsigned* p, unsigned v) { return __hip_atomic_fetch_add(p, v, __ATOMIC_RELAXED, __HIP_MEMORY_SCOPE_AGENT); }
__device__ __forceinline__ unsigned xb_xcc_id() { return (unsigned)__builtin_amdgcn_s_getreg((3 << 11) | 20) & 0xFu; }
#define XB_SPIN(cond, bar) do { unsigned _sp = 0; while (cond) { __builtin_amdgcn_s_sleep(1); \
    if ((++_sp & 255u) == 0u) { if (xb_ld(&(bar)[XB_TMO])) break; if (_sp > XB_SPIN_CAP) { atomicAdd(&(bar)[XB_TMO], 1u); break; } } } } while (0)
struct XcdBarrier { unsigned* bar; unsigned x; volatile LAS unsigned* st; };
__device__ __forceinline__ XcdBarrier xcd_barrier_post(unsigned* bar, volatile LAS unsigned* st) {
    XcdBarrier b; b.bar = bar; b.x = xb_xcc_id(); b.st = st;
    if (threadIdx.x == 0) (void)xb_add(&bar[XB_XCNT(b.x)], 1u);
    return b;
}
__device__ __forceinline__ void xcd_barrier_complete(unsigned* bar, unsigned x, unsigned& nloc, unsigned& nx) {
    const unsigned G = gridDim.x * gridDim.y * gridDim.z;
    unsigned sum, cnt, mine, sp = 0u;
    for (;;) {
        sum = 0u; cnt = 0u; mine = 0u;
#pragma unroll
        for (unsigned j = 0; j < 16; ++j) { const unsigned c = xb_ld(&bar[XB_XCNT(j)]); sum += c; cnt += (c > 0u) ? 1u : 0u; mine = (j == x) ? c : mine; }
        if (sum == G) break;
        __builtin_amdgcn_s_sleep(1);
        if ((++sp & 255u) == 0u) { if (xb_ld(&bar[XB_TMO])) break; if (sp > XB_SPIN_CAP) { atomicAdd(&bar[XB_TMO], 1u); break; } }
    }
    nloc = mine > 0u ? mine : 1u; nx = cnt > 0u ? cnt : 1u;
}
__device__ __forceinline__ void xcd_barrier(const XcdBarrier& b) {
    asm volatile("s_waitcnt vmcnt(0)" ::: "memory");
    __syncthreads();
    if (threadIdx.x == 0) {
        unsigned* bar = b.bar;
        __builtin_amdgcn_s_waitcnt(0);
        unsigned nloc = b.st[0], nx = b.st[1];
        if (nloc == 0u) { xcd_barrier_complete(bar, b.x, nloc, nx); b.st[0] = nloc; b.st[1] = nx; }
        const unsigned old = xb_add(&bar[XB_XSUB(b.x)], 1u);
        const unsigned gen = old / nloc;
        if (old + 1u == (gen + 1u) * nloc) {
            __builtin_amdgcn_fence(__ATOMIC_RELEASE, "agent");
            asm volatile("s_waitcnt vmcnt(0)" ::: "memory");
            const unsigned og = xb_add(&bar[XB_TOP], 1u);
            const unsigned tg = og / nx;
            if (og + 1u == (tg + 1u) * nx) xb_add(&bar[XB_TOPGEN], 1u);
            else XB_SPIN(xb_ld(&bar[XB_TOPGEN]) == tg, bar);
            __builtin_amdgcn_fence(__ATOMIC_ACQUIRE, "agent");
            xb_add(&bar[XB_XGEN(b.x)], 1u);
            asm volatile("s_waitcnt vmcnt(0)" ::: "memory");
        } else {
            XB_SPIN(xb_ld(&bar[XB_XGEN(b.x)]) == gen, bar);
            __builtin_amdgcn_fence(__ATOMIC_ACQUIRE, "agent");
            asm volatile("s_waitcnt vmcnt(0)" ::: "memory");
        }
    }
    __syncthreads();
}

#ifndef PHASE_MASK
#define PHASE_MASK 0x1fff
#endif
#ifndef DUP_MASK
#define DUP_MASK 0
#endif
#define PHASE(n) if ((PHASE_MASK & (1 << (n))) && (ph_only < 0 || ph_only == (n))) for (int rep_ = 0; rep_ < 1 + ((DUP_MASK >> (n)) & 1); ++rep_)
#define SYNC() do { if (ph_only < 0) xcd_barrier(xb); } while (0)
__global__ void __launch_bounds__(NTHREADS, 2) fwd_megakernel(Params p, int ph_only) {
    extern __shared__ __attribute__((aligned(16))) unsigned char shm[];
    cg::grid_group grid = cg::this_grid();
    LAS unsigned char* lds3 = (LAS unsigned char*)shm;
    volatile LAS unsigned* xst = (volatile LAS unsigned*)(lds3 + LDS_BYTES - 16);
    if (threadIdx.x == 0) { xst[0] = 0u; xst[1] = 0u; }
    __syncthreads();
    const XcdBarrier xb = xcd_barrier_post((unsigned*)(p.ws + OFF_BAR), xst);
    PHASE(0) { phase_prep(p, shm); }
    if (ph_only == -12345) grid.sync();
    SYNC();
    PHASE(1) { pg8::StaticOrder<IN_COLS / 256> S; S.init(T_TOK, IN_COLS, gridDim.x, blockIdx.x);
               pg8::Gemm g{(const bf16_t*)(p.ws + OFF_XB), (const bf16_t*)(p.ws + OFF_WIN), T_TOK, IN_COLS, DM, DM, nullptr, 0, 0};
               EpiProj e{p.ws, (unsigned short*)p.out, (const float*)(p.ws + OFF_MISC)}; pg8::gemm_phase(lds3, g, S, e); }
    SYNC();
    PHASE(2) { phase_conv(p, shm);
               hgrn_phase<false>(p, shm); }
    SYNC();
    PHASE(4) { hgrn_phase<true>(p, shm); }
    SYNC();
    PHASE(5) { pg8::StaticOrder<DM / 256> S; S.init(T_TOK, DM, gridDim.x, blockIdx.x);
               pg8::Gemm g{(const bf16_t*)(p.ws + OFF_C), (const bf16_t*)(p.ws + OFF_WCO), T_TOK, DM, CONV_DIM + HG, CONV_DIM, (const bf16_t*)(p.ws + OFF_CVG), HG, CONV_DIM / 64};
               EpiMix e{(const unsigned short*)p.out, (unsigned short*)(p.ws + OFF_V)}; pg8::gemm_phase<EpiMix, true>(lds3, g, S, e); }
    SYNC();
    PHASE(7) { pg8::StaticOrder<DM / 256> S; S.init(T_TOK, DM, gridDim.x, blockIdx.x);
               pg8::Gemm g{(const bf16_t*)(p.ws + OFF_V), (const bf16_t*)(p.ws + OFF_WOUT), T_TOK, DM, DM, DM, nullptr, 0, 0};
               EpiLn<2> e{p.ws + OFF_XB, p.ws + OFF_G, p.ln1_g, p.ln1_b, (float*)(p.ws + OFF_PART7), (unsigned*)(p.ws + OFF_CNT), lds3 + 131072}; pg8::gemm_phase(lds3, g, S, e); }
    SYNC();
    PHASE(9) { pg8::StaticOrder<2 * DFF / 256> S; S.init(T_TOK, 2 * DFF, gridDim.x, blockIdx.x);
               pg8::Gemm g{(const bf16_t*)(p.ws + OFF_G), (const bf16_t*)(p.ws + OFF_WFI), T_TOK, 2 * DFF, DM, DM, nullptr, 0, 0};
               EpiZ e{(unsigned short*)(p.ws + OFF_Z), 2 * DFF}; pg8::gemm_phase(lds3, g, S, e); }
    SYNC();
    PHASE(10) { phase_act(p); }
    SYNC();
    PHASE(11) { pg8::StaticOrder<DM / 256> S; S.init(T_TOK, DM, gridDim.x, blockIdx.x);
                pg8::Gemm g{(const bf16_t*)(p.ws + OFF_Z) + DFF, (const bf16_t*)(p.ws + OFF_WFO), T_TOK, DM, DFF, 2 * DFF, nullptr, 0, 0};
                EpiLn<1> e{p.ws + OFF_G, p.out, p.ln2_g, p.ln2_b, (float*)(p.ws + OFF_PART11), (unsigned*)(p.ws + OFF_CNT) + 128 * 2 * 64, lds3 + 131072}; pg8::gemm_phase(lds3, g, S, e); }
}

extern "C" void kernel_launch(void* const* d_in, const int* in_sizes, int n_in, void* d_out, int out_size, void* d_ws, size_t ws_size, hipStream_t stream) {
    static int grid_blocks = 0;
    if (!grid_blocks) {
        int dev = 0, cus = 0, per_cu = 0;
        hipGetDevice(&dev);
        hipDeviceGetAttribute(&cus, hipDeviceAttributeMultiprocessorCount, dev);
        hipFuncSetAttribute((const void*)fwd_megakernel, hipFuncAttributeMaxDynamicSharedMemorySize, LDS_BYTES);
        hipOccupancyMaxActiveBlocksPerMultiprocessor(&per_cu, (const void*)fwd_megakernel, NTHREADS, LDS_BYTES);
        if (per_cu < 1) per_cu = 1;
        if (per_cu > 1) per_cu = 1;
        grid_blocks = cus * per_cu;
        if (ws_size < WS_NEED) fprintf(stderr, "kernel_launch: workspace too small: %zu < %zu\n", ws_size, (size_t)WS_NEED);
    }
    hipMemsetAsync((unsigned char*)d_ws + OFF_BAR, 0, ZERO_BYTES, stream);
    Params p{};
    p.x = (const float*)d_in[0]; p.w_in = (const float*)d_in[1]; p.w_conv_dw = (const float*)d_in[2]; p.b_conv_dw = (const float*)d_in[3];
    p.conv_ln_g = (const float*)d_in[4]; p.conv_ln_b = (const float*)d_in[5]; p.w_conv_out = (const float*)d_in[6]; p.lb_logits = (const float*)d_in[7];
    p.hgrn_norm_g = (const float*)d_in[8]; p.w_hgrn_out = (const float*)d_in[9]; p.w_out = (const float*)d_in[10]; p.ln1_g = (const float*)d_in[11];
    p.ln1_b = (const float*)d_in[12]; p.w_ffn_in = (const float*)d_in[13]; p.w_ffn_dw = (const float*)d_in[14]; p.b_ffn_dw = (const float*)d_in[15];
    p.w_ffn_out = (const float*)d_in[16]; p.ln2_g = (const float*)d_in[17]; p.ln2_b = (const float*)d_in[18];
    p.out = (float*)d_out; p.ws = (unsigned char*)d_ws;
#if defined(MULTI_LAUNCH)
    for (int ph = 0; ph < 13; ++ph) hipLaunchKernelGGL(fwd_megakernel, dim3(grid_blocks), dim3(NTHREADS), LDS_BYTES, stream, p, ph);
#else
    int ph_only = -1;
    void* args[] = {&p, &ph_only};
    hipError_t e = hipLaunchCooperativeKernel((const void*)fwd_megakernel, dim3(grid_blocks), dim3(NTHREADS), args, LDS_BYTES, stream);
    if (e != hipSuccess) fprintf(stderr, "cooperative launch failed: %s (grid %d)\n", hipGetErrorString(e), grid_blocks);
#endif
}
```
